# Optimizing an MI355X kernel written in HIP

```python
import math
import jax
import jax.numpy as jnp
from jax import lax
import numpy as np

D_MODEL = 1024
BATCH = 1
SEQ = 16384
DEPTH = 4

GRID_W = 64
CTX_LEN = 256
N_MIXERS = 3
NORM_EPS = 1e-6
N_MOD = 6

DA_HEADS = 8
DA_HEAD_DIM = D_MODEL // (2 * DA_HEADS)
DA_SCALE = DA_HEAD_DIM ** -0.5
Q_BLOCK = 128
ROPE_BASE = 10000.0
ROPE_AXIS_DIM = DA_HEAD_DIM // 2

CHUNK = 128
GM_DIM = D_MODEL
GM_GROUPS = 8
GM_GROUP_CH = GM_DIM // GM_GROUPS

RW_HEAD = 64
RW_HEADS = D_MODEL // RW_HEAD
RW_DECAY_LORA = 64
RW_A_LORA = 64
RW_GATE_LORA = 160
RW_GN_EPS = 64e-5

FFN_DIM = 2816
N_EXPERTS = 8
TOP_K = 2

kernel_name = 'hybrid_diffattn_gmlp_rwkv7_moe_dit'


def rms_norm(x, g, eps=NORM_EPS):
    xf = x.astype(jnp.float32)
    y = xf * lax.rsqrt(jnp.mean(xf * xf, axis=-1, keepdims=True) + eps)
    return (y * g.astype(jnp.float32)).astype(x.dtype)


def layer_norm(x, g, b, eps=1e-5):
    xf = x.astype(jnp.float32)
    xc = xf - jnp.mean(xf, axis=-1, keepdims=True)
    var = jnp.mean(xc * xc, axis=-1, keepdims=True)
    return (xc * lax.rsqrt(var + eps) * g.astype(jnp.float32) + b.astype(jnp.float32)).astype(x.dtype)


def swiglu(h, w1, w3, w2):
    return (jax.nn.silu(h @ w1) * (h @ w3)) @ w2


def moe_swiglu(h, router, w1, w3, w2):
    logits = (h @ router).astype(jnp.float32)
    top_v, top_i = lax.top_k(logits, TOP_K)
    gate = jnp.einsum('bnk,bnke->bne', jax.nn.softmax(top_v, axis=-1),
                      jax.nn.one_hot(top_i, N_EXPERTS, dtype=jnp.float32)).astype(h.dtype)
    y = jnp.zeros_like(h)
    for e in range(N_EXPERTS):
        y = y + gate[..., e:e + 1] * swiglu(h, w1[e], w3[e], w2[e])
    return y


def axial_rope_tables(n_tokens):
    rows = n_tokens // GRID_W
    row = jnp.repeat(jnp.arange(rows, dtype=jnp.float32), GRID_W)
    col = jnp.tile(jnp.arange(GRID_W, dtype=jnp.float32), rows)
    inv_freq = ROPE_BASE ** (-jnp.arange(0, ROPE_AXIS_DIM, 2, dtype=jnp.float32) / ROPE_AXIS_DIM)
    ang_r = row[:, None] * inv_freq
    ang_c = col[:, None] * inv_freq
    ang = jnp.concatenate([ang_r, ang_r, ang_c, ang_c], axis=-1)
    return jnp.cos(ang), jnp.sin(ang)


def apply_axial_rope(x, cos, sin):
    x1, x2, x3, x4 = jnp.split(x, 4, axis=-1)
    rot = jnp.concatenate([-x2, x1, -x4, x3], axis=-1)
    return (x * cos[:, None, None, :] + rot * sin[:, None, None, :]).astype(x.dtype)


def diff_softmax_attend(q, k, v, lam):
    s = jnp.einsum('bqhmd,bkhmd->bhmqk', q, k).astype(jnp.float32) * DA_SCALE
    p = jax.nn.softmax(s, axis=-1)
    a = p[:, :, 0] - lam * p[:, :, 1]
    return jnp.einsum('bhqk,bkhe->bqhe', a.astype(v.dtype), v)


def diff_attention(h_lat, h_ctx, w_in, lam_p, subln, w_out, lam_init, need_ctx):
    B, T, _ = h_lat.shape

    def project(h):
        n = h.shape[1]
        q, k, v = jnp.split(h @ w_in, 3, axis=-1)
        return (q.reshape(B, n, DA_HEADS, 2, DA_HEAD_DIM),
                k.reshape(B, n, DA_HEADS, 2, DA_HEAD_DIM),
                v.reshape(B, n, DA_HEADS, 2 * DA_HEAD_DIM))

    def finish(o):
        o = rms_norm(o, subln, 1e-5) * (1.0 - lam_init)
        return o.reshape(B, o.shape[1], D_MODEL) @ w_out

    cos, sin = axial_rope_tables(T)
    q_l, k_l, v_l = project(h_lat)
    q_l = apply_axial_rope(q_l, cos, sin)
    k_l = apply_axial_rope(k_l, cos, sin)
    q_c, k_c, v_c = project(h_ctx)
    lp = lam_p.astype(jnp.float32)
    lam = jnp.exp(jnp.sum(lp[0] * lp[1])) - jnp.exp(jnp.sum(lp[2] * lp[3])) + lam_init
    k_all = jnp.concatenate([k_c, k_l], axis=1)
    v_all = jnp.concatenate([v_c, v_l], axis=1)
    n_blk = T // Q_BLOCK
    q_blk = jnp.moveaxis(q_l.reshape(B, n_blk, Q_BLOCK, DA_HEADS, 2, DA_HEAD_DIM), 1, 0)
    o_blk = lax.map(lambda qb: diff_softmax_attend(qb, k_all, v_all, lam), q_blk)
    o_lat = jnp.moveaxis(o_blk, 0, 1).reshape(B, T, DA_HEADS, 2 * DA_HEAD_DIM)
    y_lat = finish(o_lat)
    y_ctx = finish(diff_softmax_attend(q_c, k_c, v_c, lam)) if need_ctx else None
    return y_lat, y_ctx


def chunk_gmlp(h_lat, h_ctx, w_in, ln_g, ln_b, w_s, b_s, w_out, need_ctx):
    def mix(h):
        B, n, _ = h.shape
        u, v = jnp.split(jax.nn.gelu(h @ w_in, approximate=False), 2, axis=-1)
        v = layer_norm(v, ln_g, ln_b).reshape(B, n // CHUNK, CHUNK, GM_GROUPS, GM_GROUP_CH)
        s = jnp.einsum('gpq,bcqgk->bcpgk', w_s, v) + b_s.T[:, :, None]
        return (u * s.reshape(B, n, GM_DIM)) @ w_out

    return mix(h_lat), (mix(h_ctx) if need_ctx else None)


def token_shift(x):
    prev = jnp.pad(x, ((0, 0), (1, 0), (0, 0)))[:, :-1]
    nxt = jnp.pad(x, ((0, 0), (0, 1), (0, 0)))[:, 1:]
    return 0.5 * (prev + nxt) - x


def to_heads(t):
    return t.reshape(t.shape[:-1] + (RW_HEADS, RW_HEAD)).astype(jnp.float32)


def rwkv_prepare(h, mix, w_rkv, w0, w1, w2, a0, a1, a2, g1, g2, k_k, k_a):
    xm = h[None] + token_shift(h)[None] * mix[:, None, None, :]
    xr, xw, xk, xv, xa, xg = xm
    r, k, v = jnp.einsum('pbnd,pde->pbne', jnp.stack([xr, xk, xv]), w_rkv)
    w_log = -jax.nn.softplus(-(w0[:, None, None, :] + jnp.einsum(
        'zbnl,zld->zbnd', jnp.tanh(jnp.einsum('bnd,zdl->zbnl', xw, w1)), w2))) - 0.5
    a = jax.nn.sigmoid(a0[:, None, None, :] + jnp.einsum(
        'zbnl,zld->zbnd', jnp.einsum('bnd,zdl->zbnl', xa, a1), a2))
    g = jax.nn.sigmoid(xg @ g1) @ g2
    kk = to_heads(k * k_k)
    kk = kk / jnp.maximum(jnp.sqrt(jnp.sum(kk * kk, axis=-1, keepdims=True)), 1e-12)
    k_dir = to_heads(k[None] * (1.0 + (a - 1.0) * k_a))
    r_h, v_h = to_heads(r), to_heads(v)
    decay = jnp.exp(-jnp.exp(to_heads(w_log)))
    pair = lambda t: jnp.broadcast_to(t[None], (2,) + t.shape)
    scan_in = (pair(r_h), decay, k_dir, pair(v_h), pair(-kk), kk[None] * to_heads(a))
    return scan_in, r_h, k_dir, v_h, g


def wkv7_bidir(scan_in, state0):
    def to_time_major(t):
        return jnp.moveaxis(jnp.stack([t[0], jnp.flip(t[1], axis=1)]), 2, 0)

    def step(S, inp):
        r, w, k, v, a, b = inp
        sa = jnp.einsum('zbhij,zbhj->zbhi', S, a)
        S = S * w[..., None, :] + sa[..., :, None] * b[..., None, :] + v[..., :, None] * k[..., None, :]
        return S, jnp.einsum('zbhij,zbhj->zbhi', S, r)

    s_fin, y = lax.scan(step, state0, tuple(to_time_major(t) for t in scan_in))
    y = jnp.moveaxis(y, 0, 2)
    return s_fin, y[0] + jnp.flip(y[1], axis=1)


def rwkv_output(y, r_h, k_dir, v_h, g, r_k, ln_w, ln_b, w_out, dtype):
    B, n = y.shape[:2]
    yc = y - jnp.mean(y, axis=-1, keepdims=True)
    yn = yc * lax.rsqrt(jnp.mean(yc * yc, axis=-1, keepdims=True) + RW_GN_EPS)
    yn = yn.reshape(B, n, D_MODEL) * ln_w.astype(jnp.float32) + ln_b.astype(jnp.float32)
    bonus = jnp.sum(jnp.sum(r_h[None] * k_dir * r_k.astype(jnp.float32), axis=-1, keepdims=True), axis=0) * v_h
    o = (yn + bonus.reshape(B, n, D_MODEL)).astype(dtype)
    return (o * g) @ w_out


def rwkv7_bidir(h_lat, h_ctx, mix, w_rkv, w0, w1, w2, a0, a1, a2, g1, g2, k_k, k_a,
                r_k, ln_w, ln_b, w_out, need_ctx):
    pp = (mix, w_rkv, w0, w1, w2, a0, a1, a2, g1, g2, k_k, k_a)
    scan_c, r_c, kd_c, v_c, g_c = rwkv_prepare(h_ctx, *pp)
    scan_l, r_l, kd_l, v_l, g_l = rwkv_prepare(h_lat, *pp)
    s0 = jnp.zeros((2, h_lat.shape[0], RW_HEADS, RW_HEAD, RW_HEAD), jnp.float32)
    s_ctx, y_c = wkv7_bidir(scan_c, s0)
    _, y_l = wkv7_bidir(scan_l, s_ctx)
    y_lat = rwkv_output(y_l, r_l, kd_l, v_l, g_l, r_k, ln_w, ln_b, w_out, h_lat.dtype)
    y_ctx = rwkv_output(y_c, r_c, kd_c, v_c, g_c, r_k, ln_w, ln_b, w_out, h_ctx.dtype) if need_ctx else None
    return y_lat, y_ctx


def setup_inputs(seed: int = 0) -> dict:
    key = jax.random.key(seed)
    ks = iter(jax.random.split(key, 64))
    f32 = jnp.float32
    D = D_MODEL
    nrm = lambda shape, scale: jax.random.normal(next(ks), shape, f32) * scale
    gain = lambda shape: 1.0 + jax.random.normal(next(ks), shape, f32) * 0.05
    unif = lambda shape, lo, hi: jax.random.uniform(next(ks), shape, f32, lo, hi)
    na, ng, nr = (DEPTH + 2) // 3, (DEPTH + 1) // 3, DEPTH // 3
    nd, nm = (DEPTH + 1) // 2, DEPTH // 2
    return {
        'x': nrm((BATCH, SEQ, D), 1.0),
        'c': nrm((BATCH, D), 1.0),
        'ctx': nrm((BATCH, CTX_LEN, D), 1.0),
        'c_ctx': nrm((D,), 1.0),
        'norm_g': gain((DEPTH, 2, D)),
        'mod_w': nrm((DEPTH, D, N_MOD * D), 0.5 * D ** -0.5),
        'mod_b': nrm((DEPTH, N_MOD * D), 0.02),
        'final_g': gain((D,)),
        'attn_w_in': nrm((na, D, 3 * D), D ** -0.5),
        'attn_lambda': nrm((na, 4, DA_HEAD_DIM), 0.1),
        'attn_subln': gain((na, 2 * DA_HEAD_DIM)),
        'attn_w_out': nrm((na, D, D), D ** -0.5),
        'gmlp_w_in': nrm((ng, D, 2 * GM_DIM), D ** -0.5),
        'gmlp_ln_g': gain((ng, GM_DIM)),
        'gmlp_ln_b': nrm((ng, GM_DIM), 0.02),
        'gmlp_w_s': nrm((ng, GM_GROUPS, CHUNK, CHUNK), CHUNK ** -0.5),
        'gmlp_b_s': gain((ng, GM_GROUPS, CHUNK)),
        'gmlp_w_out': nrm((ng, GM_DIM, D), GM_DIM ** -0.5),
        'rwkv_mix': unif((nr, 6, D), 0.0, 1.0),
        'rwkv_w_rkv': nrm((nr, 3, D, D), D ** -0.5),
        'rwkv_w0': unif((nr, 2, D), -4.0, -0.5),
        'rwkv_w1': nrm((nr, 2, D, RW_DECAY_LORA), D ** -0.5),
        'rwkv_w2': nrm((nr, 2, RW_DECAY_LORA, D), 0.1 * RW_DECAY_LORA ** -0.5),
        'rwkv_a0': nrm((nr, 2, D), 0.1),
        'rwkv_a1': nrm((nr, 2, D, RW_A_LORA), D ** -0.5),
        'rwkv_a2': nrm((nr, 2, RW_A_LORA, D), RW_A_LORA ** -0.5),
        'rwkv_g1': nrm((nr, D, RW_GATE_LORA), D ** -0.5),
        'rwkv_g2': nrm((nr, RW_GATE_LORA, D), RW_GATE_LORA ** -0.5),
        'rwkv_k_k': 0.85 + nrm((nr, D), 0.05),
        'rwkv_k_a': gain((nr, D)),
        'rwkv_r_k': nrm((nr, RW_HEADS, RW_HEAD), 0.1),
        'rwkv_ln_w': gain((nr, D)),
        'rwkv_ln_b': nrm((nr, D), 0.02),
        'rwkv_w_out': nrm((nr, D, D), D ** -0.5),
        'ffn_w1': nrm((nd, D, FFN_DIM), D ** -0.5),
        'ffn_w3': nrm((nd, D, FFN_DIM), D ** -0.5),
        'ffn_w2': nrm((nd, FFN_DIM, D), FFN_DIM ** -0.5),
        'moe_router': nrm((nm, D, N_EXPERTS), D ** -0.5),
        'moe_w1': nrm((nm, N_EXPERTS, D, FFN_DIM), D ** -0.5),
        'moe_w3': nrm((nm, N_EXPERTS, D, FFN_DIM), D ** -0.5),
        'moe_w2': nrm((nm, N_EXPERTS, FFN_DIM, D), FFN_DIM ** -0.5),
    }


def reference(x, c, ctx, c_ctx, norm_g, mod_w, mod_b, final_g,
              attn_w_in, attn_lambda, attn_subln, attn_w_out,
              gmlp_w_in, gmlp_ln_g, gmlp_ln_b, gmlp_w_s, gmlp_b_s, gmlp_w_out,
              rwkv_mix, rwkv_w_rkv, rwkv_w0, rwkv_w1, rwkv_w2, rwkv_a0, rwkv_a1, rwkv_a2,
              rwkv_g1, rwkv_g2, rwkv_k_k, rwkv_k_a, rwkv_r_k, rwkv_ln_w, rwkv_ln_b, rwkv_w_out,
              ffn_w1, ffn_w3, ffn_w2, moe_router, moe_w1, moe_w3, moe_w2):
    n_ctx = ctx.shape[1]
    xl, xc = x, ctx
    s_lat = jax.nn.silu(c)[:, None, :]
    s_ctx = jax.nn.silu(c_ctx)
    for i in range(DEPTH):
        last = i == DEPTH - 1
        mod_l = jnp.split(s_lat @ mod_w[i] + mod_b[i], N_MOD, axis=-1)
        mod_c = jnp.split(s_ctx @ mod_w[i] + mod_b[i], N_MOD, axis=-1)
        h_l = rms_norm(xl, norm_g[i, 0]) * (1.0 + mod_l[1]) + mod_l[0]
        h_c = rms_norm(xc, norm_g[i, 0]) * (1.0 + mod_c[1]) + mod_c[0]
        kind, j = i % N_MIXERS, i // N_MIXERS
        if kind == 0:
            lam_init = 0.8 - 0.6 * math.exp(-0.3 * i)
            y_l, y_c = diff_attention(h_l, h_c, attn_w_in[j], attn_lambda[j], attn_subln[j],
                                      attn_w_out[j], lam_init, not last)
        elif kind == 1:
            y_l, y_c = chunk_gmlp(h_l, h_c, gmlp_w_in[j], gmlp_ln_g[j], gmlp_ln_b[j], gmlp_w_s[j],
                                  gmlp_b_s[j], gmlp_w_out[j], not last)
        else:
            y_l, y_c = rwkv7_bidir(h_l, h_c, rwkv_mix[j], rwkv_w_rkv[j], rwkv_w0[j], rwkv_w1[j],
                                   rwkv_w2[j], rwkv_a0[j], rwkv_a1[j], rwkv_a2[j], rwkv_g1[j],
                                   rwkv_g2[j], rwkv_k_k[j], rwkv_k_a[j], rwkv_r_k[j], rwkv_ln_w[j],
                                   rwkv_ln_b[j], rwkv_w_out[j], not last)
        xl = xl + mod_l[2] * y_l
        h2_l = rms_norm(xl, norm_g[i, 1]) * (1.0 + mod_l[4]) + mod_l[3]
        if last:
            h2 = h2_l
        else:
            xc = xc + mod_c[2] * y_c
            h2_c = rms_norm(xc, norm_g[i, 1]) * (1.0 + mod_c[4]) + mod_c[3]
            h2 = jnp.concatenate([h2_c, h2_l], axis=1)
        if i % 2 == 0:
            f = swiglu(h2, ffn_w1[i // 2], ffn_w3[i // 2], ffn_w2[i // 2])
        else:
            f = moe_swiglu(h2, moe_router[i // 2], moe_w1[i // 2], moe_w3[i // 2], moe_w2[i // 2])
        if last:
            xl = xl + mod_l[5] * f
        else:
            xc = xc + mod_c[5] * f[:, :n_ctx]
            xl = xl + mod_l[5] * f[:, n_ctx:]
    return rms_norm(xl, final_g)
```

```cpp
#include <hip/hip_runtime.h>
#include <stdint.h>
#include <math.h>
#include <string.h>

namespace {
constexpr int D = 1024, RC = 256, RL = 16384, R = RC + RL, FF = 2816, NTHR = 512;
typedef unsigned short bf16_t;
typedef float f32x4 __attribute__((ext_vector_type(4)));
typedef unsigned u32x4 __attribute__((ext_vector_type(4)));
typedef unsigned u32x2 __attribute__((ext_vector_type(2)));

struct Params { const float* in[41]; float* out; unsigned char* ws; };

constexpr size_t MiB = 1u << 20;
constexpr size_t WS_MOD = 1 * MiB;
constexpr size_t WS_TAB = 2 * MiB;
constexpr size_t WS_ROUTE = 3 * MiB;
constexpr size_t WS_KN = 4 * MiB;
constexpr size_t WS_XL = 8 * MiB;
constexpr size_t WS_H = 73 * MiB;
constexpr size_t WS_S = 106 * MiB;
constexpr size_t WS_QKV = WS_S;
constexpr size_t WS_O = WS_S + 98 * MiB;
constexpr size_t WS_A2 = WS_S + 228 * MiB;
constexpr size_t WS_ACT = WS_S;
constexpr size_t WS_U = WS_S;
constexpr size_t WS_VP = WS_S + 33 * MiB;
constexpr size_t WS_VN = WS_S + 98 * MiB;
constexpr size_t WS_MIX = WS_S;
constexpr size_t WS_DEC = WS_S;
constexpr size_t WS_AP = WS_S + 130 * MiB;
constexpr size_t WS_RR = WS_S + 196 * MiB;
constexpr size_t WS_KK = WS_S + 229 * MiB;
constexpr size_t WS_VV = WS_S + 262 * MiB;
constexpr size_t WS_L1W = WS_S + 295 * MiB;
constexpr size_t WS_L1A = WS_S + 300 * MiB;
constexpr size_t WS_L1G = WS_S + 305 * MiB;
constexpr size_t WS_G = WS_S + 314 * MiB;
constexpr size_t WS_Y = WS_S + 347 * MiB;
constexpr size_t WS_A2R = WS_S + 478 * MiB;
constexpr size_t WS_END = WS_S + 512 * MiB;

__device__ __forceinline__ float bf2f(unsigned b) { return __uint_as_float(b << 16); }
__device__ __forceinline__ unsigned f2bf(float f) { unsigned u = __float_as_uint(f); u += 0x7fffu + ((u >> 16) & 1u); return u >> 16; }
__device__ __forceinline__ unsigned pk2(float lo, float hi) { return f2bf(lo) | (f2bf(hi) << 16); }
__device__ __forceinline__ float wave_sum(float v) {
#pragma unroll
    for (int o = 32; o > 0; o >>= 1) v += __shfl_xor(v, o);
    return v;
}
__device__ __forceinline__ float sigmoidf_(float x) { return 1.f / (1.f + __expf(-x)); }
__device__ __forceinline__ float siluf_(float x) { return x / (1.f + __expf(-x)); }
__device__ __forceinline__ float geluf_(float v) {
    const float t = __builtin_amdgcn_rcpf(fabsf(v) * 0.2316418882f + 1.0f);
    float q = t * 0.5307027145f + (-0.7265760135f); q = q * t + 0.7107068705f; q = q * t + (-0.142248368f); q = q * t + 0.127414796f; q = q * t;
    const float e = __builtin_amdgcn_exp2f(v * v * (-0.72134752044f));
    const float m = v * (q * e);
    return v < 0.f ? m : v - m;
}

struct BPlain { const float* W; int ldb; __device__ __forceinline__ float operator()(int k, int n) const { return W[(size_t)k * ldb + n]; } };
struct BGateUp { const float* W1; const float* W3; int ldb; __device__ __forceinline__ float operator()(int k, int n) const { return ((n & 1) ? W3 : W1)[(size_t)k * ldb + (n >> 1)]; } };
__device__ __forceinline__ int qk_orig_col(int n) { if (n >= 2048) return n; const int p = n & 63; return (n & ~63) + ((p >> 5) << 5) + ((p & 1) << 4) + ((p & 31) >> 1); }
struct BQKV { const float* W; __device__ __forceinline__ float operator()(int k, int n) const { return W[(size_t)k * 3072 + qk_orig_col(n)]; } };
struct BLora1 { const float* W;   __device__ __forceinline__ float operator()(int k, int n) const { return W[(size_t)(n >> 6) * 65536 + (size_t)k * 64 + (n & 63)]; } };
struct BLora2 { const float* W;   __device__ __forceinline__ float operator()(int k, int n) const { const int z = n >> 10; return ((k >> 6) == z) ? W[(size_t)z * 65536 + (size_t)(k & 63) * 1024 + (n & 1023)] : 0.f; } };
struct BG1 { const float* W;   __device__ __forceinline__ float operator()(int k, int n) const { return n < 160 ? W[(size_t)k * 160 + n] : 0.f; } };
struct BG2 { const float* W;   __device__ __forceinline__ float operator()(int k, int n) const { return k < 160 ? W[(size_t)k * 1024 + n] : 0.f; } };

struct EpiQKV {
    bf16_t* QKV; const float* tab; float qscale;
    __device__ __forceinline__ void operator()(int row, int col0, float (&v)[8]) const {
        if (col0 < 2048 && row >= RC) {
            const int t = row - RC, p0 = col0 & 63, pos = (p0 >> 5) ? (t & 63) : (t >> 6), i0 = (p0 & 31) >> 1;
#pragma unroll
            for (int j = 0; j < 4; ++j) { const float c = tab[(pos * 16 + i0 + j) * 2], s = tab[(pos * 16 + i0 + j) * 2 + 1], e = v[2 * j], o = v[2 * j + 1]; v[2 * j] = e * c - o * s; v[2 * j + 1] = o * c + e * s; }
        }
        if (col0 < 1024) {
#pragma unroll
            for (int j = 0; j < 8; ++j) v[j] *= qscale;
        }
        u32x4 w = {pk2(v[0], v[1]), pk2(v[2], v[3]), pk2(v[4], v[5]), pk2(v[6], v[7])};
        *(u32x4*)(QKV + (size_t)row * 3072 + col0) = w;
    }
};
struct EpiResid {
    float* XL; const float* modl; int which; const int* route; int expert;
    __device__ __forceinline__ void operator()(int row, int col0, float (&v)[8]) const {
        const float* m = modl + (row < RC ? 6144 : 0) + which * 1024 + col0;
        float gate = 1.f;
        if (route) { const int* rt = route + (size_t)row * 4; gate = (rt[0] == expert ? __int_as_float(rt[2]) : 0.f) + (rt[1] == expert ? __int_as_float(rt[3]) : 0.f); }
        float* x = XL + (size_t)row * 1024 + col0;
        f32x4 a = *(f32x4*)x, b = *(f32x4*)(x + 4);
        a[0] += m[0] * v[0] * gate; a[1] += m[1] * v[1] * gate; a[2] += m[2] * v[2] * gate; a[3] += m[3] * v[3] * gate;
        b[0] += m[4] * v[4] * gate; b[1] += m[5] * v[5] * gate; b[2] += m[6] * v[6] * gate; b[3] += m[7] * v[7] * gate;
        *(f32x4*)x = a; *(f32x4*)(x + 4) = b;
    }
};
struct EpiGateUp {
    bf16_t* ACT; int ld;
    __device__ __forceinline__ void operator()(int row, int col0, float (&v)[8]) const {
        float a[4];
#pragma unroll
        for (int j = 0; j < 4; ++j) a[j] = siluf_(v[2 * j]) * v[2 * j + 1];
        u32x2 w = {pk2(a[0], a[1]), pk2(a[2], a[3])};
        *(u32x2*)(ACT + (size_t)row * ld + (col0 >> 1)) = w;
    }
};
struct EpiGelu {
    bf16_t* U; float* VP;
    __device__ __forceinline__ void operator()(int row, int col0, float (&v)[8]) const {
#pragma unroll
        for (int j = 0; j < 8; ++j) v[j] = geluf_(v[j]);
        if (col0 < 1024) { u32x4 w = {pk2(v[0], v[1]), pk2(v[2], v[3]), pk2(v[4], v[5]), pk2(v[6], v[7])}; *(u32x4*)(U + (size_t)row * 1024 + col0) = w; }
        else { float* o = VP + (size_t)row * 1024 + (col0 - 1024); *(f32x4*)o = (f32x4){v[0], v[1], v[2], v[3]}; *(f32x4*)(o + 4) = (f32x4){v[4], v[5], v[6], v[7]}; }
    }
};
struct EpiStore {
    bf16_t* O; int ld; int act;
    __device__ __forceinline__ void operator()(int row, int col0, float (&v)[8]) const {
#pragma unroll
        for (int j = 0; j < 8; ++j) { if (act == 1) v[j] = tanhf(v[j]); else if (act == 2) v[j] = sigmoidf_(v[j]); }
        u32x4 w = {pk2(v[0], v[1]), pk2(v[2], v[3]), pk2(v[4], v[5]), pk2(v[6], v[7])};
        *(u32x4*)(O + (size_t)row * ld + col0) = w;
    }
};
struct EpiDecay {
    float* DEC; const float* w0;
    __device__ __forceinline__ void operator()(int row, int col0, float (&v)[8]) const {
        const int z = col0 >> 10, d0 = col0 & 1023;
        float o[8];
#pragma unroll
        for (int j = 0; j < 8; ++j) { const float x = w0[z * 1024 + d0 + j] + v[j], y = -x; const float sp = fmaxf(y, 0.f) + log1pf(expf(-fabsf(y))); const float wl = -sp - 0.5f; o[j] = expf(-expf(wl)); }
        float* p = DEC + ((size_t)z * R + row) * 1024 + d0;
        *(f32x4*)p = (f32x4){o[0], o[1], o[2], o[3]}; *(f32x4*)(p + 4) = (f32x4){o[4], o[5], o[6], o[7]};
    }
};
struct EpiAP {
    bf16_t* AP; const float* a0;
    __device__ __forceinline__ void operator()(int row, int col0, float (&v)[8]) const {
        const int z = col0 >> 10, d0 = col0 & 1023;
        float o[8];
#pragma unroll
        for (int j = 0; j < 8; ++j) o[j] = sigmoidf_(a0[z * 1024 + d0 + j] + v[j]);
        u32x4 w = {pk2(o[0], o[1]), pk2(o[2], o[3]), pk2(o[4], o[5]), pk2(o[6], o[7])};
        *(u32x4*)(AP + ((size_t)z * R + row) * 1024 + d0) = w;
    }
};

template <class BMap, class Epi>
__device__ __forceinline__ void gemm_naive(const bf16_t* __restrict__ A, int lda, int row0, int M, int N, int K, const BMap B, const Epi E, float* lds) {
    float* As = lds; float* Bs = lds + 16 * 132;
    const int tid = threadIdx.x, tr = tid >> 4, tc = tid & 15;
    const int nN = N / 128, nU = (M / 128) * nN;
    for (int u = blockIdx.x; u < nU; u += gridDim.x) {
        const int tm = u / nN, tn = u % nN;
        float acc[4][8];
#pragma unroll
        for (int i = 0; i < 4; ++i)
#pragma unroll
            for (int j = 0; j < 8; ++j) acc[i][j] = 0.f;
        for (int k0 = 0; k0 < K; k0 += 16) {
            {
                const int r = tid >> 2, kq = (tid & 3) * 4;
                const u32x2 raw = *(const u32x2*)(A + (size_t)(row0 + tm * 128 + r) * lda + k0 + kq);
                As[(kq + 0) * 132 + r] = bf2f(raw[0] & 0xffffu); As[(kq + 1) * 132 + r] = bf2f(raw[0] >> 16);
                As[(kq + 2) * 132 + r] = bf2f(raw[1] & 0xffffu); As[(kq + 3) * 132 + r] = bf2f(raw[1] >> 16);
                const int kk = tid >> 5, n4 = (tid & 31) * 4;
#pragma unroll
                for (int i = 0; i < 4; ++i) Bs[kk * 132 + n4 + i] = B(k0 + kk, tn * 128 + n4 + i);
            }
            __syncthreads();
#pragma unroll
            for (int kk = 0; kk < 16; ++kk) {
                const f32x4 a = *(const f32x4*)&As[kk * 132 + tr * 4];
                const f32x4 b0 = *(const f32x4*)&Bs[kk * 132 + tc * 8], b1 = *(const f32x4*)&Bs[kk * 132 + tc * 8 + 4];
#pragma unroll
                for (int i = 0; i < 4; ++i) {
                    acc[i][0] += a[i] * b0[0]; acc[i][1] += a[i] * b0[1]; acc[i][2] += a[i] * b0[2]; acc[i][3] += a[i] * b0[3];
                    acc[i][4] += a[i] * b1[0]; acc[i][5] += a[i] * b1[1]; acc[i][6] += a[i] * b1[2]; acc[i][7] += a[i] * b1[3];
                }
            }
            __syncthreads();
        }
#pragma unroll
        for (int i = 0; i < 4; ++i) { E(row0 + tm * 128 + tr * 4 + i, tn * 128 + tc * 8, acc[i]); __builtin_amdgcn_sched_barrier(0); }
    }
}

__device__ __forceinline__ void phase_mod(const Params& p, float* lds) {
    const int tid = threadIdx.x, lane = tid & 63, wv = tid >> 6;
    float* MOD = (float*)(p.ws + WS_MOD);
    const float* c = p.in[1]; const float* cc = p.in[3]; const float* mw = p.in[5]; const float* mb = p.in[6];
    for (int item = blockIdx.x; item < 4 * 96; item += gridDim.x) {
        const int i = item / 96, n = (item % 96) * 64 + lane;
        float sl = 0.f, sc = 0.f;
        for (int k = wv * 128; k < wv * 128 + 128; ++k) { const float w = mw[((size_t)i * 1024 + k) * 6144 + n]; sl += siluf_(c[k]) * w; sc += siluf_(cc[k]) * w; }
        lds[wv * 64 + lane] = sl; lds[512 + wv * 64 + lane] = sc;
        __syncthreads();
        if (wv == 0) {
            float a = 0.f, b = 0.f;
#pragma unroll
            for (int w = 0; w < 8; ++w) { a += lds[w * 64 + lane]; b += lds[512 + w * 64 + lane]; }
            const float bias = mb[i * 6144 + n];
            MOD[(i * 2 + 0) * 6144 + n] = a + bias; MOD[(i * 2 + 1) * 6144 + n] = b + bias;
        }
        __syncthreads();
    }
    float* tab = (float*)(p.ws + WS_TAB);
    for (int idx = blockIdx.x * NTHR + tid; idx < 256 * 16; idx += gridDim.x * NTHR) {
        const int pos = idx >> 4, f = idx & 15;
        const float inv = (float)pow(10000.0, -(double)f / 16.0);
        const float ang = (float)pos * inv;
        tab[idx * 2] = (float)cos((double)ang); tab[idx * 2 + 1] = (float)sin((double)ang);
    }
}

__device__ __forceinline__ void phase_norm(const Params& p, int layer, int which, int init, int route_j, int row_lo, int final_out) {
    const int lane = threadIdx.x & 63, wv = threadIdx.x >> 6;
    float* XL = (float*)(p.ws + WS_XL); bf16_t* H = (bf16_t*)(p.ws + WS_H);
    const float* g = final_out ? p.in[7] : p.in[4] + (layer * 2 + which) * 1024;
    const float* modb = (const float*)(p.ws + WS_MOD) + layer * 2 * 6144;
    for (int row = row_lo + blockIdx.x * 8 + wv; row < R; row += gridDim.x * 8) {
        const bool isc = row < RC;
        const float* m = modb + (isc ? 6144 : 0);
        const float* shift = m + (which ? 3 : 0) * 1024; const float* scale = m + (which ? 4 : 1) * 1024;
        f32x4 x[4]; float ss = 0.f;
#pragma unroll
        for (int j = 0; j < 4; ++j) {
            const int col = j * 256 + lane * 4;
            if (init) { const float* src = isc ? p.in[2] + (size_t)row * 1024 : p.in[0] + (size_t)(row - RC) * 1024; x[j] = *(const f32x4*)(src + col); *(f32x4*)(XL + (size_t)row * 1024 + col) = x[j]; }
            else x[j] = *(const f32x4*)(XL + (size_t)row * 1024 + col);
            ss += x[j][0] * x[j][0] + x[j][1] * x[j][1] + x[j][2] * x[j][2] + x[j][3] * x[j][3];
        }
        ss = wave_sum(ss);
        const float rs = rsqrtf(ss * (1.f / 1024.f) + 1e-6f);
        float lg[8];
#pragma unroll
        for (int e = 0; e < 8; ++e) lg[e] = 0.f;
#pragma unroll
        for (int j = 0; j < 4; ++j) {
            const int col = j * 256 + lane * 4;
            const f32x4 gg = *(const f32x4*)(g + col);
            f32x4 h;
            if (final_out) { h = x[j] * rs * gg; *(f32x4*)(p.out + (size_t)(row - RC) * 1024 + col) = h; }
            else {
                const f32x4 sc = *(const f32x4*)(scale + col), sh = *(const f32x4*)(shift + col);
                h = x[j] * rs * gg * (1.f + sc) + sh;
                u32x2 w = {pk2(h[0], h[1]), pk2(h[2], h[3])};
                *(u32x2*)(H + (size_t)row * 1024 + col) = w;
                if (route_j >= 0) {
                    const float* rt = p.in[37] + (size_t)route_j * 8192 + (size_t)col * 8;
#pragma unroll
                    for (int q = 0; q < 4; ++q)
#pragma unroll
                        for (int e = 0; e < 8; ++e) lg[e] += h[q] * rt[q * 8 + e];
                }
            }
        }
        if (route_j >= 0 && !final_out) {
#pragma unroll
            for (int e = 0; e < 8; ++e) lg[e] = wave_sum(lg[e]);
            if (lane == 0) {
                int i0 = 0; float v0 = lg[0];
#pragma unroll
                for (int e = 1; e < 8; ++e) if (lg[e] > v0) { v0 = lg[e]; i0 = e; }
                int i1 = -1; float v1 = -3.0e38f;
#pragma unroll
                for (int e = 0; e < 8; ++e) if (e != i0 && lg[e] > v1) { v1 = lg[e]; i1 = e; }
                const float e1 = expf(v1 - v0), g0 = 1.f / (1.f + e1), g1 = e1 / (1.f + e1);
                int* ro = (int*)(p.ws + WS_ROUTE) + (size_t)row * 4;
                ro[0] = i0; ro[1] = i1; ro[2] = __float_as_int(g0); ro[3] = __float_as_int(g1);
            }
        }
    }
}

__device__ __forceinline__ void phase_attn_naive(const Params& p, int with_ctx, float* lds) {
    const bf16_t* QKV = (const bf16_t*)(p.ws + WS_QKV); float* O = (float*)(p.ws + WS_O);
    float* Ks = lds; float* Vs = lds + 32 * 64;
    const int tid = threadIdx.x;
    const int nlat = 32 * 16, nU = nlat + (with_ctx ? 16 : 0);
    for (int u = blockIdx.x; u < nU; u += gridDim.x) {
        int hm, row, nkeys; bool active = true;
        if (u < nlat) { hm = u & 15; row = RC + (u >> 4) * 512 + tid; nkeys = R; }
        else { hm = u - nlat; active = tid < RC; row = active ? tid : 0; nkeys = RC; }
        float q[64];
#pragma unroll
        for (int d8 = 0; d8 < 8; ++d8) {
            const u32x4 raw = *(const u32x4*)(QKV + (size_t)row * 3072 + hm * 64 + d8 * 8);
#pragma unroll
            for (int i = 0; i < 4; ++i) { q[d8 * 8 + 2 * i] = bf2f(raw[i] & 0xffffu); q[d8 * 8 + 2 * i + 1] = bf2f(raw[i] >> 16); }
        }
        float o[128];
#pragma unroll
        for (int e = 0; e < 128; ++e) o[e] = 0.f;
        float m = -1e30f, l = 0.f;
        for (int k0 = 0; k0 < nkeys; k0 += 32) {
            __syncthreads();
            if (tid < 256) {
                const int kr = tid >> 3, c8 = (tid & 7) * 8;
                const u32x4 raw = *(const u32x4*)(QKV + (size_t)(k0 + kr) * 3072 + 1024 + hm * 64 + c8);
#pragma unroll
                for (int i = 0; i < 4; ++i) { Ks[kr * 64 + c8 + 2 * i] = bf2f(raw[i] & 0xffffu); Ks[kr * 64 + c8 + 2 * i + 1] = bf2f(raw[i] >> 16); }
            }
            {
                const int kr = tid >> 4, c8 = (tid & 15) * 8;
                const u32x4 raw = *(const u32x4*)(QKV + (size_t)(k0 + kr) * 3072 + 2048 + (hm >> 1) * 128 + c8);
#pragma unroll
                for (int i = 0; i < 4; ++i) { Vs[kr * 128 + c8 + 2 * i] = bf2f(raw[i] & 0xffffu); Vs[kr * 128 + c8 + 2 * i + 1] = bf2f(raw[i] >> 16); }
            }
            __syncthreads();
            for (int kk = 0; kk < 32; ++kk) {
                float s = 0.f;
#pragma unroll
                for (int d4 = 0; d4 < 16; ++d4) { const f32x4 kv = *(const f32x4*)&Ks[kk * 64 + d4 * 4]; s += q[d4 * 4] * kv[0] + q[d4 * 4 + 1] * kv[1] + q[d4 * 4 + 2] * kv[2] + q[d4 * 4 + 3] * kv[3]; }
                if (s > m) {
                    const float al = exp2f(m - s); l *= al;
#pragma unroll
                    for (int e = 0; e < 128; ++e) o[e] *= al;
                    m = s;
                }
                const float pr = exp2f(s - m); l += pr;
#pragma unroll
                for (int e4 = 0; e4 < 32; ++e4) { const f32x4 vv = *(const f32x4*)&Vs[kk * 128 + e4 * 4]; o[e4 * 4] += pr * vv[0]; o[e4 * 4 + 1] += pr * vv[1]; o[e4 * 4 + 2] += pr * vv[2]; o[e4 * 4 + 3] += pr * vv[3]; }
            }
        }
        if (active) {
            const float inv = 1.f / l;
            float* op = O + (size_t)row * 2048 + hm * 128;
#pragma unroll
            for (int e4 = 0; e4 < 32; ++e4) *(f32x4*)(op + e4 * 4) = (f32x4){o[e4 * 4] * inv, o[e4 * 4 + 1] * inv, o[e4 * 4 + 2] * inv, o[e4 * 4 + 3] * inv};
        }
    }
}

__device__ __forceinline__ void phase_comb(const Params& p, int j, float lam_init, int row_lo) {
    const int lane = threadIdx.x & 63, wv = threadIdx.x >> 6;
    const float* O = (const float*)(p.ws + WS_O); bf16_t* A2 = (bf16_t*)(p.ws + WS_A2);
    const float* lp = p.in[9] + j * 256; const float* sub = p.in[10] + j * 128;
    const float sa = wave_sum(lp[lane] * lp[64 + lane]), sb = wave_sum(lp[128 + lane] * lp[192 + lane]);
    const float lam = expf(sa) - expf(sb) + lam_init;
    const float g0 = sub[lane * 2] * (1.f - lam_init), g1 = sub[lane * 2 + 1] * (1.f - lam_init);
    for (int row = row_lo + blockIdx.x * 8 + wv; row < R; row += gridDim.x * 8) {
#pragma unroll
        for (int h = 0; h < 8; ++h) {
            const float* o0 = O + (size_t)row * 2048 + h * 256 + lane * 2;
            const float d0 = o0[0] - lam * o0[128], d1 = o0[1] - lam * o0[129];
            const float ss = wave_sum(d0 * d0 + d1 * d1);
            const float rs = rsqrtf(ss * (1.f / 128.f) + 1e-5f);
            *(unsigned*)(A2 + (size_t)row * 1024 + h * 128 + lane * 2) = pk2(d0 * rs * g0, d1 * rs * g1);
        }
    }
}

__device__ __forceinline__ void phase_lnv(const Params& p) {
    const int lane = threadIdx.x & 63, wv = threadIdx.x >> 6;
    const float* VP = (const float*)(p.ws + WS_VP); bf16_t* VN = (bf16_t*)(p.ws + WS_VN);
    const float* lg = p.in[13]; const float* lb = p.in[14];
    for (int row = blockIdx.x * 8 + wv; row < R; row += gridDim.x * 8) {
        f32x4 x[4]; float s = 0.f;
#pragma unroll
        for (int j = 0; j < 4; ++j) { x[j] = *(const f32x4*)(VP + (size_t)row * 1024 + j * 256 + lane * 4); s += x[j][0] + x[j][1] + x[j][2] + x[j][3]; }
        const float mean = wave_sum(s) * (1.f / 1024.f);
        float q = 0.f;
#pragma unroll
        for (int j = 0; j < 4; ++j) { x[j] = x[j] - mean; q += x[j][0] * x[j][0] + x[j][1] * x[j][1] + x[j][2] * x[j][2] + x[j][3] * x[j][3]; }
        const float rs = rsqrtf(wave_sum(q) * (1.f / 1024.f) + 1e-5f);
#pragma unroll
        for (int j = 0; j < 4; ++j) {
            const int col = j * 256 + lane * 4;
            const f32x4 h = x[j] * rs * *(const f32x4*)(lg + col) + *(const f32x4*)(lb + col);
            u32x2 w = {pk2(h[0], h[1]), pk2(h[2], h[3])};
            *(u32x2*)(VN + (size_t)row * 1024 + col) = w;
        }
    }
}

__device__ __forceinline__ void phase_spat_naive(const Params& p, float* lds) {
    const bf16_t* VN = (const bf16_t*)(p.ws + WS_VN); const bf16_t* U = (const bf16_t*)(p.ws + WS_U); bf16_t* A2 = (bf16_t*)(p.ws + WS_A2);
    const float* ws_ = p.in[15]; const float* bs = p.in[16];
    float* Ws = lds; float* Vs = lds + 128 * 129;
    const int tid = threadIdx.x;
    for (int u = blockIdx.x; u < 130 * 8; u += gridDim.x) {
        const int c = u >> 3, g = u & 7;
        __syncthreads();
        for (int i = tid; i < 128 * 128; i += NTHR) { const int pp = i >> 7, qq = i & 127; Ws[pp * 129 + qq] = ws_[(size_t)g * 16384 + i]; }
        for (int i = tid; i < 128 * 16; i += NTHR) {
            const int qq = i >> 4, c8 = (i & 15) * 8;
            const u32x4 raw = *(const u32x4*)(VN + (size_t)(c * 128 + qq) * 1024 + g * 128 + c8);
#pragma unroll
            for (int e = 0; e < 4; ++e) { Vs[qq * 128 + c8 + 2 * e] = bf2f(raw[e] & 0xffffu); Vs[qq * 128 + c8 + 2 * e + 1] = bf2f(raw[e] >> 16); }
        }
        __syncthreads();
        const int pp = tid >> 2, k0 = (tid & 3) * 32;
        float acc[32];
#pragma unroll
        for (int e = 0; e < 32; ++e) acc[e] = 0.f;
        for (int qq = 0; qq < 128; ++qq) {
            const float w = Ws[pp * 129 + qq];
#pragma unroll
            for (int e4 = 0; e4 < 8; ++e4) { const f32x4 vv = *(const f32x4*)&Vs[qq * 128 + k0 + e4 * 4]; acc[e4 * 4] += w * vv[0]; acc[e4 * 4 + 1] += w * vv[1]; acc[e4 * 4 + 2] += w * vv[2]; acc[e4 * 4 + 3] += w * vv[3]; }
        }
        const float bias = bs[g * 128 + pp];
        const size_t off = (size_t)(c * 128 + pp) * 1024 + g * 128 + k0;
#pragma unroll
        for (int e8 = 0; e8 < 4; ++e8) {
            const u32x4 uu = *(const u32x4*)(U + off + e8 * 8);
            u32x4 w;
#pragma unroll
            for (int e = 0; e < 4; ++e) w[e] = pk2(bf2f(uu[e] & 0xffffu) * (acc[e8 * 8 + 2 * e] + bias), bf2f(uu[e] >> 16) * (acc[e8 * 8 + 2 * e + 1] + bias));
            *(u32x4*)(A2 + off + e8 * 8) = w;
        }
    }
}

__device__ __forceinline__ void phase_mix(const Params& p) {
    const int lane = threadIdx.x & 63, wv = threadIdx.x >> 6;
    const bf16_t* H = (const bf16_t*)(p.ws + WS_H); bf16_t* MX = (bf16_t*)(p.ws + WS_MIX);
    const float* mix = p.in[18];
    for (int row = blockIdx.x * 8 + wv; row < R; row += gridDim.x * 8) {
        const bool hp = (row != 0 && row != RC), hn = (row != RC - 1 && row != R - 1);
#pragma unroll
        for (int j = 0; j < 4; ++j) {
            const int col = j * 256 + lane * 4;
            const u32x2 c = *(const u32x2*)(H + (size_t)row * 1024 + col);
            u32x2 a = {0u, 0u}, b = {0u, 0u};
            if (hp) a = *(const u32x2*)(H + (size_t)(row - 1) * 1024 + col);
            if (hn) b = *(const u32x2*)(H + (size_t)(row + 1) * 1024 + col);
            float hc[4] = {bf2f(c[0] & 0xffffu), bf2f(c[0] >> 16), bf2f(c[1] & 0xffffu), bf2f(c[1] >> 16)};
            float ha[4] = {bf2f(a[0] & 0xffffu), bf2f(a[0] >> 16), bf2f(a[1] & 0xffffu), bf2f(a[1] >> 16)};
            float hb[4] = {bf2f(b[0] & 0xffffu), bf2f(b[0] >> 16), bf2f(b[1] & 0xffffu), bf2f(b[1] >> 16)};
            float ts[4];
#pragma unroll
            for (int e = 0; e < 4; ++e) ts[e] = 0.5f * (ha[e] + hb[e]) - hc[e];
#pragma unroll
            for (int q = 0; q < 6; ++q) {
                const f32x4 mq = *(const f32x4*)(mix + q * 1024 + col);
                u32x2 w = {pk2(hc[0] + ts[0] * mq[0], hc[1] + ts[1] * mq[1]), pk2(hc[2] + ts[2] * mq[2], hc[3] + ts[3] * mq[3])};
                *(u32x2*)(MX + ((size_t)q * R + row) * 1024 + col) = w;
            }
        }
    }
}

__device__ __forceinline__ void phase_kkn(const Params& p) {
    const int lane = threadIdx.x & 63, wv = threadIdx.x >> 6;
    const bf16_t* KK = (const bf16_t*)(p.ws + WS_KK); float* KN = (float*)(p.ws + WS_KN);
    const float* kk_ = p.in[28];
    for (int row = blockIdx.x * 8 + wv; row < R; row += gridDim.x * 8) {
        float ss = 0.f;
#pragma unroll
        for (int j = 0; j < 2; ++j) {
            const int col = lane * 16 + j * 8;
            const u32x4 raw = *(const u32x4*)(KK + (size_t)row * 1024 + col);
#pragma unroll
            for (int e = 0; e < 4; ++e) { const float a = bf2f(raw[e] & 0xffffu) * kk_[col + 2 * e], b = bf2f(raw[e] >> 16) * kk_[col + 2 * e + 1]; ss += a * a + b * b; }
        }
        ss += __shfl_xor(ss, 1); ss += __shfl_xor(ss, 2);
        if ((lane & 3) == 0) KN[(size_t)row * 16 + (lane >> 2)] = 1.f / fmaxf(sqrtf(ss), 1e-12f);
    }
}

template <int CTRL> __device__ __forceinline__ float dppmov(float v) { return __builtin_bit_cast(float, __builtin_amdgcn_update_dpp(0, __builtin_bit_cast(int, v), CTRL, 0xf, 0xf, true)); }
__device__ __forceinline__ float wave_sum_dpp(float v) {
    v += dppmov<0xB1>(v); v += dppmov<0x4E>(v); v += dppmov<0x141>(v); v += dppmov<0x140>(v);
    const int b = __builtin_bit_cast(int, v);
    return (__builtin_bit_cast(float, __builtin_amdgcn_readlane(b, 0)) + __builtin_bit_cast(float, __builtin_amdgcn_readlane(b, 16))) +
           (__builtin_bit_cast(float, __builtin_amdgcn_readlane(b, 32)) + __builtin_bit_cast(float, __builtin_amdgcn_readlane(b, 48)));
}

__device__ __forceinline__ int scan_row(int z, int n) { return z == 0 ? n : (n < RC ? RC - 1 - n : R + RC - 1 - n); }
__device__ __forceinline__ void phase_scan(const Params& p, float* lds) {
    const int tid = threadIdx.x, lane = tid & 63, wv = tid >> 6;
    const bf16_t* RRb = (const bf16_t*)(p.ws + WS_RR); const bf16_t* KKb = (const bf16_t*)(p.ws + WS_KK); const bf16_t* VVb = (const bf16_t*)(p.ws + WS_VV);
    const float* DEC = (const float*)(p.ws + WS_DEC); const bf16_t* AP = (const bf16_t*)(p.ws + WS_AP); const float* KN = (const float*)(p.ws + WS_KN);
    float* Y = (float*)(p.ws + WS_Y);
    const float* k_k = p.in[28]; const float* k_a = p.in[29];
    float* sw = lds; float* sa_ = lds + 2048; float* sb = lds + 4096; float* sk = lds + 6144; float* sr = lds + 8192; float* sv = lds + 10240; float* sy = lds + 10496;
    for (int u = blockIdx.x; u < 256; u += gridDim.x) {
        const int zh = u & 31, rg = u >> 5, z = zh >> 4, head = zh & 15;
        float S = 0.f;
        for (int n0 = 0; n0 < R; n0 += 32) {
            __syncthreads();
#pragma unroll
            for (int q = 0; q < 4; ++q) {
                const int idx = tid + NTHR * q, s = idx >> 6, j = idx & 63, row = scan_row(z, n0 + s), col = head * 64 + j;
                const float kraw = bf2f(KKb[(size_t)row * 1024 + col]), ap = bf2f(AP[((size_t)z * R + row) * 1024 + col]);
                const float kkv = kraw * k_k[col] * KN[(size_t)row * 16 + head];
                sw[idx] = DEC[((size_t)z * R + row) * 1024 + col]; sa_[idx] = -kkv; sb[idx] = kkv * ap; sk[idx] = kraw * (1.f + (ap - 1.f) * k_a[col]);
                sr[idx] = bf2f(RRb[(size_t)row * 1024 + col]);
            }
            if (tid < 256) { const int s = tid >> 3, i = tid & 7; sv[tid] = bf2f(VVb[(size_t)scan_row(z, n0 + s) * 1024 + head * 64 + rg * 8 + i]); }
            __syncthreads();
            for (int s = 0; s < 32; ++s) {
                const float w = sw[s * 64 + lane], a = sa_[s * 64 + lane], b = sb[s * 64 + lane], kd = sk[s * 64 + lane], r = sr[s * 64 + lane], vi = sv[s * 8 + wv];
                const float sa = wave_sum_dpp(S * a);
                S = S * w + sa * b + vi * kd;
                const float y = wave_sum_dpp(S * r);
                if (lane == 0) sy[s * 8 + wv] = y;
            }
            __syncthreads();
            if (tid < 256) { const int s = tid >> 3, i = tid & 7; Y[((size_t)z * R + scan_row(z, n0 + s)) * 1024 + head * 64 + rg * 8 + i] = sy[tid]; }
        }
    }
}

__device__ __forceinline__ void phase_rout(const Params& p) {
    const int lane = threadIdx.x & 63, wv = threadIdx.x >> 6;
    const float* Y = (const float*)(p.ws + WS_Y); const bf16_t* RRb = (const bf16_t*)(p.ws + WS_RR); const bf16_t* KKb = (const bf16_t*)(p.ws + WS_KK);
    const bf16_t* VVb = (const bf16_t*)(p.ws + WS_VV); const bf16_t* AP = (const bf16_t*)(p.ws + WS_AP); const bf16_t* G = (const bf16_t*)(p.ws + WS_G);
    bf16_t* A2 = (bf16_t*)(p.ws + WS_A2R);
    const float* k_a = p.in[29]; const float* r_k = p.in[30]; const float* lw = p.in[31]; const float* lb = p.in[32];
    for (int row = blockIdx.x * 8 + wv; row < R; row += gridDim.x * 8) {
        const int c0 = lane * 16;
        float y[16], r[16], k[16], v[16], a0[16], a1[16], g[16];
#pragma unroll
        for (int q = 0; q < 4; ++q) { const f32x4 ya = *(const f32x4*)(Y + (size_t)row * 1024 + c0 + q * 4), yb = *(const f32x4*)(Y + ((size_t)R + row) * 1024 + c0 + q * 4);
#pragma unroll
            for (int e = 0; e < 4; ++e) y[q * 4 + e] = ya[e] + yb[e]; }
#define LD16(dst, ptr) do { _Pragma("unroll") for (int q = 0; q < 2; ++q) { const u32x4 raw = *(const u32x4*)((ptr) + q * 8); _Pragma("unroll") for (int e = 0; e < 4; ++e) { dst[q * 8 + 2 * e] = bf2f(raw[e] & 0xffffu); dst[q * 8 + 2 * e + 1] = bf2f(raw[e] >> 16); } } } while (0)
        LD16(r, RRb + (size_t)row * 1024 + c0); LD16(k, KKb + (size_t)row * 1024 + c0); LD16(v, VVb + (size_t)row * 1024 + c0);
        LD16(a0, AP + (size_t)row * 1024 + c0); LD16(a1, AP + ((size_t)R + row) * 1024 + c0); LD16(g, G + (size_t)row * 1024 + c0);
#undef LD16
        float s = 0.f, bsum = 0.f;
#pragma unroll
        for (int e = 0; e < 16; ++e) {
            s += y[e];
            const float ka = k_a[c0 + e], kd0 = k[e] * (1.f + (a0[e] - 1.f) * ka), kd1 = k[e] * (1.f + (a1[e] - 1.f) * ka);
            bsum += r[e] * (kd0 + kd1) * r_k[c0 + e];
        }
        s += __shfl_xor(s, 1); s += __shfl_xor(s, 2); bsum += __shfl_xor(bsum, 1); bsum += __shfl_xor(bsum, 2);
        const float mean = s * (1.f / 64.f);
        float q2 = 0.f;
#pragma unroll
        for (int e = 0; e < 16; ++e) { y[e] -= mean; q2 += y[e] * y[e]; }
        q2 += __shfl_xor(q2, 1); q2 += __shfl_xor(q2, 2);
        const float rs = rsqrtf(q2 * (1.f / 64.f) + 64e-5f);
        unsigned w[8];
#pragma unroll
        for (int e = 0; e < 8; ++e) {
            const float o0 = (y[2 * e] * rs * lw[c0 + 2 * e] + lb[c0 + 2 * e] + bsum * v[2 * e]) * g[2 * e];
            const float o1 = (y[2 * e + 1] * rs * lw[c0 + 2 * e + 1] + lb[c0 + 2 * e + 1] + bsum * v[2 * e + 1]) * g[2 * e + 1];
            w[e] = pk2(o0, o1);
        }
        *(u32x4*)(A2 + (size_t)row * 1024 + c0) = (u32x4){w[0], w[1], w[2], w[3]};
        *(u32x4*)(A2 + (size_t)row * 1024 + c0 + 8) = (u32x4){w[4], w[5], w[6], w[7]};
    }
}

enum { PH_MOD, PH_NORM, PH_QKV, PH_ATT, PH_COMB, PH_OPROJ, PH_F1, PH_F2, PH_GI, PH_LNV, PH_SPAT, PH_GO, PH_M1, PH_M2, PH_MIX, PH_RKV, PH_L1, PH_L2, PH_KKN, PH_SCAN, PH_ROUT, PH_RO };
struct PhArgs { int a, b, c, d, e, f; };

template <int PH>
__global__ void __launch_bounds__(NTHR) kph(Params p, PhArgs x) {
    extern __shared__ __attribute__((aligned(16))) char smem[];
    float* lds = (float*)smem;
    float* XL = (float*)(p.ws + WS_XL); const bf16_t* H = (const bf16_t*)(p.ws + WS_H);
    const float* MOD = (const float*)(p.ws + WS_MOD);
    if constexpr (PH == PH_MOD) phase_mod(p, lds);
    else if constexpr (PH == PH_NORM) phase_norm(p, x.a, x.b, x.c, x.d, x.e, x.f);
    else if constexpr (PH == PH_QKV) gemm_naive(H, 1024, 0, R, 3072, 1024, BQKV{p.in[8] + (size_t)x.a * 1024 * 3072}, EpiQKV{(bf16_t*)(p.ws + WS_QKV), (const float*)(p.ws + WS_TAB), 0.125f * 1.4426950408889634f}, lds);
    else if constexpr (PH == PH_ATT) phase_attn_naive(p, x.a, lds);
    else if constexpr (PH == PH_COMB) phase_comb(p, x.a, __int_as_float(x.b), x.c);
    else if constexpr (PH == PH_OPROJ) gemm_naive((const bf16_t*)(p.ws + WS_A2), 1024, x.c, R - x.c, 1024, 1024, BPlain{p.in[11] + (size_t)x.a * 1024 * 1024, 1024}, EpiResid{XL, MOD + x.b * 2 * 6144, 2, nullptr, 0}, lds);
    else if constexpr (PH == PH_F1) gemm_naive(H, 1024, 0, R, 2 * FF, 1024, BGateUp{p.in[34] + (size_t)x.a * 1024 * FF, p.in[35] + (size_t)x.a * 1024 * FF, FF}, EpiGateUp{(bf16_t*)(p.ws + WS_ACT), FF}, lds);
    else if constexpr (PH == PH_F2) gemm_naive((const bf16_t*)(p.ws + WS_ACT), FF, 0, R, 1024, FF, BPlain{p.in[36] + (size_t)x.a * FF * 1024, 1024}, EpiResid{XL, MOD + x.b * 2 * 6144, 5, nullptr, 0}, lds);
    else if constexpr (PH == PH_GI) gemm_naive(H, 1024, 0, R, 2048, 1024, BPlain{p.in[12], 2048}, EpiGelu{(bf16_t*)(p.ws + WS_U), (float*)(p.ws + WS_VP)}, lds);
    else if constexpr (PH == PH_LNV) phase_lnv(p);
    else if constexpr (PH == PH_SPAT) phase_spat_naive(p, lds);
    else if constexpr (PH == PH_GO) gemm_naive((const bf16_t*)(p.ws + WS_A2), 1024, 0, R, 1024, 1024, BPlain{p.in[17], 1024}, EpiResid{XL, MOD + 1 * 2 * 6144, 2, nullptr, 0}, lds);
    else if constexpr (PH == PH_M1) { const size_t wo = ((size_t)x.a * 8 + x.b) * 1024 * FF; gemm_naive(H, 1024, x.c, R - x.c, 2 * FF, 1024, BGateUp{p.in[38] + wo, p.in[39] + wo, FF}, EpiGateUp{(bf16_t*)(p.ws + WS_ACT), FF}, lds); }
    else if constexpr (PH == PH_M2) { const size_t wo = ((size_t)x.a * 8 + x.b) * FF * 1024; gemm_naive((const bf16_t*)(p.ws + WS_ACT), FF, x.c, R - x.c, 1024, FF, BPlain{p.in[40] + wo, 1024}, EpiResid{XL, MOD + x.d * 2 * 6144, 5, (const int*)(p.ws + WS_ROUTE), x.b}, lds); }
    else if constexpr (PH == PH_MIX) phase_mix(p);
    else if constexpr (PH == PH_RKV) {
        const bf16_t* MX = (const bf16_t*)(p.ws + WS_MIX); const int mi = x.a == 0 ? 0 : (x.a == 1 ? 2 : 3);
        bf16_t* dst = (bf16_t*)(p.ws + (x.a == 0 ? WS_RR : (x.a == 1 ? WS_KK : WS_VV)));
        gemm_naive(MX + (size_t)mi * R * 1024, 1024, 0, R, 1024, 1024, BPlain{p.in[19] + (size_t)x.a * 1024 * 1024, 1024}, EpiStore{dst, 1024, 0}, lds);
    }
    else if constexpr (PH == PH_L1) {
        const bf16_t* MX = (const bf16_t*)(p.ws + WS_MIX);
        if (x.a == 0) gemm_naive(MX + (size_t)1 * R * 1024, 1024, 0, R, 128, 1024, BLora1{p.in[21]}, EpiStore{(bf16_t*)(p.ws + WS_L1W), 128, 1}, lds);
        else if (x.a == 1) gemm_naive(MX + (size_t)4 * R * 1024, 1024, 0, R, 128, 1024, BLora1{p.in[24]}, EpiStore{(bf16_t*)(p.ws + WS_L1A), 128, 0}, lds);
        else gemm_naive(MX + (size_t)5 * R * 1024, 1024, 0, R, 256, 1024, BG1{p.in[26]}, EpiStore{(bf16_t*)(p.ws + WS_L1G), 256, 2}, lds);
    }
    else if constexpr (PH == PH_L2) {
        if (x.a == 0) gemm_naive((const bf16_t*)(p.ws + WS_L1W), 128, 0, R, 2048, 128, BLora2{p.in[22]}, EpiDecay{(float*)(p.ws + WS_DEC), p.in[20]}, lds);
        else if (x.a == 1) gemm_naive((const bf16_t*)(p.ws + WS_L1A), 128, 0, R, 2048, 128, BLora2{p.in[25]}, EpiAP{(bf16_t*)(p.ws + WS_AP), p.in[23]}, lds);
        else gemm_naive((const bf16_t*)(p.ws + WS_L1G), 256, 0, R, 1024, 256, BG2{p.in[27]}, EpiStore{(bf16_t*)(p.ws + WS_G), 1024, 0}, lds);
    }
    else if constexpr (PH == PH_KKN) phase_kkn(p);
    else if constexpr (PH == PH_SCAN) phase_scan(p, lds);
    else if constexpr (PH == PH_ROUT) phase_rout(p);
    else if constexpr (PH == PH_RO) gemm_naive((const bf16_t*)(p.ws + WS_A2R), 1024, 0, R, 1024, 1024, BPlain{p.in[33], 1024}, EpiResid{XL, MOD + 2 * 2 * 6144, 2, nullptr, 0}, lds);
}

constexpr int LDS_BYTES = 136 * 1024;
template <int PH> void launch(const Params& p, hipStream_t s, int a = 0, int b = 0, int c = 0, int d = 0, int e = 0, int f = 0) {
    static bool attr = false;
    if (!attr) { (void)hipFuncSetAttribute((const void*)kph<PH>, hipFuncAttributeMaxDynamicSharedMemorySize, LDS_BYTES); attr = true; }
    PhArgs x{a, b, c, d, e, f};
    hipLaunchKernelGGL(kph<PH>, dim3(256), dim3(NTHR), LDS_BYTES, s, p, x);
}
inline int f2i(float f) { int i; memcpy(&i, &f, 4); return i; }
}

extern "C" void kernel_launch(void* const* d_in, const int* in_sizes, int n_in, void* d_out, int out_size, void* d_ws, size_t ws_size, hipStream_t stream) {
    Params p; memset(&p, 0, sizeof(p));
    for (int i = 0; i < 41; ++i) p.in[i] = (const float*)d_in[i];
    p.out = (float*)d_out; p.ws = (unsigned char*)d_ws;
    hipStream_t s = stream;
    launch<PH_MOD>(p, s);
    launch<PH_NORM>(p, s, 0, 0, 1, -1, 0, 0);
    launch<PH_QKV>(p, s, 0);
    launch<PH_ATT>(p, s, 1);
    launch<PH_COMB>(p, s, 0, f2i(0.2f), 0);
    launch<PH_OPROJ>(p, s, 0, 0, 0);
    launch<PH_NORM>(p, s, 0, 1, 0, -1, 0, 0);
    launch<PH_F1>(p, s, 0);
    launch<PH_F2>(p, s, 0, 0);
    launch<PH_NORM>(p, s, 1, 0, 0, -1, 0, 0);
    launch<PH_GI>(p, s);
    launch<PH_LNV>(p, s);
    launch<PH_SPAT>(p, s);
    launch<PH_GO>(p, s);
    launch<PH_NORM>(p, s, 1, 1, 0, 0, 0, 0);
    for (int e = 0; e < 8; ++e) { launch<PH_M1>(p, s, 0, e, 0); launch<PH_M2>(p, s, 0, e, 0, 1); }
    launch<PH_NORM>(p, s, 2, 0, 0, -1, 0, 0);
    launch<PH_MIX>(p, s);
    for (int q = 0; q < 3; ++q) launch<PH_RKV>(p, s, q);
    for (int q = 0; q < 3; ++q) launch<PH_L1>(p, s, q);
    for (int q = 0; q < 3; ++q) launch<PH_L2>(p, s, q);
    launch<PH_KKN>(p, s);
    launch<PH_SCAN>(p, s);
    launch<PH_ROUT>(p, s);
    launch<PH_RO>(p, s);
    launch<PH_NORM>(p, s, 2, 1, 0, -1, 0, 0);
    launch<PH_F1>(p, s, 1);
    launch<PH_F2>(p, s, 1, 2);
    launch<PH_NORM>(p, s, 3, 0, 0, -1, 0, 0);
    launch<PH_QKV>(p, s, 1);
    launch<PH_ATT>(p, s, 0);
    launch<PH_COMB>(p, s, 1, f2i(0.8f - 0.6f * expf(-0.9f)), RC);
    launch<PH_OPROJ>(p, s, 1, 3, RC);
    launch<PH_NORM>(p, s, 3, 1, 0, 1, RC, 0);
    for (int e = 0; e < 8; ++e) { launch<PH_M1>(p, s, 1, e, RC); launch<PH_M2>(p, s, 1, e, RC, 3); }
    launch<PH_NORM>(p, s, 0, 0, 0, -1, RC, 1);
}
```

```cpp
#include <hip/hip_runtime.h>
#include <stdint.h>
#include <math.h>
#include <string.h>

#ifndef FUSED
#define FUSED 1
#endif
namespace {
constexpr int D = 1024, RC = 256, RL = 16384, R = RC + RL, FF = 2816, NTHR = 512;
typedef unsigned short bf16_t;
typedef float f32x4 __attribute__((ext_vector_type(4)));
typedef unsigned u32x4 __attribute__((ext_vector_type(4)));
typedef unsigned u32x2 __attribute__((ext_vector_type(2)));

struct Params { const float* in[41]; float* out; unsigned char* ws; };

constexpr size_t MiB = 1u << 20;
constexpr size_t WS_MOD = 1 * MiB;
constexpr size_t WS_TAB = 2 * MiB;
constexpr size_t WS_ROUTE = 3 * MiB;
constexpr size_t WS_KN = 4 * MiB;
constexpr size_t WS_CTL = 0;
constexpr int CW_MOE = 8192;
constexpr size_t WS_RTG = WS_ROUTE + 512 * 1024;
constexpr size_t WS_SLOT = WS_ROUTE + 768 * 1024;
constexpr size_t WS_XL = 8 * MiB;
constexpr size_t WS_H = 73 * MiB;
constexpr size_t WS_S = 106 * MiB;
constexpr size_t WS_QKV = WS_S;
constexpr size_t WS_O = WS_S + 98 * MiB;
constexpr size_t WS_A2 = WS_S + 228 * MiB;
constexpr size_t WS_ACT = WS_S;
constexpr size_t WS_U = WS_S;
constexpr size_t WS_VP = WS_S + 33 * MiB;
constexpr size_t WS_VN = WS_S + 98 * MiB;
constexpr size_t WS_MIX = WS_S;
constexpr size_t WS_DEC = WS_S;
constexpr size_t WS_AP = WS_S + 130 * MiB;
constexpr size_t WS_RR = WS_S + 196 * MiB;
constexpr size_t WS_KK = WS_S + 229 * MiB;
constexpr size_t WS_VV = WS_S + 262 * MiB;
constexpr size_t WS_L1W = WS_S + 295 * MiB;
constexpr size_t WS_L1A = WS_S + 300 * MiB;
constexpr size_t WS_L1G = WS_S + 305 * MiB;
constexpr size_t WS_G = WS_S + 314 * MiB;
constexpr size_t WS_Y = WS_S + 347 * MiB;
constexpr size_t WS_A2R = WS_S + 478 * MiB;
constexpr size_t WS_HP = WS_S;
constexpr size_t WS_ACTM = WS_S + 69 * MiB;
constexpr size_t WS_YM = WS_S + 259 * MiB;
constexpr size_t WS_END = WS_S + 512 * MiB;
constexpr size_t WS_W = 620 * MiB;
constexpr size_t WS_WIN = WS_W;
constexpr size_t WS_WOUT = WS_W + 6 * MiB;
constexpr size_t WS_WF1 = WS_W + 8 * MiB;
constexpr size_t WS_WF2D = WS_W + 19 * MiB;
constexpr size_t WS_WF2M = WS_W + 96 * MiB;
constexpr size_t WS_WL = WS_W + 25 * MiB;
constexpr size_t WS_WEND = WS_W + 140 * MiB;


__device__ __forceinline__ int ptid() { int t = (int)__builtin_amdgcn_workitem_id_x(); asm volatile("" : "+v"(t)); return t; }
__device__ __forceinline__ float bf2f(unsigned b) { return __uint_as_float(b << 16); }
__device__ __forceinline__ unsigned f2bf(float f) { unsigned u = __float_as_uint(f); u += 0x7fffu + ((u >> 16) & 1u); return u >> 16; }
__device__ __forceinline__ unsigned pk2(float lo, float hi) { return f2bf(lo) | (f2bf(hi) << 16); }
__device__ __forceinline__ float wave_sum(float v) {
#pragma unroll
    for (int o = 32; o > 0; o >>= 1) v += __shfl_xor(v, o);
    return v;
}
__device__ __forceinline__ float sigmoidf_(float x) { return 1.f / (1.f + __expf(-x)); }
__device__ __forceinline__ float siluf_(float x) { return x / (1.f + __expf(-x)); }
__device__ __forceinline__ float geluf_(float v) {
    const float t = __builtin_amdgcn_rcpf(fabsf(v) * 0.2316418882f + 1.0f);
    float q = t * 0.5307027145f + (-0.7265760135f); q = q * t + 0.7107068705f; q = q * t + (-0.142248368f); q = q * t + 0.127414796f; q = q * t;
    const float e = __builtin_amdgcn_exp2f(v * v * (-0.72134752044f));
    const float m = v * (q * e);
    return v < 0.f ? m : v - m;
}

struct BPlain { const float* W; int ldb; __device__ __forceinline__ float operator()(int k, int n) const { return W[(size_t)k * ldb + n]; } };
struct BGateUp { const float* W1; const float* W3; int ldb; __device__ __forceinline__ float operator()(int k, int n) const { const uintptr_t a = (uintptr_t)W1, d = (uintptr_t)W3 - (uintptr_t)W1; return ((const float*)(a + (uintptr_t)(n & 1) * d))[(size_t)k * ldb + (n >> 1)]; } };
__device__ __forceinline__ int qk_orig_col(int n) { if (n >= 2048) return n; const int p = n & 63; return (n & ~63) + ((p >> 5) << 5) + ((p & 1) << 4) + ((p & 31) >> 1); }
struct BQKV { const float* W; __device__ __forceinline__ float operator()(int k, int n) const { return W[(size_t)k * 3072 + qk_orig_col(n)]; } };
struct BLora1 { const float* W;   __device__ __forceinline__ float operator()(int k, int n) const { return n < 128 ? W[(size_t)(n >> 6) * 65536 + (size_t)k * 64 + (n & 63)] : 0.f; } };
struct BLora2 { const float* W;   __device__ __forceinline__ float operator()(int k, int n) const { const int z = n >> 10; return ((k >> 6) == z) ? W[(size_t)z * 65536 + (size_t)(k & 63) * 1024 + (n & 1023)] : 0.f; } };
struct BG1 { const float* W;   __device__ __forceinline__ float operator()(int k, int n) const { return n < 160 ? W[(size_t)k * 160 + n] : 0.f; } };
struct BG2 { const float* W;   __device__ __forceinline__ float operator()(int k, int n) const { return k < 160 ? W[(size_t)k * 1024 + n] : 0.f; } };

struct EpiQKV {
    bf16_t* QKV; const float* tab; float qscale;
    __device__ __forceinline__ void operator()(int row, int col0, float (&v)[8]) const {
        if (col0 < 2048 && row >= RC) {
            const int t = row - RC, p0 = col0 & 63, pos = (p0 >> 5) ? (t & 63) : (t >> 6), i0 = (p0 & 31) >> 1;
#pragma unroll
            for (int j = 0; j < 4; ++j) { const float c = tab[(pos * 16 + i0 + j) * 2], s = tab[(pos * 16 + i0 + j) * 2 + 1], e = v[2 * j], o = v[2 * j + 1]; v[2 * j] = e * c - o * s; v[2 * j + 1] = o * c + e * s; }
        }
        if (col0 < 1024) {
#pragma unroll
            for (int j = 0; j < 8; ++j) v[j] *= qscale;
        }
        u32x4 w = {pk2(v[0], v[1]), pk2(v[2], v[3]), pk2(v[4], v[5]), pk2(v[6], v[7])};
        *(u32x4*)(QKV + (size_t)row * 3072 + col0) = w;
    }
};
struct EpiResid {
    float* XL; const float* modl; int which; const int* route; int expert;
    __device__ __forceinline__ void operator()(int row, int col0, float (&v)[8]) const {
        const float* m = modl + (row < RC ? 6144 : 0) + which * 1024 + col0;
        float gate = 1.f;
        if (route) { const int* rt = route + (size_t)row * 4; gate = (rt[0] == expert ? __int_as_float(rt[2]) : 0.f) + (rt[1] == expert ? __int_as_float(rt[3]) : 0.f); }
        float* x = XL + (size_t)row * 1024 + col0;
        f32x4 a = *(f32x4*)x, b = *(f32x4*)(x + 4);
        a[0] += m[0] * v[0] * gate; a[1] += m[1] * v[1] * gate; a[2] += m[2] * v[2] * gate; a[3] += m[3] * v[3] * gate;
        b[0] += m[4] * v[4] * gate; b[1] += m[5] * v[5] * gate; b[2] += m[6] * v[6] * gate; b[3] += m[7] * v[7] * gate;
        *(f32x4*)x = a; *(f32x4*)(x + 4) = b;
    }
};
struct EpiGateUp {
    bf16_t* ACT; int ld;
    __device__ __forceinline__ void operator()(int row, int col0, float (&v)[8]) const {
        float a[4];
#pragma unroll
        for (int j = 0; j < 4; ++j) a[j] = siluf_(v[2 * j]) * v[2 * j + 1];
        u32x2 w = {pk2(a[0], a[1]), pk2(a[2], a[3])};
        *(u32x2*)(ACT + (size_t)row * ld + (col0 >> 1)) = w;
    }
};
struct EpiGelu {
    bf16_t* U; float* VP;
    __device__ __forceinline__ void operator()(int row, int col0, float (&v)[8]) const {
#pragma unroll
        for (int j = 0; j < 8; ++j) v[j] = geluf_(v[j]);
        if (col0 < 1024) { u32x4 w = {pk2(v[0], v[1]), pk2(v[2], v[3]), pk2(v[4], v[5]), pk2(v[6], v[7])}; *(u32x4*)(U + (size_t)row * 1024 + col0) = w; }
        else { float* o = VP + (size_t)row * 1024 + (col0 - 1024); *(f32x4*)o = (f32x4){v[0], v[1], v[2], v[3]}; *(f32x4*)(o + 4) = (f32x4){v[4], v[5], v[6], v[7]}; }
    }
};
struct EpiStore {
    bf16_t* O; int ld; int act;
    __device__ __forceinline__ void operator()(int row, int col0, float (&v)[8]) const {
        if (col0 >= ld) return;
#pragma unroll
        for (int j = 0; j < 8; ++j) { if (act == 1) v[j] = tanhf(v[j]); else if (act == 2) v[j] = sigmoidf_(v[j]); }
        u32x4 w = {pk2(v[0], v[1]), pk2(v[2], v[3]), pk2(v[4], v[5]), pk2(v[6], v[7])};
        *(u32x4*)(O + (size_t)row * ld + col0) = w;
    }
};
struct EpiDecay {
    float* DEC; const float* w0;
    __device__ __forceinline__ void operator()(int row, int col0, float (&v)[8]) const {
        const int z = col0 >> 10, d0 = col0 & 1023;
        const f32x4 wa = *(const f32x4*)(w0 + z * 1024 + d0), wb = *(const f32x4*)(w0 + z * 1024 + d0 + 4);
        float* p = DEC + ((size_t)z * R + row) * 1024 + d0;
#pragma unroll
        for (int h = 0; h < 2; ++h) {
            f32x4 o;
#pragma unroll
            for (int j = 0; j < 4; ++j) { const float y = -((h ? wb[j] : wa[j]) + v[h * 4 + j]); const float t = __builtin_amdgcn_exp2f(-fabsf(y) * 1.4426950408889634f);
                const float sp = fmaxf(y, 0.f) + __builtin_amdgcn_logf(1.f + t) * 0.6931471805599453f; const float wl = -sp - 0.5f; o[j] = __builtin_amdgcn_exp2f(-1.4426950408889634f * __builtin_amdgcn_exp2f(wl * 1.4426950408889634f)); }
            *(f32x4*)(p + h * 4) = o;
            __builtin_amdgcn_sched_barrier(0);
        }
    }
};
struct EpiAP {
    bf16_t* AP; const float* a0;
    __device__ __forceinline__ void operator()(int row, int col0, float (&v)[8]) const {
        const int z = col0 >> 10, d0 = col0 & 1023;
        float o[8];
#pragma unroll
        for (int j = 0; j < 8; ++j) o[j] = sigmoidf_(a0[z * 1024 + d0 + j] + v[j]);
        u32x4 w = {pk2(o[0], o[1]), pk2(o[2], o[3]), pk2(o[4], o[5]), pk2(o[6], o[7])};
        *(u32x4*)(AP + ((size_t)z * R + row) * 1024 + d0) = w;
    }
};


namespace pg8 {
#define PG8_LAS __attribute__((address_space(3)))
typedef unsigned short bf16_t;
typedef short bf16x8 __attribute__((ext_vector_type(8)));
typedef float f32x4 __attribute__((ext_vector_type(4)));
typedef unsigned u32x4 __attribute__((ext_vector_type(4)));
constexpr int BM = 256, BK = 64, HALF = 128, HTB = HALF * BK * 2  , STAGE_BYTES = 8 * HTB, NXCD = 8, WGM = 8;

__host__ __device__ __forceinline__ int lds_byte(int r, int c) { const int st = (r >> 4) * 2 + (c >> 5), rr = r & 15, cc = c & 31, ob = rr * 64 + cc * 2; return st * 1024 + (ob ^ (((ob >> 9) & 1) << 5)); }
__host__ __device__ __forceinline__ void stage_rc(int b, int& R, int& C) { const int st = b / 1024, sb = b % 1024, swz = sb ^ (((sb >> 9) & 1) << 5); R = (st >> 1) * 16 + swz / 64; C = (st & 1) * 32 + (swz % 64) / 2; }
__host__ __device__ __forceinline__ int perm32(int rho) { const int n = rho >> 4, i = rho & 15; return 8 * (i >> 2) + 4 * n + (i & 3); }

struct Unit { int pm, pn; };
struct Gemm { const bf16_t* A; const bf16_t* Bt; int M, N, K; };

struct StaticOrder {
    int nM, nN, nwg, G, c;
    __host__ __device__ void init(int M, int N, int G_, int c_) { nM = M / BM; nN = N / BM; nwg = nM * nN; G = G_; c = c_; }
    __host__ __device__ bool next(int i, Unit& u) const {
        const long L = (long)i * G + c; if (L >= nwg) return false;
        int wgid = (int)L; { const int q = nwg / NXCD, r = nwg % NXCD, xcd = wgid % NXCD, off = wgid / NXCD; wgid = (xcd < r ? xcd * (q + 1) : r * (q + 1) + (xcd - r) * q) + off; }
        const int nig = WGM * nN, gid = wgid / nig, fm = gid * WGM, gsz = (nM - fm) < WGM ? (nM - fm) : WGM;
        u.pm = fm + ((wgid % nig) % gsz); u.pn = (wgid % nig) / gsz; return true;
    }
    __device__ __forceinline__ void a_ready(const Unit&) const {}
    __device__ __forceinline__ void done(const Unit&) const {}
};

__device__ __forceinline__ unsigned cvt_pk_bf16(float lo, float hi) { unsigned r; asm volatile("v_cvt_pk_bf16_f32 %0, %1, %2" : "=v"(r) : "v"(lo), "v"(hi)); return r; }

template <class Epi, class Sched, bool ALIGN_EPI = false, bool SP2 = false>
__device__ __forceinline__ void gemm_phase(PG8_LAS unsigned char* lds, const Gemm g, const Sched& S, const Epi& E) {
    const int tid = ptid(), wid = __builtin_amdgcn_readfirstlane(tid >> 6), lane = tid & 63, wr = wid >> 2, wc = wid & 3, fr = lane & 15, fq = lane >> 4;
    const int K = g.K, nt = K / BK;
    unsigned voffA[2], voffB[2];
#pragma unroll
    for (int i = 0; i < 2; ++i) { int R, C; stage_rc(tid * 16 + i * 8192, R, C); const int Rb = Epi::PERM ? ((R & ~31) + perm32(R & 31)) : R;
        voffA[i] = (unsigned)(R * K + C) * 2u; voffB[i] = (unsigned)(Rb * K + C) * 2u; }
    const size_t kstep = (size_t)(BK * 2);
    const size_t hstep = (size_t)HALF * K * 2;
    const size_t tstep = 2 * hstep;
    const unsigned ldsw = (unsigned)wid * 1024u;
    const int aoff = lds_byte(wr * 64 + fr, fq * 8), boff = lds_byte(wc * 32 + fr, fq * 8);
#define PG8_SA(b, h) (((b) * 2 + (h)) * HTB)
#define PG8_SB(b, h) ((4 + (b) * 2 + (h)) * HTB)
#define PG8_STAGE(bufoff, gbase, voff) do { _Pragma("unroll") for (int _i = 0; _i < 2; ++_i) \
        __builtin_amdgcn_global_load_lds((const unsigned*)((const char*)(gbase) + (voff)[_i]), (PG8_LAS unsigned*)(lds + (bufoff) + ldsw + _i * 8192), 16, 0, 0); } while (0)
#define PG8_LDA(dst, b, h) do { _Pragma("unroll") for (int m = 0; m < 4; ++m) _Pragma("unroll") for (int k = 0; k < 2; ++k) dst[m][k] = *(const PG8_LAS bf16x8*)(lds + PG8_SA(b, h) + aoff + m * 2048 + k * 1024); } while (0)
#define PG8_LDB(dst, b, h) do { _Pragma("unroll") for (int n = 0; n < 2; ++n) _Pragma("unroll") for (int k = 0; k < 2; ++k) dst[n][k] = *(const PG8_LAS bf16x8*)(lds + PG8_SB(b, h) + boff + n * 2048 + k * 1024); } while (0)
#define PG8_MMA(ai, bj, At, Bt) do { __builtin_amdgcn_s_setprio(1); _Pragma("unroll") for (int m = 0; m < 4; ++m) _Pragma("unroll") for (int n = 0; n < 2; ++n) _Pragma("unroll") for (int k = 0; k < 2; ++k) \
        acc[ai][bj][m][n] = __builtin_amdgcn_mfma_f32_16x16x32_bf16(Bt[n][k], At[m][k], acc[ai][bj][m][n], 0, 0, 0); __builtin_amdgcn_s_setprio(0); } while (0)
#define PG8_WAIT_V(n) asm volatile("s_waitcnt vmcnt(" #n ")" ::: "memory")
#define PG8_WAIT_L(n) asm volatile("s_waitcnt lgkmcnt(" #n ")" ::: "memory")
#define PG8_BAR __builtin_amdgcn_s_barrier()
#define PG8_SCHED __builtin_amdgcn_sched_barrier(0)
    Unit cur, nxt; int ui = 0;
    if (!S.next(0, cur)) return;
    f32x4 acc[2][2][4][2];
#pragma unroll
    for (int a = 0; a < 2; ++a)
#pragma unroll
        for (int b = 0; b < 2; ++b)
#pragma unroll
            for (int m = 0; m < 4; ++m)
#pragma unroll
                for (int n = 0; n < 2; ++n) acc[a][b][m][n] = (f32x4){0.f, 0.f, 0.f, 0.f};
    bf16x8 At[4][2], B0[2][2], B1[2][2];
    const char* cA = (const char*)g.A + (size_t)cur.pm * tstep; const char* cB = (const char*)g.Bt + (size_t)cur.pn * tstep;
    S.a_ready(cur);
    if constexpr (SP2) {
        PG8_STAGE(PG8_SB(0, 0), cB, voffB); PG8_STAGE(PG8_SB(0, 1), cB + hstep, voffB); PG8_STAGE(PG8_SA(0, 0), cA, voffA); PG8_STAGE(PG8_SA(0, 1), cA + hstep, voffA);
        if (wr == 1) PG8_BAR;
        PG8_WAIT_V(2); PG8_BAR;
        PG8_STAGE(PG8_SB(1, 0), cB + kstep, voffB); PG8_STAGE(PG8_SA(1, 0), cA + kstep, voffA); PG8_STAGE(PG8_SB(1, 1), cB + hstep + kstep, voffB);
        PG8_WAIT_V(6); PG8_BAR;
    } else {
        PG8_STAGE(PG8_SB(0, 0), cB, voffB); PG8_STAGE(PG8_SA(0, 0), cA, voffA); PG8_STAGE(PG8_SB(0, 1), cB + hstep, voffB); PG8_STAGE(PG8_SA(0, 1), cA + hstep, voffA);
        if (wr == 1) PG8_BAR;
        PG8_WAIT_V(4); PG8_BAR;
        PG8_STAGE(PG8_SB(1, 0), cB + kstep, voffB); PG8_STAGE(PG8_SA(1, 0), cA + kstep, voffA); PG8_STAGE(PG8_SB(1, 1), cB + hstep + kstep, voffB);
        PG8_WAIT_V(6); PG8_BAR;
    }
    for (;;) {
        const bool has_next = S.next(ui + 1, nxt);
        const char* nA = has_next ? (const char*)g.A + (size_t)nxt.pm * tstep : cA; const char* nB = has_next ? (const char*)g.Bt + (size_t)nxt.pn * tstep : cB;
        for (int t = 0; t < nt; t += 2) {
            const bool last = (t == nt - 2);
            const char* a1 = cA + (size_t)(t + 1) * kstep;
            const char* a2 = last ? nA : cA + (size_t)(t + 2) * kstep; const char* b2 = last ? nB : cB + (size_t)(t + 2) * kstep;
            const char* a3 = a2 + kstep; const char* b3 = b2 + kstep;
            if (last && has_next) S.a_ready(nxt);
            if constexpr (SP2) {
            PG8_LDB(B0, 0, 0); PG8_LDB(B1, 0, 1); PG8_SCHED; PG8_LDA(At, 0, 0); PG8_STAGE(PG8_SA(1, 1), a1 + hstep, voffA);
            PG8_WAIT_V(8); PG8_WAIT_L(0); PG8_BAR; PG8_MMA(0, 0, At, B0); PG8_MMA(0, 1, At, B1); PG8_BAR; PG8_SCHED;
            PG8_LDA(At, 0, 1); PG8_STAGE(PG8_SB(0, 0), b2, voffB); PG8_STAGE(PG8_SB(0, 1), b2 + hstep, voffB); PG8_STAGE(PG8_SA(0, 0), a2, voffA);
            PG8_WAIT_V(8); PG8_WAIT_L(0); PG8_BAR; PG8_MMA(1, 0, At, B0); PG8_MMA(1, 1, At, B1); PG8_BAR; PG8_SCHED;
            PG8_LDB(B0, 1, 0); PG8_LDB(B1, 1, 1); PG8_SCHED; PG8_LDA(At, 1, 0); PG8_STAGE(PG8_SA(0, 1), a2 + hstep, voffA);
            PG8_WAIT_V(8); PG8_WAIT_L(0); PG8_BAR; PG8_MMA(0, 0, At, B0); PG8_MMA(0, 1, At, B1); PG8_BAR; PG8_SCHED;
            PG8_LDA(At, 1, 1); PG8_STAGE(PG8_SB(1, 0), b3, voffB); PG8_STAGE(PG8_SB(1, 1), b3 + hstep, voffB); PG8_STAGE(PG8_SA(1, 0), a3, voffA);
            PG8_WAIT_V(8); PG8_WAIT_L(0); PG8_BAR; PG8_MMA(1, 0, At, B0); PG8_MMA(1, 1, At, B1); PG8_BAR; PG8_SCHED;
            } else {
            PG8_LDB(B0, 0, 0); PG8_SCHED; PG8_LDA(At, 0, 0); PG8_STAGE(PG8_SA(1, 1), a1 + hstep, voffA);
            PG8_WAIT_L(8); PG8_BAR; PG8_WAIT_L(0); PG8_MMA(0, 0, At, B0); PG8_BAR; PG8_SCHED;
            PG8_LDB(B1, 0, 1); PG8_STAGE(PG8_SB(0, 0), b2, voffB);
            PG8_BAR; PG8_WAIT_L(0); PG8_MMA(0, 1, At, B1); PG8_BAR;
            PG8_LDA(At, 0, 1); PG8_STAGE(PG8_SA(0, 0), a2, voffA);
            PG8_BAR; PG8_WAIT_L(0); PG8_MMA(1, 0, At, B0); PG8_BAR; PG8_SCHED;
            PG8_STAGE(PG8_SB(0, 1), b2 + hstep, voffB);
            PG8_WAIT_V(6); PG8_BAR; PG8_MMA(1, 1, At, B1); PG8_BAR;
            PG8_LDB(B0, 1, 0); PG8_SCHED; PG8_LDA(At, 1, 0); PG8_STAGE(PG8_SA(0, 1), a2 + hstep, voffA);
            PG8_WAIT_L(8); PG8_BAR; PG8_WAIT_L(0); PG8_MMA(0, 0, At, B0); PG8_BAR; PG8_SCHED;
            PG8_LDB(B1, 1, 1); PG8_STAGE(PG8_SB(1, 0), b3, voffB);
            PG8_BAR; PG8_WAIT_L(0); PG8_MMA(0, 1, At, B1); PG8_BAR;
            PG8_LDA(At, 1, 1); PG8_STAGE(PG8_SA(1, 0), a3, voffA);
            PG8_BAR; PG8_WAIT_L(0); PG8_MMA(1, 0, At, B0); PG8_BAR; PG8_SCHED;
            PG8_STAGE(PG8_SB(1, 1), b3 + hstep, voffB);
            PG8_WAIT_V(6); PG8_BAR; PG8_MMA(1, 1, At, B1); PG8_BAR;
            }
        }
        if constexpr (ALIGN_EPI) { if (wr == 0) PG8_BAR; }
        if constexpr (!Epi::AFTER_DRAIN) { E(acc, cur, wr, wc, fr, fq); S.done(cur); }
        if (!has_next) break;
#pragma unroll
        for (int a = 0; a < 2; ++a)
#pragma unroll
            for (int b = 0; b < 2; ++b)
#pragma unroll
                for (int m = 0; m < 4; ++m)
#pragma unroll
                    for (int n = 0; n < 2; ++n) acc[a][b][m][n] = (f32x4){0.f, 0.f, 0.f, 0.f};
        cur = nxt; cA = nA; cB = nB; ++ui;
        if constexpr (ALIGN_EPI) { if (wr == 1) PG8_BAR; }
    }
    PG8_WAIT_V(0);
    if constexpr (!ALIGN_EPI) { if (wr == 0) PG8_BAR; }
    PG8_BAR;
    if constexpr (Epi::AFTER_DRAIN) { E.fused(acc, cur, wr, wc, fr, fq, lds, wid, lane); S.done(cur); }
#undef PG8_SA
#undef PG8_SB
#undef PG8_STAGE
#undef PG8_LDA
#undef PG8_LDB
#undef PG8_MMA
#undef PG8_WAIT_V
#undef PG8_WAIT_L
#undef PG8_BAR
#undef PG8_SCHED
}
}


template <class E> struct EpiA {
    static constexpr bool PERM = true, AFTER_DRAIN = false;
    E e; int row0;
    __device__ __forceinline__ void operator()(const pg8::f32x4 (&acc)[2][2][4][2], const pg8::Unit& u, int wr, int wc, int fr, int fq) const {
#pragma unroll
        for (int ai = 0; ai < 2; ++ai)
#pragma unroll
            for (int m = 0; m < 4; ++m)
#pragma unroll
                for (int bj = 0; bj < 2; ++bj) {
                    float v[8] = {acc[ai][bj][m][0][0], acc[ai][bj][m][0][1], acc[ai][bj][m][0][2], acc[ai][bj][m][0][3], acc[ai][bj][m][1][0], acc[ai][bj][m][1][1], acc[ai][bj][m][1][2], acc[ai][bj][m][1][3]};
                    e(row0 + u.pm * 256 + ai * 128 + wr * 64 + m * 16 + fr, u.pn * 256 + bj * 128 + wc * 32 + 8 * fq, v);
                    __builtin_amdgcn_sched_barrier(0);
                }
    }
};
template <class E>
__device__ __forceinline__ void gemm_fast(char* lds, const bf16_t* A, int row0, int M, int K, const bf16_t* Bt, int N, const E& e) {
    asm volatile("" : "+s"(K));
    pg8::Gemm g{A + (size_t)row0 * K, Bt, M, N, K}; pg8::StaticOrder S; S.init(M, N, (int)gridDim.x, (int)blockIdx.x);
    EpiA<E> ea{e, row0};
    pg8::gemm_phase<EpiA<E>, pg8::StaticOrder, true, true>((PG8_LAS unsigned char*)lds, g, S, ea);
}
template <class BMap>
__device__ __forceinline__ void conv_w(const BMap B, bf16_t* Bt, int N, int K, float* lds) {
    const int tid = ptid(), nTk = K / 64, nT = (N / 64) * nTk;
    for (int t = blockIdx.x; t < nT; t += gridDim.x) {
        const int n0 = (t / nTk) * 64, k0 = (t % nTk) * 64;
        __syncthreads();
#pragma unroll
        for (int i = 0; i < 8; ++i) { const int k = (tid >> 6) + 8 * i, n = tid & 63; lds[k * 65 + n] = B(k0 + k, n0 + n); }
        __syncthreads();
        const int nl = tid >> 3, k8 = (tid & 7) * 8;
        u32x4 w = {pk2(lds[(k8 + 0) * 65 + nl], lds[(k8 + 1) * 65 + nl]), pk2(lds[(k8 + 2) * 65 + nl], lds[(k8 + 3) * 65 + nl]),
                   pk2(lds[(k8 + 4) * 65 + nl], lds[(k8 + 5) * 65 + nl]), pk2(lds[(k8 + 6) * 65 + nl], lds[(k8 + 7) * 65 + nl])};
        *(u32x4*)(Bt + (size_t)(n0 + nl) * K + k0 + k8) = w;
    }
}

template <class BMap, class Epi>
__device__ __forceinline__ void gemm_naive(const bf16_t* __restrict__ A, int lda, int row0, int M, int N, int K, const BMap B, const Epi E, float* lds) {
    float* As = lds; float* Bs = lds + 16 * 132;
    const int tid = ptid(), tr = tid >> 4, tc = tid & 15;
    const int nN = N / 128, nU = (M / 128) * nN;
    for (int u = blockIdx.x; u < nU; u += gridDim.x) {
        const int tm = u / nN, tn = u % nN;
        float acc[4][8];
#pragma unroll
        for (int i = 0; i < 4; ++i)
#pragma unroll
            for (int j = 0; j < 8; ++j) acc[i][j] = 0.f;
        for (int k0 = 0; k0 < K; k0 += 16) {
            {
                const int r = tid >> 2, kq = (tid & 3) * 4;
                const u32x2 raw = *(const u32x2*)(A + (size_t)(row0 + tm * 128 + r) * lda + k0 + kq);
                As[(kq + 0) * 132 + r] = bf2f(raw[0] & 0xffffu); As[(kq + 1) * 132 + r] = bf2f(raw[0] >> 16);
                As[(kq + 2) * 132 + r] = bf2f(raw[1] & 0xffffu); As[(kq + 3) * 132 + r] = bf2f(raw[1] >> 16);
                const int kk = tid >> 5, n4 = (tid & 31) * 4;
#pragma unroll
                for (int i = 0; i < 4; ++i) Bs[kk * 132 + n4 + i] = B(k0 + kk, tn * 128 + n4 + i);
            }
            __syncthreads();
#pragma unroll
            for (int kk = 0; kk < 16; ++kk) {
                const f32x4 a = *(const f32x4*)&As[kk * 132 + tr * 4];
                const f32x4 b0 = *(const f32x4*)&Bs[kk * 132 + tc * 8], b1 = *(const f32x4*)&Bs[kk * 132 + tc * 8 + 4];
#pragma unroll
                for (int i = 0; i < 4; ++i) {
                    acc[i][0] += a[i] * b0[0]; acc[i][1] += a[i] * b0[1]; acc[i][2] += a[i] * b0[2]; acc[i][3] += a[i] * b0[3];
                    acc[i][4] += a[i] * b1[0]; acc[i][5] += a[i] * b1[1]; acc[i][6] += a[i] * b1[2]; acc[i][7] += a[i] * b1[3];
                }
            }
            __syncthreads();
        }
#pragma unroll
        for (int i = 0; i < 4; ++i) { E(row0 + tm * 128 + tr * 4 + i, tn * 128 + tc * 8, acc[i]); __builtin_amdgcn_sched_barrier(0); }
    }
}

__device__ __forceinline__ void phase_mod(const Params& p, float* lds) {
    const int tid = ptid(), lane = tid & 63, wv = tid >> 6;
    float* MOD = (float*)(p.ws + WS_MOD);
    const float* c = p.in[1]; const float* cc = p.in[3]; const float* mw = p.in[5]; const float* mb = p.in[6];
    for (int item = blockIdx.x; item < 4 * 96; item += gridDim.x) {
        const int i = item / 96, n = (item % 96) * 64 + lane;
        float sl = 0.f, sc = 0.f;
        for (int k = wv * 128; k < wv * 128 + 128; ++k) { const float w = mw[((size_t)i * 1024 + k) * 6144 + n]; sl += siluf_(c[k]) * w; sc += siluf_(cc[k]) * w; }
        lds[wv * 64 + lane] = sl; lds[512 + wv * 64 + lane] = sc;
        __syncthreads();
        if (wv == 0) {
            float a = 0.f, b = 0.f;
#pragma unroll
            for (int w = 0; w < 8; ++w) { a += lds[w * 64 + lane]; b += lds[512 + w * 64 + lane]; }
            const float bias = mb[i * 6144 + n];
            MOD[(i * 2 + 0) * 6144 + n] = a + bias; MOD[(i * 2 + 1) * 6144 + n] = b + bias;
        }
        __syncthreads();
    }
    float* tab = (float*)(p.ws + WS_TAB);
    for (int idx = blockIdx.x * NTHR + tid; idx < 256 * 16; idx += gridDim.x * NTHR) {
        const int pos = idx >> 4, f = idx & 15;
        const float inv = (float)pow(10000.0, -(double)f / 16.0);
        const float ang = (float)pos * inv;
        tab[idx * 2] = (float)cos((double)ang); tab[idx * 2 + 1] = (float)sin((double)ang);
    }
}

__device__ __forceinline__ void phase_norm(const Params& p, int layer, int which, int init, int route_j, int row_lo, int final_out, int comb_layer, char* smem) {
    const int tid = ptid(), lane = tid & 63, wv = tid >> 6;
    int* li = (int*)smem; float* lf = (float*)(smem + 4096);
    float* XL = (float*)(p.ws + WS_XL); bf16_t* H = (bf16_t*)(p.ws + WS_H);
    const float* g = final_out ? p.in[7] : p.in[4] + (layer * 2 + which) * 1024;
    const float* modb = (const float*)(p.ws + WS_MOD) + layer * 2 * 6144;
    const int nrows = (R - row_lo + (int)gridDim.x - 1) / (int)gridDim.x, rbase = row_lo + (int)blockIdx.x * nrows, rend = (rbase + nrows < R) ? rbase + nrows : R;
    if (route_j >= 0) { if (tid < 8) li[tid] = 0; __syncthreads(); }
    for (int row = rbase + wv; row < rend; row += 8) {
        const bool isc = row < RC;
        const float* m = modb + (isc ? 6144 : 0);
        const float* shift = m + (which ? 3 : 0) * 1024; const float* scale = m + (which ? 4 : 1) * 1024;
        f32x4 x[4]; float ss = 0.f;
        int s0 = 0, s1 = 0; float cg0 = 0.f, cg1 = 0.f; const float* cm = nullptr;
        if (comb_layer >= 0) {
            const int* sl = (const int*)(p.ws + WS_SLOT) + (size_t)row * 2; const float* gg = (const float*)(p.ws + WS_RTG) + (size_t)row * 2;
            s0 = sl[0]; s1 = sl[1]; cg0 = gg[0]; cg1 = gg[1];
            cm = (const float*)(p.ws + WS_MOD) + comb_layer * 2 * 6144 + (isc ? 6144 : 0) + 5 * 1024;
        }
#pragma unroll
        for (int j = 0; j < 4; ++j) {
            const int col = j * 256 + lane * 4;
            if (init) { const float* src = isc ? p.in[2] + (size_t)row * 1024 : p.in[0] + (size_t)(row - RC) * 1024; x[j] = *(const f32x4*)(src + col); *(f32x4*)(XL + (size_t)row * 1024 + col) = x[j]; }
            else x[j] = *(const f32x4*)(XL + (size_t)row * 1024 + col);
            if (comb_layer >= 0) {
                const bf16_t* Y = (const bf16_t*)(p.ws + WS_YM);
                const u32x2 a = *(const u32x2*)(Y + (size_t)s0 * 1024 + col), b = *(const u32x2*)(Y + (size_t)s1 * 1024 + col);
                const f32x4 mm = *(const f32x4*)(cm + col);
                x[j][0] += mm[0] * (cg0 * bf2f(a[0] & 0xffffu) + cg1 * bf2f(b[0] & 0xffffu)); x[j][1] += mm[1] * (cg0 * bf2f(a[0] >> 16) + cg1 * bf2f(b[0] >> 16));
                x[j][2] += mm[2] * (cg0 * bf2f(a[1] & 0xffffu) + cg1 * bf2f(b[1] & 0xffffu)); x[j][3] += mm[3] * (cg0 * bf2f(a[1] >> 16) + cg1 * bf2f(b[1] >> 16));
                if (!final_out) *(f32x4*)(XL + (size_t)row * 1024 + col) = x[j];
            }
            ss += x[j][0] * x[j][0] + x[j][1] * x[j][1] + x[j][2] * x[j][2] + x[j][3] * x[j][3];
        }
        ss = wave_sum(ss);
        const float rs = rsqrtf(ss * (1.f / 1024.f) + 1e-6f);
        float lg[8];
#pragma unroll
        for (int e = 0; e < 8; ++e) lg[e] = 0.f;
#pragma unroll
        for (int j = 0; j < 4; ++j) {
            const int col = j * 256 + lane * 4;
            const f32x4 gg = *(const f32x4*)(g + col);
            f32x4 h;
            if (final_out) { h = x[j] * rs * gg; *(f32x4*)(p.out + (size_t)(row - RC) * 1024 + col) = h; }
            else {
                const f32x4 sc = *(const f32x4*)(scale + col), sh = *(const f32x4*)(shift + col);
                h = x[j] * rs * gg * (1.f + sc) + sh;
                u32x2 w = {pk2(h[0], h[1]), pk2(h[2], h[3])};
                *(u32x2*)(H + (size_t)row * 1024 + col) = w;
                if (route_j >= 0) {
                    const float* rt = p.in[37] + (size_t)route_j * 8192 + (size_t)col * 8;
#pragma unroll
                    for (int q = 0; q < 4; ++q)
#pragma unroll
                        for (int e = 0; e < 8; ++e) lg[e] += h[q] * rt[q * 8 + e];
                }
            }
        }
        if (route_j >= 0 && !final_out) {
#pragma unroll
            for (int e = 0; e < 8; ++e) lg[e] = wave_sum(lg[e]);
            if (lane == 0) {
                int i0 = 0; float v0 = lg[0];
#pragma unroll
                for (int e = 1; e < 8; ++e) if (lg[e] > v0) { v0 = lg[e]; i0 = e; }
                int i1 = -1; float v1 = -3.0e38f;
#pragma unroll
                for (int e = 0; e < 8; ++e) if (e != i0 && lg[e] > v1) { v1 = lg[e]; i1 = e; }
                const float e1 = expf(v1 - v0), g0 = 1.f / (1.f + e1), g1 = e1 / (1.f + e1);
                const int i = row - rbase;
                li[16 + 4 * i] = i0; li[17 + 4 * i] = i1; li[18 + 4 * i] = atomicAdd(&li[i0], 1); li[19 + 4 * i] = atomicAdd(&li[i1], 1);
                lf[2 * i] = g0; lf[2 * i + 1] = g1;
            }
        }
    }
    if (route_j >= 0) {
        unsigned* gcnt = (unsigned*)(p.ws + WS_CTL) + CW_MOE + route_j * 256;
        __syncthreads();
        if (tid < 8) li[8 + tid] = (int)atomicAdd(gcnt + tid * 16, (unsigned)li[tid]);
        __syncthreads();
        for (int i = tid; i < rend - rbase; i += NTHR) {
            const int e0 = li[16 + 4 * i], e1 = li[17 + 4 * i];
            int* ro = (int*)(p.ws + WS_ROUTE) + (size_t)(rbase + i) * 4;
            ro[0] = e0; ro[1] = e1; ro[2] = li[8 + e0] + li[18 + 4 * i]; ro[3] = li[8 + e1] + li[19 + 4 * i];
            float* go = (float*)(p.ws + WS_RTG) + (size_t)(rbase + i) * 2; go[0] = lf[2 * i]; go[1] = lf[2 * i + 1];
        }
    }
}

__device__ __forceinline__ void moe_bases(const Params& p, int j, int (&base)[9]) {
    const unsigned* gcnt = (const unsigned*)(p.ws + WS_CTL) + CW_MOE + j * 256;
    base[0] = 0;
#pragma unroll
    for (int e = 0; e < 8; ++e) base[e + 1] = base[e] + (int)((__hip_atomic_load(gcnt + e * 16, __ATOMIC_RELAXED, __HIP_MEMORY_SCOPE_AGENT) + 255u) & ~255u);
}
__device__ __forceinline__ void phase_perm(const Params& p, int j, int row_lo, char* smem) {
    const int tid = ptid(), lane = tid & 63, wv = tid >> 6;
    int* lb = (int*)smem;
    { int base[9]; moe_bases(p, j, base); if (tid == 0) {
#pragma unroll
        for (int e = 0; e < 9; ++e) lb[e] = base[e]; } }
    __syncthreads();
    const bf16_t* H = (const bf16_t*)(p.ws + WS_H); bf16_t* HP = (bf16_t*)(p.ws + WS_HP);
    for (int row = row_lo + blockIdx.x * 8 + wv; row < R; row += gridDim.x * 8) {
        const int* ro = (const int*)(p.ws + WS_ROUTE) + (size_t)row * 4;
        const int s0 = lb[ro[0]] + ro[2], s1 = lb[ro[1]] + ro[3];
        const u32x4 a = *(const u32x4*)(H + (size_t)row * 1024 + lane * 8), b = *(const u32x4*)(H + (size_t)row * 1024 + 512 + lane * 8);
        *(u32x4*)(HP + (size_t)s0 * 1024 + lane * 8) = a; *(u32x4*)(HP + (size_t)s0 * 1024 + 512 + lane * 8) = b;
        *(u32x4*)(HP + (size_t)s1 * 1024 + lane * 8) = a; *(u32x4*)(HP + (size_t)s1 * 1024 + 512 + lane * 8) = b;
        if (lane == 0) { int* sl = (int*)(p.ws + WS_SLOT) + (size_t)row * 2; sl[0] = s0; sl[1] = s1; }
    }
}
struct MoeOrder {
    const int* lb; int nN, G, c, ntiles;
    __device__ __forceinline__ bool next(int i, pg8::Unit& u) const {
        const long L = (long)i * G + c; if (L >= (long)ntiles * nN) return false;
        const int t = (int)(L / nN), pn = (int)(L % nN); int e = 0;
#pragma unroll
        for (int q = 1; q < 8; ++q) e += (t * 256 >= lb[q]) ? 1 : 0;
        u.pm = t; u.pn = __builtin_amdgcn_readfirstlane(e) * nN + pn; return true;
    }
    __device__ __forceinline__ void a_ready(const pg8::Unit&) const {}
    __device__ __forceinline__ void done(const pg8::Unit&) const {}
};
struct EpiGateUpM { bf16_t* ACT;
    __device__ __forceinline__ void operator()(int row, int col0, float (&v)[8]) const {
        float a[4];
#pragma unroll
        for (int j = 0; j < 4; ++j) a[j] = siluf_(v[2 * j]) * v[2 * j + 1];
        u32x2 w = {pk2(a[0], a[1]), pk2(a[2], a[3])};
        *(u32x2*)(ACT + (size_t)row * FF + ((col0 % (2 * FF)) >> 1)) = w;
    }
};
struct EpiStoreM { bf16_t* Y;
    __device__ __forceinline__ void operator()(int row, int col0, float (&v)[8]) const {
        u32x4 w = {pk2(v[0], v[1]), pk2(v[2], v[3]), pk2(v[4], v[5]), pk2(v[6], v[7])};
        *(u32x4*)(Y + (size_t)row * 1024 + (col0 & 1023)) = w;
    }
};
template <class E>
__device__ __forceinline__ void gemm_moe(char* lds, const Params& p, int j, const bf16_t* A, int K, const bf16_t* Bt, int nN, const E& e) {
    int* lb = (int*)(lds + 132 * 1024);
    { int base[9]; moe_bases(p, j, base); if (ptid() == 0) {
#pragma unroll
        for (int q = 0; q < 9; ++q) lb[q] = base[q]; } }
    __syncthreads();
    MoeOrder S; S.lb = lb; S.nN = nN; S.G = (int)gridDim.x; S.c = (int)blockIdx.x; S.ntiles = __builtin_amdgcn_readfirstlane(lb[8]) >> 8;
    pg8::Gemm g{A, Bt, 0, 0, K};
    EpiA<E> ea{e, 0};
    pg8::gemm_phase<EpiA<E>, MoeOrder, true, true>((PG8_LAS unsigned char*)lds, g, S, ea);
}

__device__ __forceinline__ void phase_attn_naive(const Params& p, int with_ctx, float* lds) {
    const bf16_t* QKV = (const bf16_t*)(p.ws + WS_QKV); float* O = (float*)(p.ws + WS_O);
    float* Ks = lds; float* Vs = lds + 32 * 64;
    const int tid = ptid();
    const int nlat = 32 * 16, nU = nlat + (with_ctx ? 16 : 0);
    for (int u = blockIdx.x; u < nU; u += gridDim.x) {
        int hm, row, nkeys; bool active = true;
        if (u < nlat) { hm = u & 15; row = RC + (u >> 4) * 512 + tid; nkeys = R; }
        else { hm = u - nlat; active = tid < RC; row = active ? tid : 0; nkeys = RC; }
        float q[64];
#pragma unroll
        for (int d8 = 0; d8 < 8; ++d8) {
            const u32x4 raw = *(const u32x4*)(QKV + (size_t)row * 3072 + hm * 64 + d8 * 8);
#pragma unroll
            for (int i = 0; i < 4; ++i) { q[d8 * 8 + 2 * i] = bf2f(raw[i] & 0xffffu); q[d8 * 8 + 2 * i + 1] = bf2f(raw[i] >> 16); }
        }
        float o[128];
#pragma unroll
        for (int e = 0; e < 128; ++e) o[e] = 0.f;
        float m = -1e30f, l = 0.f;
        for (int k0 = 0; k0 < nkeys; k0 += 32) {
            __syncthreads();
            if (tid < 256) {
                const int kr = tid >> 3, c8 = (tid & 7) * 8;
                const u32x4 raw = *(const u32x4*)(QKV + (size_t)(k0 + kr) * 3072 + 1024 + hm * 64 + c8);
#pragma unroll
                for (int i = 0; i < 4; ++i) { Ks[kr * 64 + c8 + 2 * i] = bf2f(raw[i] & 0xffffu); Ks[kr * 64 + c8 + 2 * i + 1] = bf2f(raw[i] >> 16); }
            }
            {
                const int kr = tid >> 4, c8 = (tid & 15) * 8;
                const u32x4 raw = *(const u32x4*)(QKV + (size_t)(k0 + kr) * 3072 + 2048 + (hm >> 1) * 128 + c8);
#pragma unroll
                for (int i = 0; i < 4; ++i) { Vs[kr * 128 + c8 + 2 * i] = bf2f(raw[i] & 0xffffu); Vs[kr * 128 + c8 + 2 * i + 1] = bf2f(raw[i] >> 16); }
            }
            __syncthreads();
            for (int kk = 0; kk < 32; ++kk) {
                float s = 0.f;
#pragma unroll
                for (int d4 = 0; d4 < 16; ++d4) { const f32x4 kv = *(const f32x4*)&Ks[kk * 64 + d4 * 4]; s += q[d4 * 4] * kv[0] + q[d4 * 4 + 1] * kv[1] + q[d4 * 4 + 2] * kv[2] + q[d4 * 4 + 3] * kv[3]; }
                if (s > m) {
                    const float al = exp2f(m - s); l *= al;
#pragma unroll
                    for (int e = 0; e < 128; ++e) o[e] *= al;
                    m = s;
                }
                const float pr = exp2f(s - m); l += pr;
#pragma unroll
                for (int e4 = 0; e4 < 32; ++e4) { const f32x4 vv = *(const f32x4*)&Vs[kk * 128 + e4 * 4]; o[e4 * 4] += pr * vv[0]; o[e4 * 4 + 1] += pr * vv[1]; o[e4 * 4 + 2] += pr * vv[2]; o[e4 * 4 + 3] += pr * vv[3]; }
            }
        }
        if (active) {
            const float inv = 1.f / l;
            float* op = O + (size_t)row * 2048 + hm * 128;
#pragma unroll
            for (int e4 = 0; e4 < 32; ++e4) *(f32x4*)(op + e4 * 4) = (f32x4){o[e4 * 4] * inv, o[e4 * 4 + 1] * inv, o[e4 * 4 + 2] * inv, o[e4 * 4 + 3] * inv};
        }
    }
}


namespace att {
using bf16x8 = __attribute__((ext_vector_type(8))) short;
using s16x4  = __attribute__((ext_vector_type(4))) short;
using f32x16 = __attribute__((ext_vector_type(16))) float;
constexpr int NW = 8, QBLK = 32, KVBLK = 64, LDQ = 3072, LDO = 2048;
constexpr float THR2 = 8.f;
constexpr int SHM_V = KVBLK * 128 * 2, SHM_K = KVBLK * 64 * 2, SHM_ATTN = 2 * SHM_V + 2 * SHM_K + NW * 64 * 4;
#define KSWZ64(row, colB) ((row) * 128 + ((colB) ^ ((((row) >> 1) & 7) << 4)))
#define SBAR() __builtin_amdgcn_sched_barrier(0)
__device__ __forceinline__ int crow(int r, int hi) { return (r & 3) + 8 * (r >> 2) + 4 * hi; }
__device__ __forceinline__ unsigned cvtpk(float lo, float hi) { unsigned r; asm volatile("v_cvt_pk_bf16_f32 %0, %1, %2" : "=v"(r) : "v"(lo), "v"(hi)); return r; }
__device__ __forceinline__ void partialSM(f32x16& p0, f32x16& p1, float& m_reg, float& mn, float& alpha) {
    float pmax = p0[0];
#pragma unroll
    for (int r = 1; r < 16; ++r) pmax = fmaxf(pmax, p0[r]);
#pragma unroll
    for (int r = 0; r < 16; ++r) pmax = fmaxf(pmax, p1[r]);
    { auto rr = __builtin_amdgcn_permlane32_swap(__float_as_uint(pmax), __float_as_uint(pmax), false, false); pmax = fmaxf(__uint_as_float(rr[0]), __uint_as_float(rr[1])); }
    if (__builtin_expect(__all(pmax - m_reg <= THR2), 1)) { mn = m_reg; alpha = 1.f; }
    else { mn = fmaxf(m_reg, pmax); alpha = __builtin_amdgcn_exp2f(m_reg - mn); m_reg = mn; }
#pragma unroll
    for (int r = 0; r < 16; ++r) p0[r] = p0[r] - mn;
#pragma unroll
    for (int r = 0; r < 16; ++r) p1[r] = p1[r] - mn;
#pragma unroll
    for (int r = 0; r < 16; ++r) p0[r] = __builtin_amdgcn_exp2f(p0[r]);
}
__device__ __forceinline__ void finishSM(f32x16& p0, f32x16& p1, float alpha, float& l_reg, bf16x8& pa0, bf16x8& pa1, bf16x8& pa2, bf16x8& pa3) {
#pragma unroll
    for (int r = 0; r < 16; ++r) p1[r] = __builtin_amdgcn_exp2f(p1[r]);
    float ps = 0;
#pragma unroll
    for (int r = 0; r < 16; ++r) ps += p0[r];
#pragma unroll
    for (int r = 0; r < 16; ++r) ps += p1[r];
    { auto rr = __builtin_amdgcn_permlane32_swap(__float_as_uint(ps), __float_as_uint(ps), false, false); ps = __uint_as_float(rr[0]) + __uint_as_float(rr[1]); }
    l_reg = l_reg * alpha + ps;
#define PK4(P, BASE, OUT) do { unsigned a0 = cvtpk(P[BASE + 0], P[BASE + 1]), a1 = cvtpk(P[BASE + 2], P[BASE + 3]);   \
    unsigned b0 = cvtpk(P[BASE + 4], P[BASE + 5]), b1 = cvtpk(P[BASE + 6], P[BASE + 7]);                              \
    auto r0 = __builtin_amdgcn_permlane32_swap(a0, b0, false, false); auto r1 = __builtin_amdgcn_permlane32_swap(a1, b1, false, false); \
    u32x4 w = {r0[0], r1[0], r0[1], r1[1]}; OUT = *reinterpret_cast<bf16x8*>(&w); } while (0)
    PK4(p0, 0, pa0); PK4(p0, 8, pa1); PK4(p1, 0, pa2); PK4(p1, 8, pa3);
#undef PK4
}
__device__ __forceinline__ void qkt(f32x16& p0, f32x16& p1, const char* Ks, const bf16x8* qr, int r32, int hi) {
    p0 = f32x16{}; p1 = f32x16{};
#pragma unroll
    for (int d0 = 0; d0 < 4; ++d0) { const int cb = (d0 * 16 + hi * 8) * 2;
        bf16x8 b0 = *reinterpret_cast<const bf16x8*>(Ks + KSWZ64(r32, cb));
        bf16x8 b1 = *reinterpret_cast<const bf16x8*>(Ks + KSWZ64(32 + r32, cb));
        p0 = __builtin_amdgcn_mfma_f32_32x32x16_bf16(b0, qr[d0], p0, 0, 0, 0);
        p1 = __builtin_amdgcn_mfma_f32_32x32x16_bf16(b1, qr[d0], p1, 0, 0, 0); }
}
__device__ __forceinline__ int v_st(int k, int c) { const int kk = (k & ~0xC) | ((k & 4) << 1) | ((k & 8) >> 1); return ((kk >> 3) * 4 + (c >> 5)) * 512 + ((kk & 7) * 32 + (c & 31)) * 2; }
__device__ __forceinline__ int v_rd_base(int lane) { return ((lane & 3) << 3) | (((lane >> 2) & 3) << 6) | (((lane >> 4) & 1) << 5) | (((lane >> 5) & 1) << 8); }
constexpr int v_rd_off(int d0, int ks, int half) { return d0 * 512 + ks * 4096 + half * 2048; }
template <int OFF> __device__ __forceinline__ s16x4 tr_read(int vb) { s16x4 r; asm volatile("ds_read_b64_tr_b16 %0, %1 offset:%2" : "=&v"(r) : "v"(vb), "i"(OFF) : "memory"); return r; }
template <int D0> __device__ __forceinline__ void pv_one(f32x16& od, int vb, bf16x8 pa0, bf16x8 pa1, bf16x8 pa2, bf16x8 pa3) {
    const s16x4 l0 = tr_read<v_rd_off(D0, 0, 0)>(vb), h0 = tr_read<v_rd_off(D0, 0, 1)>(vb), l1 = tr_read<v_rd_off(D0, 1, 0)>(vb), h1 = tr_read<v_rd_off(D0, 1, 1)>(vb);
    const s16x4 l2 = tr_read<v_rd_off(D0, 2, 0)>(vb), h2 = tr_read<v_rd_off(D0, 2, 1)>(vb), l3 = tr_read<v_rd_off(D0, 3, 0)>(vb), h3 = tr_read<v_rd_off(D0, 3, 1)>(vb);
    asm volatile("s_waitcnt lgkmcnt(0)" ::: "memory"); SBAR();
#define PK(L, H) (bf16x8){L[0], L[1], L[2], L[3], H[0], H[1], H[2], H[3]}
    od = __builtin_amdgcn_mfma_f32_32x32x16_bf16(pa0, PK(l0, h0), od, 0, 0, 0);
    od = __builtin_amdgcn_mfma_f32_32x32x16_bf16(pa1, PK(l1, h1), od, 0, 0, 0);
    od = __builtin_amdgcn_mfma_f32_32x32x16_bf16(pa2, PK(l2, h2), od, 0, 0, 0);
    od = __builtin_amdgcn_mfma_f32_32x32x16_bf16(pa3, PK(l3, h3), od, 0, 0, 0);
#undef PK
}
__device__ __forceinline__ void pv_d0(f32x16* o, int vb, bf16x8 pa0, bf16x8 pa1, bf16x8 pa2, bf16x8 pa3) {
    pv_one<0>(o[0], vb, pa0, pa1, pa2, pa3); pv_one<1>(o[1], vb, pa0, pa1, pa2, pa3); pv_one<2>(o[2], vb, pa0, pa1, pa2, pa3); pv_one<3>(o[3], vb, pa0, pa1, pa2, pa3);
}
__device__ __forceinline__ void attn_body(const bf16_t* __restrict__ Qb, const bf16_t* __restrict__ Kh, const bf16_t* __restrict__ Vh, float* __restrict__ Ob, int seq, char* lds) {
    const int tid = ptid(), wid = tid >> 6, lane = tid & 63, r32 = lane & 31, hi = lane >> 5;
    char* V_lds = lds; char* K_lds = lds + 2 * SHM_V;
    float* ws = (float*)(lds + 2 * SHM_V + 2 * SHM_K) + wid * 64; float* li_l = ws; float* al_l = ws + 32;
    float m_reg = -1e30f, l_reg = 0; f32x16 o[4] = {}; bf16x8 qr[4];
    const bf16_t* Qw = Qb + (long)(wid * QBLK + r32) * LDQ + hi * 8;
#pragma unroll
    for (int d0 = 0; d0 < 4; ++d0) qr[d0] = *reinterpret_cast<const bf16x8*>(Qw + d0 * 16);
    const int sr = tid >> 4, sc = (tid & 15) * 8, vst0 = v_st(sr, sc), vst1 = v_st(32 + sr, sc);
    const int kr = tid >> 3, kc = (tid & 7) * 8, kst = KSWZ64(kr, kc * 2);
    const int vb0 = (int)(uintptr_t)V_lds + v_rd_base(lane);
    struct { bf16x8 vs0, vs1, ks0; } sr_[2];
#define SLOAD(i, k0) do { sr_[i].vs0 = *reinterpret_cast<const bf16x8*>(&Vh[(long)((k0) + sr) * LDQ + sc]); sr_[i].vs1 = *reinterpret_cast<const bf16x8*>(&Vh[(long)((k0) + 32 + sr) * LDQ + sc]); \
    sr_[i].ks0 = *reinterpret_cast<const bf16x8*>(&Kh[(long)((k0) + kr) * LDQ + kc]); } while (0)
#define SWRITE(b, i) do { *(bf16x8*)(V_lds + (b) * SHM_V + vst0) = sr_[i].vs0; *(bf16x8*)(V_lds + (b) * SHM_V + vst1) = sr_[i].vs1; *(bf16x8*)(K_lds + (b) * SHM_K + kst) = sr_[i].ks0; } while (0)
#define SWAIT() asm volatile("s_waitcnt vmcnt(3)" ::: "memory")
#define RESC(a) do { if (__any((a) < 1.f)) { if (hi == 0) al_l[r32] = (a); asm volatile("s_waitcnt lgkmcnt(0)" ::: "memory"); \
    _Pragma("unroll") for (int d = 0; d < 4; ++d) _Pragma("unroll") for (int r = 0; r < 16; ++r) o[d][r] *= al_l[crow(r, hi)]; } } while (0)
    f32x16 pA0, pA1, pB0, pB1; float mnA, mnB, alA, alB; bf16x8 pa0, pa1, pa2, pa3; const int NT = seq / KVBLK;
    constexpr int SE = 0, SO = 1;
    SLOAD(SE, 0); asm volatile("s_waitcnt vmcnt(0)" ::: "memory"); SWRITE(0, SE); __syncthreads();
    qkt(pA0, pA1, K_lds, qr, r32, hi); partialSM(pA0, pA1, m_reg, mnA, alA);
    SLOAD(SO, KVBLK); if (2 < NT) SLOAD(SE, 2 * KVBLK);
    SWAIT(); SWRITE(1, SO); __syncthreads();
    for (int j = 1; j + 1 < NT; j += 2) {
        SBAR(); qkt(pB0, pB1, K_lds + SHM_K, qr, r32, hi);
        finishSM(pA0, pA1, alA, l_reg, pa0, pa1, pa2, pa3); SBAR();
        SLOAD(SO, (j + 2) * KVBLK); SBAR();
        pv_d0(o, vb0, pa0, pa1, pa2, pa3); partialSM(pB0, pB1, m_reg, mnB, alB);
        __syncthreads(); SWAIT(); SWRITE(0, SE);
        RESC(alB); __syncthreads();
        SBAR(); qkt(pA0, pA1, K_lds, qr, r32, hi);
        finishSM(pB0, pB1, alB, l_reg, pa0, pa1, pa2, pa3); SBAR();
        if (j + 3 < NT) SLOAD(SE, (j + 3) * KVBLK); SBAR();
        pv_d0(o, vb0 + SHM_V, pa0, pa1, pa2, pa3); partialSM(pA0, pA1, m_reg, mnA, alA);
        __syncthreads(); SWAIT(); SWRITE(1, SO);
        RESC(alA); __syncthreads();
    }
    SBAR(); qkt(pB0, pB1, K_lds + SHM_K, qr, r32, hi);
    finishSM(pA0, pA1, alA, l_reg, pa0, pa1, pa2, pa3); SBAR();
    pv_d0(o, vb0, pa0, pa1, pa2, pa3); partialSM(pB0, pB1, m_reg, mnB, alB);
    __syncthreads(); RESC(alB);
    finishSM(pB0, pB1, alB, l_reg, pa0, pa1, pa2, pa3); SBAR();
    pv_d0(o, vb0 + SHM_V, pa0, pa1, pa2, pa3);
    if (hi == 0) li_l[r32] = l_reg; asm volatile("s_waitcnt lgkmcnt(0)" ::: "memory");
    float rli[16];
#pragma unroll
    for (int r = 0; r < 16; ++r) rli[r] = __builtin_amdgcn_rcpf(li_l[crow(r, hi)]);
    float* Ow = Ob + (long)(wid * QBLK) * LDO;
#pragma unroll
    for (int r = 0; r < 16; ++r) { const int orow = crow(r, hi);
#pragma unroll
        for (int d0 = 0; d0 < 4; ++d0) Ow[(long)orow * LDO + d0 * 32 + r32] = o[d0][r] * rli[r]; }
    __syncthreads();
#undef SLOAD
#undef SWRITE
#undef SWAIT
#undef RESC
}
}

__device__ __forceinline__ void phase_attn(const Params& p, int with_ctx, char* lds) {
    const bf16_t* QKV = (const bf16_t*)(p.ws + WS_QKV); float* O = (float*)(p.ws + WS_O);
    const int nlat = 64 * 16, nU = nlat + (with_ctx ? 16 : 0);
    for (int u = blockIdx.x; u < nU; u += gridDim.x) {
        int hm, row0, nkeys;
        if (u < nlat) { const int k = u >> 8, b = u & 255, xcd = b & 7, idx = b >> 3; hm = 4 * k + (xcd >> 1); row0 = RC + ((xcd & 1) * 32 + idx) * 256; nkeys = R; }
        else { hm = u - nlat; row0 = 0; nkeys = RC; }
        att::attn_body(QKV + (size_t)row0 * 3072 + hm * 64, QKV + 1024 + hm * 64, QKV + 2048 + (hm >> 1) * 128, O + (size_t)row0 * 2048 + hm * 128, nkeys, lds);
    }
}

__device__ __forceinline__ void phase_comb(const Params& p, int j, float lam_init, int row_lo) {
    const int lane = ptid() & 63, wv = ptid() >> 6;
    const float* O = (const float*)(p.ws + WS_O); bf16_t* A2 = (bf16_t*)(p.ws + WS_A2);
    const float* lp = p.in[9] + j * 256; const float* sub = p.in[10] + j * 128;
    const float sa = wave_sum(lp[lane] * lp[64 + lane]), sb = wave_sum(lp[128 + lane] * lp[192 + lane]);
    const float lam = expf(sa) - expf(sb) + lam_init;
    const float g0 = sub[lane * 2] * (1.f - lam_init), g1 = sub[lane * 2 + 1] * (1.f - lam_init);
    for (int row = row_lo + blockIdx.x * 8 + wv; row < R; row += gridDim.x * 8) {
#pragma unroll
        for (int h = 0; h < 8; ++h) {
            const float* o0 = O + (size_t)row * 2048 + h * 256 + lane * 2;
            const float d0 = o0[0] - lam * o0[128], d1 = o0[1] - lam * o0[129];
            const float ss = wave_sum(d0 * d0 + d1 * d1);
            const float rs = rsqrtf(ss * (1.f / 128.f) + 1e-5f);
            *(unsigned*)(A2 + (size_t)row * 1024 + h * 128 + lane * 2) = pk2(d0 * rs * g0, d1 * rs * g1);
        }
    }
}

__device__ __forceinline__ void phase_lnv(const Params& p) {
    const int lane = ptid() & 63, wv = ptid() >> 6;
    const float* VP = (const float*)(p.ws + WS_VP); bf16_t* VN = (bf16_t*)(p.ws + WS_VN);
    const float* lg = p.in[13]; const float* lb = p.in[14];
    for (int row = blockIdx.x * 8 + wv; row < R; row += gridDim.x * 8) {
        f32x4 x[4]; float s = 0.f;
#pragma unroll
        for (int j = 0; j < 4; ++j) { x[j] = *(const f32x4*)(VP + (size_t)row * 1024 + j * 256 + lane * 4); s += x[j][0] + x[j][1] + x[j][2] + x[j][3]; }
        const float mean = wave_sum(s) * (1.f / 1024.f);
        float q = 0.f;
#pragma unroll
        for (int j = 0; j < 4; ++j) { x[j] = x[j] - mean; q += x[j][0] * x[j][0] + x[j][1] * x[j][1] + x[j][2] * x[j][2] + x[j][3] * x[j][3]; }
        const float rs = rsqrtf(wave_sum(q) * (1.f / 1024.f) + 1e-5f);
#pragma unroll
        for (int j = 0; j < 4; ++j) {
            const int col = j * 256 + lane * 4;
            const f32x4 h = x[j] * rs * *(const f32x4*)(lg + col) + *(const f32x4*)(lb + col);
            u32x2 w = {pk2(h[0], h[1]), pk2(h[2], h[3])};
            *(u32x2*)(VN + (size_t)row * 1024 + col) = w;
        }
    }
}

__device__ __forceinline__ void phase_spat_naive(const Params& p, float* lds) {
    const bf16_t* VN = (const bf16_t*)(p.ws + WS_VN); const bf16_t* U = (const bf16_t*)(p.ws + WS_U); bf16_t* A2 = (bf16_t*)(p.ws + WS_A2);
    const float* ws_ = p.in[15]; const float* bs = p.in[16];
    float* Ws = lds; float* Vs = lds + 128 * 129;
    const int tid = ptid();
    for (int u = blockIdx.x; u < 130 * 8; u += gridDim.x) {
        const int c = u >> 3, g = u & 7;
        __syncthreads();
        for (int i = tid; i < 128 * 128; i += NTHR) { const int pp = i >> 7, qq = i & 127; Ws[pp * 129 + qq] = ws_[(size_t)g * 16384 + i]; }
        for (int i = tid; i < 128 * 16; i += NTHR) {
            const int qq = i >> 4, c8 = (i & 15) * 8;
            const u32x4 raw = *(const u32x4*)(VN + (size_t)(c * 128 + qq) * 1024 + g * 128 + c8);
#pragma unroll
            for (int e = 0; e < 4; ++e) { Vs[qq * 128 + c8 + 2 * e] = bf2f(raw[e] & 0xffffu); Vs[qq * 128 + c8 + 2 * e + 1] = bf2f(raw[e] >> 16); }
        }
        __syncthreads();
        const int pp = tid >> 2, k0 = (tid & 3) * 32;
        float acc[32];
#pragma unroll
        for (int e = 0; e < 32; ++e) acc[e] = 0.f;
        for (int qq = 0; qq < 128; ++qq) {
            const float w = Ws[pp * 129 + qq];
#pragma unroll
            for (int e4 = 0; e4 < 8; ++e4) { const f32x4 vv = *(const f32x4*)&Vs[qq * 128 + k0 + e4 * 4]; acc[e4 * 4] += w * vv[0]; acc[e4 * 4 + 1] += w * vv[1]; acc[e4 * 4 + 2] += w * vv[2]; acc[e4 * 4 + 3] += w * vv[3]; }
        }
        const float bias = bs[g * 128 + pp];
        const size_t off = (size_t)(c * 128 + pp) * 1024 + g * 128 + k0;
#pragma unroll
        for (int e8 = 0; e8 < 4; ++e8) {
            const u32x4 uu = *(const u32x4*)(U + off + e8 * 8);
            u32x4 w;
#pragma unroll
            for (int e = 0; e < 4; ++e) w[e] = pk2(bf2f(uu[e] & 0xffffu) * (acc[e8 * 8 + 2 * e] + bias), bf2f(uu[e] >> 16) * (acc[e8 * 8 + 2 * e + 1] + bias));
            *(u32x4*)(A2 + off + e8 * 8) = w;
        }
    }
}

__device__ __forceinline__ void phase_mix(const Params& p) {
    const int lane = ptid() & 63, wv = ptid() >> 6;
    const bf16_t* H = (const bf16_t*)(p.ws + WS_H); bf16_t* MX = (bf16_t*)(p.ws + WS_MIX);
    const float* mix = p.in[18];
    for (int row = blockIdx.x * 8 + wv; row < R; row += gridDim.x * 8) {
        const bool hp = (row != 0 && row != RC), hn = (row != RC - 1 && row != R - 1);
#pragma unroll
        for (int j = 0; j < 4; ++j) {
            const int col = j * 256 + lane * 4;
            const u32x2 c = *(const u32x2*)(H + (size_t)row * 1024 + col);
            u32x2 a = {0u, 0u}, b = {0u, 0u};
            if (hp) a = *(const u32x2*)(H + (size_t)(row - 1) * 1024 + col);
            if (hn) b = *(const u32x2*)(H + (size_t)(row + 1) * 1024 + col);
            float hc[4] = {bf2f(c[0] & 0xffffu), bf2f(c[0] >> 16), bf2f(c[1] & 0xffffu), bf2f(c[1] >> 16)};
            float ha[4] = {bf2f(a[0] & 0xffffu), bf2f(a[0] >> 16), bf2f(a[1] & 0xffffu), bf2f(a[1] >> 16)};
            float hb[4] = {bf2f(b[0] & 0xffffu), bf2f(b[0] >> 16), bf2f(b[1] & 0xffffu), bf2f(b[1] >> 16)};
            float ts[4];
#pragma unroll
            for (int e = 0; e < 4; ++e) ts[e] = 0.5f * (ha[e] + hb[e]) - hc[e];
#pragma unroll
            for (int q = 0; q < 6; ++q) {
                const f32x4 mq = *(const f32x4*)(mix + q * 1024 + col);
                u32x2 w = {pk2(hc[0] + ts[0] * mq[0], hc[1] + ts[1] * mq[1]), pk2(hc[2] + ts[2] * mq[2], hc[3] + ts[3] * mq[3])};
                *(u32x2*)(MX + ((size_t)q * R + row) * 1024 + col) = w;
            }
        }
    }
}

__device__ __forceinline__ void phase_kkn(const Params& p) {
    const int lane = ptid() & 63, wv = ptid() >> 6;
    const bf16_t* KK = (const bf16_t*)(p.ws + WS_KK); float* KN = (float*)(p.ws + WS_KN);
    const float* kk_ = p.in[28];
    for (int row = blockIdx.x * 8 + wv; row < R; row += gridDim.x * 8) {
        float ss = 0.f;
#pragma unroll
        for (int j = 0; j < 2; ++j) {
            const int col = lane * 16 + j * 8;
            const u32x4 raw = *(const u32x4*)(KK + (size_t)row * 1024 + col);
#pragma unroll
            for (int e = 0; e < 4; ++e) { const float a = bf2f(raw[e] & 0xffffu) * kk_[col + 2 * e], b = bf2f(raw[e] >> 16) * kk_[col + 2 * e + 1]; ss += a * a + b * b; }
        }
        ss += __shfl_xor(ss, 1); ss += __shfl_xor(ss, 2);
        if ((lane & 3) == 0) KN[(size_t)row * 16 + (lane >> 2)] = 1.f / fmaxf(sqrtf(ss), 1e-12f);
    }
}

template <int CTRL> __device__ __forceinline__ float dppmov(float v) { return __builtin_bit_cast(float, __builtin_amdgcn_update_dpp(0, __builtin_bit_cast(int, v), CTRL, 0xf, 0xf, true)); }
__device__ __forceinline__ float wave_sum_dpp(float v) {
    v += dppmov<0xB1>(v); v += dppmov<0x4E>(v); v += dppmov<0x141>(v); v += dppmov<0x140>(v);
    const int b = __builtin_bit_cast(int, v);
    return (__builtin_bit_cast(float, __builtin_amdgcn_readlane(b, 0)) + __builtin_bit_cast(float, __builtin_amdgcn_readlane(b, 16))) +
           (__builtin_bit_cast(float, __builtin_amdgcn_readlane(b, 32)) + __builtin_bit_cast(float, __builtin_amdgcn_readlane(b, 48)));
}

__device__ __forceinline__ int scan_row(int z, int n) { return z == 0 ? n : (n < RC ? RC - 1 - n : R + RC - 1 - n); }
__device__ __forceinline__ void phase_scan(const Params& p, float* lds) {
    const int tid = ptid(), lane = tid & 63, wv = tid >> 6;
    const bf16_t* RRb = (const bf16_t*)(p.ws + WS_RR); const bf16_t* KKb = (const bf16_t*)(p.ws + WS_KK); const bf16_t* VVb = (const bf16_t*)(p.ws + WS_VV);
    const float* DEC = (const float*)(p.ws + WS_DEC); const bf16_t* AP = (const bf16_t*)(p.ws + WS_AP); const float* KN = (const float*)(p.ws + WS_KN);
    float* Y = (float*)(p.ws + WS_Y);
    const float* k_k = p.in[28]; const float* k_a = p.in[29];
    float* sw = lds; float* sa_ = lds + 2048; float* sb = lds + 4096; float* sk = lds + 6144; float* sr = lds + 8192; float* sv = lds + 10240; float* sy = lds + 10496;
    for (int u = blockIdx.x; u < 256; u += gridDim.x) {
        const int zh = u & 31, rg = u >> 5, z = zh >> 4, head = zh & 15;
        float S = 0.f;
        for (int n0 = 0; n0 < R; n0 += 32) {
            __syncthreads();
#pragma unroll
            for (int q = 0; q < 4; ++q) {
                const int idx = tid + NTHR * q, s = idx >> 6, j = idx & 63, row = scan_row(z, n0 + s), col = head * 64 + j;
                const float kraw = bf2f(KKb[(size_t)row * 1024 + col]), ap = bf2f(AP[((size_t)z * R + row) * 1024 + col]);
                const float kkv = kraw * k_k[col] * KN[(size_t)row * 16 + head];
                sw[idx] = DEC[((size_t)z * R + row) * 1024 + col]; sa_[idx] = -kkv; sb[idx] = kkv * ap; sk[idx] = kraw * (1.f + (ap - 1.f) * k_a[col]);
                sr[idx] = bf2f(RRb[(size_t)row * 1024 + col]);
            }
            if (tid < 256) { const int s = tid >> 3, i = tid & 7; sv[tid] = bf2f(VVb[(size_t)scan_row(z, n0 + s) * 1024 + head * 64 + rg * 8 + i]); }
            __syncthreads();
            for (int s = 0; s < 32; ++s) {
                const float w = sw[s * 64 + lane], a = sa_[s * 64 + lane], b = sb[s * 64 + lane], kd = sk[s * 64 + lane], r = sr[s * 64 + lane], vi = sv[s * 8 + wv];
                const float sa = wave_sum_dpp(S * a);
                S = S * w + sa * b + vi * kd;
                const float y = wave_sum_dpp(S * r);
                if (lane == 0) sy[s * 8 + wv] = y;
            }
            __syncthreads();
            if (tid < 256) { const int s = tid >> 3, i = tid & 7; Y[((size_t)z * R + scan_row(z, n0 + s)) * 1024 + head * 64 + rg * 8 + i] = sy[tid]; }
        }
    }
}

__device__ __forceinline__ void phase_rout(const Params& p) {
    const int lane = ptid() & 63, wv = ptid() >> 6;
    const float* Y = (const float*)(p.ws + WS_Y); const bf16_t* RRb = (const bf16_t*)(p.ws + WS_RR); const bf16_t* KKb = (const bf16_t*)(p.ws + WS_KK);
    const bf16_t* VVb = (const bf16_t*)(p.ws + WS_VV); const bf16_t* AP = (const bf16_t*)(p.ws + WS_AP); const bf16_t* G = (const bf16_t*)(p.ws + WS_G);
    bf16_t* A2 = (bf16_t*)(p.ws + WS_A2R);
    const float* k_a = p.in[29]; const float* r_k = p.in[30]; const float* lw = p.in[31]; const float* lb = p.in[32];
    for (int row = blockIdx.x * 8 + wv; row < R; row += gridDim.x * 8) {
        const int c0 = lane * 16;
        float y[16], r[16], k[16], v[16], a0[16], a1[16], g[16];
#pragma unroll
        for (int q = 0; q < 4; ++q) { const f32x4 ya = *(const f32x4*)(Y + (size_t)row * 1024 + c0 + q * 4), yb = *(const f32x4*)(Y + ((size_t)R + row) * 1024 + c0 + q * 4);
#pragma unroll
            for (int e = 0; e < 4; ++e) y[q * 4 + e] = ya[e] + yb[e]; }
#define LD16(dst, ptr) do { _Pragma("unroll") for (int q = 0; q < 2; ++q) { const u32x4 raw = *(const u32x4*)((ptr) + q * 8); _Pragma("unroll") for (int e = 0; e < 4; ++e) { dst[q * 8 + 2 * e] = bf2f(raw[e] & 0xffffu); dst[q * 8 + 2 * e + 1] = bf2f(raw[e] >> 16); } } } while (0)
        LD16(r, RRb + (size_t)row * 1024 + c0); LD16(k, KKb + (size_t)row * 1024 + c0); LD16(v, VVb + (size_t)row * 1024 + c0);
        LD16(a0, AP + (size_t)row * 1024 + c0); LD16(a1, AP + ((size_t)R + row) * 1024 + c0); LD16(g, G + (size_t)row * 1024 + c0);
#undef LD16
        float s = 0.f, bsum = 0.f;
#pragma unroll
        for (int e = 0; e < 16; ++e) {
            s += y[e];
            const float ka = k_a[c0 + e], kd0 = k[e] * (1.f + (a0[e] - 1.f) * ka), kd1 = k[e] * (1.f + (a1[e] - 1.f) * ka);
            bsum += r[e] * (kd0 + kd1) * r_k[c0 + e];
        }
        s += __shfl_xor(s, 1); s += __shfl_xor(s, 2); bsum += __shfl_xor(bsum, 1); bsum += __shfl_xor(bsum, 2);
        const float mean = s * (1.f / 64.f);
        float q2 = 0.f;
#pragma unroll
        for (int e = 0; e < 16; ++e) { y[e] -= mean; q2 += y[e] * y[e]; }
        q2 += __shfl_xor(q2, 1); q2 += __shfl_xor(q2, 2);
        const float rs = rsqrtf(q2 * (1.f / 64.f) + 64e-5f);
        unsigned w[8];
#pragma unroll
        for (int e = 0; e < 8; ++e) {
            const float o0 = (y[2 * e] * rs * lw[c0 + 2 * e] + lb[c0 + 2 * e] + bsum * v[2 * e]) * g[2 * e];
            const float o1 = (y[2 * e + 1] * rs * lw[c0 + 2 * e + 1] + lb[c0 + 2 * e + 1] + bsum * v[2 * e + 1]) * g[2 * e + 1];
            w[e] = pk2(o0, o1);
        }
        *(u32x4*)(A2 + (size_t)row * 1024 + c0) = (u32x4){w[0], w[1], w[2], w[3]};
        *(u32x4*)(A2 + (size_t)row * 1024 + c0 + 8) = (u32x4){w[4], w[5], w[6], w[7]};
    }
}

enum { PH_MOD, PH_NORM, PH_QKV, PH_ATT, PH_COMB, PH_OPROJ, PH_F1, PH_F2, PH_GI, PH_LNV, PH_SPAT, PH_GO, PH_M1, PH_M2, PH_MIX, PH_RKV, PH_L1, PH_L2, PH_KKN, PH_SCAN, PH_ROUT, PH_RO, PH_CONV, PH_PERM, PH_M1G, PH_M2G };
struct PhArgs { int a, b, c, d, e, f; };
#define WSB(off) ((bf16_t*)(p.ws + (off)))

__device__ __forceinline__ void conv_layer(const Params& p, int layer, float* lds) {
    if (layer == 0 || layer == 3) {
        const int j = layer == 0 ? 0 : 1;
        conv_w(BQKV{p.in[8] + (size_t)j * 1024 * 3072}, WSB(WS_WIN), 3072, 1024, lds);
        conv_w(BPlain{p.in[11] + (size_t)j * 1024 * 1024, 1024}, WSB(WS_WOUT), 1024, 1024, lds);
    } else if (layer == 1) {
        conv_w(BPlain{p.in[12], 2048}, WSB(WS_WIN), 2048, 1024, lds);
        conv_w(BPlain{p.in[17], 1024}, WSB(WS_WOUT), 1024, 1024, lds);
    } else {
#pragma unroll
        for (int q = 0; q < 3; ++q) conv_w(BPlain{p.in[19] + (size_t)q * 1024 * 1024, 1024}, WSB(WS_WIN) + (size_t)q * 1024 * 1024, 1024, 1024, lds);
        conv_w(BPlain{p.in[33], 1024}, WSB(WS_WOUT), 1024, 1024, lds);
        conv_w(BLora1{p.in[21]}, WSB(WS_WL), 256, 1024, lds);
        conv_w(BLora1{p.in[24]}, WSB(WS_WL) + 256 * 1024, 256, 1024, lds);
        conv_w(BG1{p.in[26]}, WSB(WS_WL) + 2 * 256 * 1024, 256, 1024, lds);
        conv_w(BLora2{p.in[22]}, WSB(WS_WL) + 3 * 256 * 1024, 2048, 128, lds);
        conv_w(BLora2{p.in[25]}, WSB(WS_WL) + 4 * 256 * 1024, 2048, 128, lds);
        conv_w(BG2{p.in[27]}, WSB(WS_WL) + 5 * 256 * 1024, 1024, 256, lds);
    }
    if (layer == 0 || layer == 2) {
        const int j = layer >> 1;
        conv_w(BGateUp{p.in[34] + (size_t)j * 1024 * FF, p.in[35] + (size_t)j * 1024 * FF, FF}, WSB(WS_WF1), 2 * FF, 1024, lds);
        conv_w(BPlain{p.in[36] + (size_t)j * FF * 1024, 1024}, WSB(WS_WF2D), 1024, FF, lds);
    } else {
        const int j = layer >> 1;
#pragma unroll 1
        for (int e = 0; e < 8; ++e) {
            const size_t wo = ((size_t)j * 8 + e) * 1024 * FF;
            conv_w(BGateUp{p.in[38] + wo, p.in[39] + wo, FF}, WSB(WS_WF1) + (size_t)e * 2 * FF * 1024, 2 * FF, 1024, lds);
            conv_w(BPlain{p.in[40] + wo, 1024}, WSB(WS_WF2M) + (size_t)e * 1024 * FF, 1024, FF, lds);
        }
    }
}

template <int PH>
__global__ void __launch_bounds__(NTHR, 2) kph(Params p, PhArgs x) {
    extern __shared__ __attribute__((aligned(16))) char smem[];
    float* lds = (float*)smem;
    float* XL = (float*)(p.ws + WS_XL); const bf16_t* H = (const bf16_t*)(p.ws + WS_H);
    const float* MOD = (const float*)(p.ws + WS_MOD);
    if constexpr (PH == PH_MOD) phase_mod(p, lds);
    else if constexpr (PH == PH_CONV) conv_layer(p, x.a, lds);
    else if constexpr (PH == PH_NORM) phase_norm(p, x.a, x.b, x.c & 1, x.d, x.e, x.f, (x.c >> 1) - 1, smem);
    else if constexpr (PH == PH_PERM) phase_perm(p, x.a, x.b, smem);
    else if constexpr (PH == PH_M1G) gemm_moe(smem, p, x.a, WSB(WS_HP), 1024, WSB(WS_WF1), 22, EpiGateUpM{WSB(WS_ACTM)});
    else if constexpr (PH == PH_M2G) gemm_moe(smem, p, x.a, WSB(WS_ACTM), FF, WSB(WS_WF2M), 4, EpiStoreM{WSB(WS_YM)});
    else if constexpr (PH == PH_QKV) gemm_fast(smem, H, 0, R, 1024, WSB(WS_WIN), 3072, EpiQKV{WSB(WS_QKV), (const float*)(p.ws + WS_TAB), 0.125f * 1.4426950408889634f});
    else if constexpr (PH == PH_ATT) phase_attn(p, x.a, smem);
    else if constexpr (PH == PH_COMB) phase_comb(p, x.a, __int_as_float(x.b), x.c);
    else if constexpr (PH == PH_OPROJ) gemm_fast(smem, WSB(WS_A2), x.c, R - x.c, 1024, WSB(WS_WOUT), 1024, EpiResid{XL, MOD + x.b * 2 * 6144, 2, nullptr, 0});
    else if constexpr (PH == PH_F1) gemm_fast(smem, H, 0, R, 1024, WSB(WS_WF1), 2 * FF, EpiGateUp{WSB(WS_ACT), FF});
    else if constexpr (PH == PH_F2) gemm_fast(smem, WSB(WS_ACT), 0, R, FF, WSB(WS_WF2D), 1024, EpiResid{XL, MOD + x.b * 2 * 6144, 5, nullptr, 0});
    else if constexpr (PH == PH_GI) gemm_fast(smem, H, 0, R, 1024, WSB(WS_WIN), 2048, EpiGelu{WSB(WS_U), (float*)(p.ws + WS_VP)});
    else if constexpr (PH == PH_LNV) phase_lnv(p);
    else if constexpr (PH == PH_SPAT) phase_spat_naive(p, lds);
    else if constexpr (PH == PH_GO) gemm_fast(smem, WSB(WS_A2), 0, R, 1024, WSB(WS_WOUT), 1024, EpiResid{XL, MOD + 1 * 2 * 6144, 2, nullptr, 0});
    else if constexpr (PH == PH_M1) gemm_fast(smem, H, x.c, R - x.c, 1024, WSB(WS_WF1) + (size_t)x.b * 2 * FF * 1024, 2 * FF, EpiGateUp{WSB(WS_ACT), FF});
    else if constexpr (PH == PH_M2) gemm_fast(smem, WSB(WS_ACT), x.c, R - x.c, FF, WSB(WS_WF2M) + (size_t)x.b * 1024 * FF, 1024, EpiResid{XL, MOD + x.d * 2 * 6144, 5, (const int*)(p.ws + WS_ROUTE), x.b});
    else if constexpr (PH == PH_MIX) phase_mix(p);
    else if constexpr (PH == PH_RKV) {
        const int mi = x.a == 0 ? 0 : (x.a == 1 ? 2 : 3);
        bf16_t* dst = WSB(x.a == 0 ? WS_RR : (x.a == 1 ? WS_KK : WS_VV));
        gemm_fast(smem, WSB(WS_MIX) + (size_t)mi * R * 1024, 0, R, 1024, WSB(WS_WIN) + (size_t)x.a * 1024 * 1024, 1024, EpiStore{dst, 1024, 0});
    }
    else if constexpr (PH == PH_L1) {
        if (x.a == 0) gemm_fast(smem, WSB(WS_MIX) + (size_t)1 * R * 1024, 0, R, 1024, WSB(WS_WL), 256, EpiStore{WSB(WS_L1W), 128, 1});
        else if (x.a == 1) gemm_fast(smem, WSB(WS_MIX) + (size_t)4 * R * 1024, 0, R, 1024, WSB(WS_WL) + 256 * 1024, 256, EpiStore{WSB(WS_L1A), 128, 0});
        else gemm_fast(smem, WSB(WS_MIX) + (size_t)5 * R * 1024, 0, R, 1024, WSB(WS_WL) + 2 * 256 * 1024, 256, EpiStore{WSB(WS_L1G), 256, 2});
    }
    else if constexpr (PH == PH_L2) {
        if (x.a == 0) gemm_fast(smem, WSB(WS_L1W), 0, R, 128, WSB(WS_WL) + 3 * 256 * 1024, 2048, EpiDecay{(float*)(p.ws + WS_DEC), p.in[20]});
        else if (x.a == 1) gemm_fast(smem, WSB(WS_L1A), 0, R, 128, WSB(WS_WL) + 4 * 256 * 1024, 2048, EpiAP{WSB(WS_AP), p.in[23]});
        else gemm_fast(smem, WSB(WS_L1G), 0, R, 256, WSB(WS_WL) + 5 * 256 * 1024, 1024, EpiStore{WSB(WS_G), 1024, 0});
    }
    else if constexpr (PH == PH_KKN) phase_kkn(p);
    else if constexpr (PH == PH_SCAN) phase_scan(p, lds);
    else if constexpr (PH == PH_ROUT) phase_rout(p);
    else if constexpr (PH == PH_RO) gemm_fast(smem, WSB(WS_A2R), 0, R, 1024, WSB(WS_WOUT), 1024, EpiResid{XL, MOD + 2 * 2 * 6144, 2, nullptr, 0});
}

#define XB_TMO      128
#define XB_XCNT(j)  (256  + 64 * (j))
#define XB_XSUB(j)  (1280 + 64 * (j))
#define XB_XGEN(j)  (2304 + 64 * (j))
#define XB_TOP      3328
#define XB_TOPGEN   3392
#define XCD_BAR_WORDS 3456
#define XB_SPIN_CAP (1u << 22)
#define LAS __attribute__((address_space(3)))

__device__ __forceinline__ unsigned xb_ld(unsigned* p)              { return __hip_atomic_load(p, __ATOMIC_RELAXED, __HIP_MEMORY_SCOPE_AGENT); }
__device__ __forceinline__ unsigned xb_add(unsigned* p, unsigned v) { return __hip_atomic_fetch_add(p, v, __ATOMIC_RELAXED, __HIP_MEMORY_SCOPE_AGENT); }
__device__ __forceinline__ unsigned xb_xcc_id() { return (unsigned)__builtin_amdgcn_s_getreg((3 << 11) | 20) & 0xFu; }
#define XB_SPIN(cond, bar) do { unsigned _sp = 0; while (cond) { __builtin_amdgcn_s_sleep(1); \
    if ((++_sp & 255u) == 0u) { if (xb_ld(&(bar)[XB_TMO])) break; if (_sp > XB_SPIN_CAP) { atomicAdd(&(bar)[XB_TMO], 1u); break; } } } } while (0)

struct XcdBarrier {
    unsigned* bar; unsigned x;
    volatile LAS unsigned* st;
};

__device__ __forceinline__ XcdBarrier xcd_barrier_post(unsigned* bar, volatile LAS unsigned* st) {
    XcdBarrier b; b.bar = bar; b.x = xb_xcc_id(); b.st = st;
    if (ptid() == 0) (void)xb_add(&bar[XB_XCNT(b.x)], 1u);
    return b;
}
__device__ __forceinline__ void xcd_barrier_complete(unsigned* bar, unsigned x, unsigned& nloc, unsigned& nx) {
    const unsigned G = gridDim.x * gridDim.y * gridDim.z;
    unsigned sum, cnt, mine, sp = 0u;
    for (;;) {
        sum = 0u; cnt = 0u; mine = 0u;
#pragma unroll
        for (unsigned j = 0; j < 16; ++j) { const unsigned c = xb_ld(&bar[XB_XCNT(j)]); sum += c; cnt += (c > 0u) ? 1u : 0u; mine = (j == x) ? c : mine; }
        if (sum == G) break;
        __builtin_amdgcn_s_sleep(1);
        if ((++sp & 255u) == 0u) { if (xb_ld(&bar[XB_TMO])) break; if (sp > XB_SPIN_CAP) { atomicAdd(&bar[XB_TMO], 1u); break; } }
    }
    nloc = mine > 0u ? mine : 1u; nx = cnt > 0u ? cnt : 1u;
}

__device__ __forceinline__ void xcd_barrier(const XcdBarrier& b) {
    asm volatile("s_waitcnt vmcnt(0)" ::: "memory");
    __syncthreads();
    if (ptid() == 0) {
        unsigned* bar = b.bar;
        __builtin_amdgcn_s_waitcnt(0);
        unsigned nloc = b.st[0], nx = b.st[1];
        if (nloc == 0u) { xcd_barrier_complete(bar, b.x, nloc, nx); b.st[0] = nloc; b.st[1] = nx; }
        const unsigned old = xb_add(&bar[XB_XSUB(b.x)], 1u);
        const unsigned gen = old / nloc;
        if (old + 1u == (gen + 1u) * nloc) {
            __builtin_amdgcn_fence(__ATOMIC_RELEASE, "agent");
            asm volatile("s_waitcnt vmcnt(0)" ::: "memory");
            const unsigned og = xb_add(&bar[XB_TOP], 1u);
            const unsigned tg = og / nx;
            if (og + 1u == (tg + 1u) * nx) xb_add(&bar[XB_TOPGEN], 1u);
            else XB_SPIN(xb_ld(&bar[XB_TOPGEN]) == tg, bar);
            __builtin_amdgcn_fence(__ATOMIC_ACQUIRE, "agent");
            xb_add(&bar[XB_XGEN(b.x)], 1u);
            asm volatile("s_waitcnt vmcnt(0)" ::: "memory");
        } else {
            XB_SPIN(xb_ld(&bar[XB_XGEN(b.x)]) == gen, bar);
            __builtin_amdgcn_fence(__ATOMIC_ACQUIRE, "agent");
            asm volatile("s_waitcnt vmcnt(0)" ::: "memory");
        }
    }
    __syncthreads();
}


#define AS4 __attribute__((address_space(4)))
__device__ __forceinline__ Params fresh_params() {
    Params q;
#if defined(__HIP_DEVICE_COMPILE__)
    const AS4 unsigned long long* ka = (const AS4 unsigned long long*)__builtin_amdgcn_kernarg_segment_ptr();
    asm volatile("" : "+s"(ka));
#pragma unroll
    for (int i = 0; i < 41; ++i) q.in[i] = (const float*)ka[i];
    q.out = (float*)ka[41]; q.ws = (unsigned char*)ka[42];
#endif
    return q;
}
__global__ void __launch_bounds__(NTHR, 2) mega(Params p_unused) {
    extern __shared__ __attribute__((aligned(16))) char smem[];
    float* lds = (float*)smem;
    volatile LAS unsigned* st = (volatile LAS unsigned*)(smem + 143 * 1024);
    if (ptid() == 0) { st[0] = 0u; st[1] = 0u; st[2] = 0u; st[3] = 0u; }
    __syncthreads();
    { const Params p = fresh_params(); (void)xcd_barrier_post((unsigned*)(p.ws + WS_CTL), st); }
#define GB() do { XcdBarrier b_; b_.bar = (unsigned*)(fresh_params().ws + WS_CTL); b_.x = xb_xcc_id(); b_.st = st; xcd_barrier(b_); } while (0)
    const float QS = 0.125f * 1.4426950408889634f;
    { const Params p = fresh_params(); float* XL = (float*)(p.ws + WS_XL); const bf16_t* H = (const bf16_t*)(p.ws + WS_H); const float* MOD = (const float*)(p.ws + WS_MOD); (void)XL; (void)H; (void)MOD; phase_mod(p, lds); } { const Params p = fresh_params(); float* XL = (float*)(p.ws + WS_XL); const bf16_t* H = (const bf16_t*)(p.ws + WS_H); const float* MOD = (const float*)(p.ws + WS_MOD); (void)XL; (void)H; (void)MOD; conv_layer(p, 0, lds); } GB();
    { const Params p = fresh_params(); float* XL = (float*)(p.ws + WS_XL); const bf16_t* H = (const bf16_t*)(p.ws + WS_H); const float* MOD = (const float*)(p.ws + WS_MOD); (void)XL; (void)H; (void)MOD; phase_norm(p, 0, 0, 1, -1, 0, 0, -1, smem); } GB();
    { const Params p = fresh_params(); float* XL = (float*)(p.ws + WS_XL); const bf16_t* H = (const bf16_t*)(p.ws + WS_H); const float* MOD = (const float*)(p.ws + WS_MOD); (void)XL; (void)H; (void)MOD; gemm_fast(smem, H, 0, R, 1024, WSB(WS_WIN), 3072, EpiQKV{WSB(WS_QKV), (const float*)(p.ws + WS_TAB), QS}); } GB();
    { const Params p = fresh_params(); float* XL = (float*)(p.ws + WS_XL); const bf16_t* H = (const bf16_t*)(p.ws + WS_H); const float* MOD = (const float*)(p.ws + WS_MOD); (void)XL; (void)H; (void)MOD; phase_attn(p, 1, smem); } GB();
    { const Params p = fresh_params(); float* XL = (float*)(p.ws + WS_XL); const bf16_t* H = (const bf16_t*)(p.ws + WS_H); const float* MOD = (const float*)(p.ws + WS_MOD); (void)XL; (void)H; (void)MOD; phase_comb(p, 0, 0.2f, 0); } GB();
    { const Params p = fresh_params(); float* XL = (float*)(p.ws + WS_XL); const bf16_t* H = (const bf16_t*)(p.ws + WS_H); const float* MOD = (const float*)(p.ws + WS_MOD); (void)XL; (void)H; (void)MOD; gemm_fast(smem, WSB(WS_A2), 0, R, 1024, WSB(WS_WOUT), 1024, EpiResid{XL, MOD + 0 * 2 * 6144, 2, nullptr, 0}); } GB();
    { const Params p = fresh_params(); float* XL = (float*)(p.ws + WS_XL); const bf16_t* H = (const bf16_t*)(p.ws + WS_H); const float* MOD = (const float*)(p.ws + WS_MOD); (void)XL; (void)H; (void)MOD; phase_norm(p, 0, 1, 0, -1, 0, 0, -1, smem); } GB();
    { const Params p = fresh_params(); float* XL = (float*)(p.ws + WS_XL); const bf16_t* H = (const bf16_t*)(p.ws + WS_H); const float* MOD = (const float*)(p.ws + WS_MOD); (void)XL; (void)H; (void)MOD; gemm_fast(smem, H, 0, R, 1024, WSB(WS_WF1), 2 * FF, EpiGateUp{WSB(WS_ACT), FF}); } GB();
    { const Params p = fresh_params(); float* XL = (float*)(p.ws + WS_XL); const bf16_t* H = (const bf16_t*)(p.ws + WS_H); const float* MOD = (const float*)(p.ws + WS_MOD); (void)XL; (void)H; (void)MOD; gemm_fast(smem, WSB(WS_ACT), 0, R, FF, WSB(WS_WF2D), 1024, EpiResid{XL, MOD + 0 * 2 * 6144, 5, nullptr, 0}); } GB();
    { const Params p = fresh_params(); float* XL = (float*)(p.ws + WS_XL); const bf16_t* H = (const bf16_t*)(p.ws + WS_H); const float* MOD = (const float*)(p.ws + WS_MOD); (void)XL; (void)H; (void)MOD; conv_layer(p, 1, lds); } { const Params p = fresh_params(); float* XL = (float*)(p.ws + WS_XL); const bf16_t* H = (const bf16_t*)(p.ws + WS_H); const float* MOD = (const float*)(p.ws + WS_MOD); (void)XL; (void)H; (void)MOD; phase_norm(p, 1, 0, 0, -1, 0, 0, -1, smem); } GB();
    { const Params p = fresh_params(); float* XL = (float*)(p.ws + WS_XL); const bf16_t* H = (const bf16_t*)(p.ws + WS_H); const float* MOD = (const float*)(p.ws + WS_MOD); (void)XL; (void)H; (void)MOD; gemm_fast(smem, H, 0, R, 1024, WSB(WS_WIN), 2048, EpiGelu{WSB(WS_U), (float*)(p.ws + WS_VP)}); } GB();
    { const Params p = fresh_params(); float* XL = (float*)(p.ws + WS_XL); const bf16_t* H = (const bf16_t*)(p.ws + WS_H); const float* MOD = (const float*)(p.ws + WS_MOD); (void)XL; (void)H; (void)MOD; phase_lnv(p); } GB();
    { const Params p = fresh_params(); float* XL = (float*)(p.ws + WS_XL); const bf16_t* H = (const bf16_t*)(p.ws + WS_H); const float* MOD = (const float*)(p.ws + WS_MOD); (void)XL; (void)H; (void)MOD; phase_spat_naive(p, lds); } GB();
    { const Params p = fresh_params(); float* XL = (float*)(p.ws + WS_XL); const bf16_t* H = (const bf16_t*)(p.ws + WS_H); const float* MOD = (const float*)(p.ws + WS_MOD); (void)XL; (void)H; (void)MOD; gemm_fast(smem, WSB(WS_A2), 0, R, 1024, WSB(WS_WOUT), 1024, EpiResid{XL, MOD + 1 * 2 * 6144, 2, nullptr, 0}); } GB();
    { const Params p = fresh_params(); float* XL = (float*)(p.ws + WS_XL); const bf16_t* H = (const bf16_t*)(p.ws + WS_H); const float* MOD = (const float*)(p.ws + WS_MOD); (void)XL; (void)H; (void)MOD; phase_norm(p, 1, 1, 0, 0, 0, 0, -1, smem); } GB();
    { const Params p = fresh_params(); float* XL = (float*)(p.ws + WS_XL); const bf16_t* H = (const bf16_t*)(p.ws + WS_H); const float* MOD = (const float*)(p.ws + WS_MOD); (void)XL; (void)H; (void)MOD; phase_perm(p, 0, 0, smem); } GB();
    { const Params p = fresh_params(); float* XL = (float*)(p.ws + WS_XL); const bf16_t* H = (const bf16_t*)(p.ws + WS_H); const float* MOD = (const float*)(p.ws + WS_MOD); (void)XL; (void)H; (void)MOD; gemm_moe(smem, p, 0, WSB(WS_HP), 1024, WSB(WS_WF1), 22, EpiGateUpM{WSB(WS_ACTM)}); } GB();
    { const Params p = fresh_params(); float* XL = (float*)(p.ws + WS_XL); const bf16_t* H = (const bf16_t*)(p.ws + WS_H); const float* MOD = (const float*)(p.ws + WS_MOD); (void)XL; (void)H; (void)MOD; gemm_moe(smem, p, 0, WSB(WS_ACTM), FF, WSB(WS_WF2M), 4, EpiStoreM{WSB(WS_YM)}); } GB();
    { const Params p = fresh_params(); float* XL = (float*)(p.ws + WS_XL); const bf16_t* H = (const bf16_t*)(p.ws + WS_H); const float* MOD = (const float*)(p.ws + WS_MOD); (void)XL; (void)H; (void)MOD; conv_layer(p, 2, lds); } { const Params p = fresh_params(); float* XL = (float*)(p.ws + WS_XL); const bf16_t* H = (const bf16_t*)(p.ws + WS_H); const float* MOD = (const float*)(p.ws + WS_MOD); (void)XL; (void)H; (void)MOD; phase_norm(p, 2, 0, 0, -1, 0, 0, 1, smem); } GB();
    { const Params p = fresh_params(); float* XL = (float*)(p.ws + WS_XL); const bf16_t* H = (const bf16_t*)(p.ws + WS_H); const float* MOD = (const float*)(p.ws + WS_MOD); (void)XL; (void)H; (void)MOD; phase_mix(p); } GB();
    { const Params p = fresh_params(); float* XL = (float*)(p.ws + WS_XL); const bf16_t* H = (const bf16_t*)(p.ws + WS_H); const float* MOD = (const float*)(p.ws + WS_MOD); (void)XL; (void)H; (void)MOD; gemm_fast(smem, WSB(WS_MIX) + (size_t)0 * R * 1024, 0, R, 1024, WSB(WS_WIN), 1024, EpiStore{WSB(WS_RR), 1024, 0}); }
    { const Params p = fresh_params(); float* XL = (float*)(p.ws + WS_XL); const bf16_t* H = (const bf16_t*)(p.ws + WS_H); const float* MOD = (const float*)(p.ws + WS_MOD); (void)XL; (void)H; (void)MOD; gemm_fast(smem, WSB(WS_MIX) + (size_t)2 * R * 1024, 0, R, 1024, WSB(WS_WIN) + (size_t)1 * 1024 * 1024, 1024, EpiStore{WSB(WS_KK), 1024, 0}); }
    { const Params p = fresh_params(); float* XL = (float*)(p.ws + WS_XL); const bf16_t* H = (const bf16_t*)(p.ws + WS_H); const float* MOD = (const float*)(p.ws + WS_MOD); (void)XL; (void)H; (void)MOD; gemm_fast(smem, WSB(WS_MIX) + (size_t)3 * R * 1024, 0, R, 1024, WSB(WS_WIN) + (size_t)2 * 1024 * 1024, 1024, EpiStore{WSB(WS_VV), 1024, 0}); }
    { const Params p = fresh_params(); float* XL = (float*)(p.ws + WS_XL); const bf16_t* H = (const bf16_t*)(p.ws + WS_H); const float* MOD = (const float*)(p.ws + WS_MOD); (void)XL; (void)H; (void)MOD; gemm_fast(smem, WSB(WS_MIX) + (size_t)1 * R * 1024, 0, R, 1024, WSB(WS_WL), 256, EpiStore{WSB(WS_L1W), 128, 1}); }
    { const Params p = fresh_params(); float* XL = (float*)(p.ws + WS_XL); const bf16_t* H = (const bf16_t*)(p.ws + WS_H); const float* MOD = (const float*)(p.ws + WS_MOD); (void)XL; (void)H; (void)MOD; gemm_fast(smem, WSB(WS_MIX) + (size_t)4 * R * 1024, 0, R, 1024, WSB(WS_WL) + 256 * 1024, 256, EpiStore{WSB(WS_L1A), 128, 0}); }
    { const Params p = fresh_params(); float* XL = (float*)(p.ws + WS_XL); const bf16_t* H = (const bf16_t*)(p.ws + WS_H); const float* MOD = (const float*)(p.ws + WS_MOD); (void)XL; (void)H; (void)MOD; gemm_fast(smem, WSB(WS_MIX) + (size_t)5 * R * 1024, 0, R, 1024, WSB(WS_WL) + 2 * 256 * 1024, 256, EpiStore{WSB(WS_L1G), 256, 2}); } GB();
    { const Params p = fresh_params(); float* XL = (float*)(p.ws + WS_XL); const bf16_t* H = (const bf16_t*)(p.ws + WS_H); const float* MOD = (const float*)(p.ws + WS_MOD); (void)XL; (void)H; (void)MOD; gemm_fast(smem, WSB(WS_L1W), 0, R, 128, WSB(WS_WL) + 3 * 256 * 1024, 2048, EpiDecay{(float*)(p.ws + WS_DEC), p.in[20]}); }
    { const Params p = fresh_params(); float* XL = (float*)(p.ws + WS_XL); const bf16_t* H = (const bf16_t*)(p.ws + WS_H); const float* MOD = (const float*)(p.ws + WS_MOD); (void)XL; (void)H; (void)MOD; gemm_fast(smem, WSB(WS_L1A), 0, R, 128, WSB(WS_WL) + 4 * 256 * 1024, 2048, EpiAP{WSB(WS_AP), p.in[23]}); }
    { const Params p = fresh_params(); float* XL = (float*)(p.ws + WS_XL); const bf16_t* H = (const bf16_t*)(p.ws + WS_H); const float* MOD = (const float*)(p.ws + WS_MOD); (void)XL; (void)H; (void)MOD; gemm_fast(smem, WSB(WS_L1G), 0, R, 256, WSB(WS_WL) + 5 * 256 * 1024, 1024, EpiStore{WSB(WS_G), 1024, 0}); }
    { const Params p = fresh_params(); float* XL = (float*)(p.ws + WS_XL); const bf16_t* H = (const bf16_t*)(p.ws + WS_H); const float* MOD = (const float*)(p.ws + WS_MOD); (void)XL; (void)H; (void)MOD; phase_kkn(p); } GB();
    { const Params p = fresh_params(); float* XL = (float*)(p.ws + WS_XL); const bf16_t* H = (const bf16_t*)(p.ws + WS_H); const float* MOD = (const float*)(p.ws + WS_MOD); (void)XL; (void)H; (void)MOD; phase_scan(p, lds); } GB();
    { const Params p = fresh_params(); float* XL = (float*)(p.ws + WS_XL); const bf16_t* H = (const bf16_t*)(p.ws + WS_H); const float* MOD = (const float*)(p.ws + WS_MOD); (void)XL; (void)H; (void)MOD; phase_rout(p); } GB();
    { const Params p = fresh_params(); float* XL = (float*)(p.ws + WS_XL); const bf16_t* H = (const bf16_t*)(p.ws + WS_H); const float* MOD = (const float*)(p.ws + WS_MOD); (void)XL; (void)H; (void)MOD; gemm_fast(smem, WSB(WS_A2R), 0, R, 1024, WSB(WS_WOUT), 1024, EpiResid{XL, MOD + 2 * 2 * 6144, 2, nullptr, 0}); } GB();
    { const Params p = fresh_params(); float* XL = (float*)(p.ws + WS_XL); const bf16_t* H = (const bf16_t*)(p.ws + WS_H); const float* MOD = (const float*)(p.ws + WS_MOD); (void)XL; (void)H; (void)MOD; phase_norm(p, 2, 1, 0, -1, 0, 0, -1, smem); } GB();
    { const Params p = fresh_params(); float* XL = (float*)(p.ws + WS_XL); const bf16_t* H = (const bf16_t*)(p.ws + WS_H); const float* MOD = (const float*)(p.ws + WS_MOD); (void)XL; (void)H; (void)MOD; gemm_fast(smem, H, 0, R, 1024, WSB(WS_WF1), 2 * FF, EpiGateUp{WSB(WS_ACT), FF}); } GB();
    { const Params p = fresh_params(); float* XL = (float*)(p.ws + WS_XL); const bf16_t* H = (const bf16_t*)(p.ws + WS_H); const float* MOD = (const float*)(p.ws + WS_MOD); (void)XL; (void)H; (void)MOD; gemm_fast(smem, WSB(WS_ACT), 0, R, FF, WSB(WS_WF2D), 1024, EpiResid{XL, MOD + 2 * 2 * 6144, 5, nullptr, 0}); } GB();
    { const Params p = fresh_params(); float* XL = (float*)(p.ws + WS_XL); const bf16_t* H = (const bf16_t*)(p.ws + WS_H); const float* MOD = (const float*)(p.ws + WS_MOD); (void)XL; (void)H; (void)MOD; conv_layer(p, 3, lds); } { const Params p = fresh_params(); float* XL = (float*)(p.ws + WS_XL); const bf16_t* H = (const bf16_t*)(p.ws + WS_H); const float* MOD = (const float*)(p.ws + WS_MOD); (void)XL; (void)H; (void)MOD; phase_norm(p, 3, 0, 0, -1, 0, 0, -1, smem); } GB();
    { const Params p = fresh_params(); float* XL = (float*)(p.ws + WS_XL); const bf16_t* H = (const bf16_t*)(p.ws + WS_H); const float* MOD = (const float*)(p.ws + WS_MOD); (void)XL; (void)H; (void)MOD; gemm_fast(smem, H, 0, R, 1024, WSB(WS_WIN), 3072, EpiQKV{WSB(WS_QKV), (const float*)(p.ws + WS_TAB), QS}); } GB();
    { const Params p = fresh_params(); float* XL = (float*)(p.ws + WS_XL); const bf16_t* H = (const bf16_t*)(p.ws + WS_H); const float* MOD = (const float*)(p.ws + WS_MOD); (void)XL; (void)H; (void)MOD; phase_attn(p, 0, smem); } GB();
    { const Params p = fresh_params(); float* XL = (float*)(p.ws + WS_XL); const bf16_t* H = (const bf16_t*)(p.ws + WS_H); const float* MOD = (const float*)(p.ws + WS_MOD); (void)XL; (void)H; (void)MOD; phase_comb(p, 1, 0.8f - 0.6f * 0.40656965974059911f, RC); } GB();
    { const Params p = fresh_params(); float* XL = (float*)(p.ws + WS_XL); const bf16_t* H = (const bf16_t*)(p.ws + WS_H); const float* MOD = (const float*)(p.ws + WS_MOD); (void)XL; (void)H; (void)MOD; gemm_fast(smem, WSB(WS_A2), RC, R - RC, 1024, WSB(WS_WOUT), 1024, EpiResid{XL, MOD + 3 * 2 * 6144, 2, nullptr, 0}); } GB();
    { const Params p = fresh_params(); float* XL = (float*)(p.ws + WS_XL); const bf16_t* H = (const bf16_t*)(p.ws + WS_H); const float* MOD = (const float*)(p.ws + WS_MOD); (void)XL; (void)H; (void)MOD; phase_norm(p, 3, 1, 0, 1, RC, 0, -1, smem); } GB();
    { const Params p = fresh_params(); float* XL = (float*)(p.ws + WS_XL); const bf16_t* H = (const bf16_t*)(p.ws + WS_H); const float* MOD = (const float*)(p.ws + WS_MOD); (void)XL; (void)H; (void)MOD; phase_perm(p, 1, RC, smem); } GB();
    { const Params p = fresh_params(); float* XL = (float*)(p.ws + WS_XL); const bf16_t* H = (const bf16_t*)(p.ws + WS_H); const float* MOD = (const float*)(p.ws + WS_MOD); (void)XL; (void)H; (void)MOD; gemm_moe(smem, p, 1, WSB(WS_HP), 1024, WSB(WS_WF1), 22, EpiGateUpM{WSB(WS_ACTM)}); } GB();
    { const Params p = fresh_params(); float* XL = (float*)(p.ws + WS_XL); const bf16_t* H = (const bf16_t*)(p.ws + WS_H); const float* MOD = (const float*)(p.ws + WS_MOD); (void)XL; (void)H; (void)MOD; gemm_moe(smem, p, 1, WSB(WS_ACTM), FF, WSB(WS_WF2M), 4, EpiStoreM{WSB(WS_YM)}); } GB();
    { const Params p = fresh_params(); float* XL = (float*)(p.ws + WS_XL); const bf16_t* H = (const bf16_t*)(p.ws + WS_H); const float* MOD = (const float*)(p.ws + WS_MOD); (void)XL; (void)H; (void)MOD; phase_norm(p, 0, 0, 0, -1, RC, 1, 3, smem); }
#undef GB
}

constexpr int LDS_BYTES = 144 * 1024;
template <int PH> void launch(const Params& p, hipStream_t s, int a = 0, int b = 0, int c = 0, int d = 0, int e = 0, int f = 0) {
    static bool attr = false;
    if (!attr) { (void)hipFuncSetAttribute((const void*)kph<PH>, hipFuncAttributeMaxDynamicSharedMemorySize, LDS_BYTES); attr = true; }
    PhArgs x{a, b, c, d, e, f};
    hipLaunchKernelGGL(kph<PH>, dim3(256), dim3(NTHR), LDS_BYTES, s, p, x);
}
inline int f2i(float f) { int i; memcpy(&i, &f, 4); return i; }
}

extern "C" void kernel_launch(void* const* d_in, const int* in_sizes, int n_in, void* d_out, int out_size, void* d_ws, size_t ws_size, hipStream_t stream) {
    Params p; memset(&p, 0, sizeof(p));
    for (int i = 0; i < 41; ++i) p.in[i] = (const float*)d_in[i];
    p.out = (float*)d_out; p.ws = (unsigned char*)d_ws;
    hipStream_t s = stream;
    (void)hipMemsetAsync(d_ws, 0, 1 * MiB, s);
#if FUSED
    static int grid = 0;
    if (!grid) {
        int dev = 0, cus = 0;
        (void)hipGetDevice(&dev); (void)hipDeviceGetAttribute(&cus, hipDeviceAttributeMultiprocessorCount, dev);
        (void)hipFuncSetAttribute((const void*)mega, hipFuncAttributeMaxDynamicSharedMemorySize, LDS_BYTES);
        grid = cus > 0 ? cus : 256;
    }
    hipLaunchKernelGGL(mega, dim3(grid), dim3(NTHR), LDS_BYTES, s, p);
#else
    launch<PH_MOD>(p, s);
    launch<PH_CONV>(p, s, 0);
    launch<PH_NORM>(p, s, 0, 0, 1, -1, 0, 0);
    launch<PH_QKV>(p, s, 0);
    launch<PH_ATT>(p, s, 1);
    launch<PH_COMB>(p, s, 0, f2i(0.2f), 0);
    launch<PH_OPROJ>(p, s, 0, 0, 0);
    launch<PH_NORM>(p, s, 0, 1, 0, -1, 0, 0);
    launch<PH_F1>(p, s, 0);
    launch<PH_F2>(p, s, 0, 0);
    launch<PH_CONV>(p, s, 1);
    launch<PH_NORM>(p, s, 1, 0, 0, -1, 0, 0);
    launch<PH_GI>(p, s);
    launch<PH_LNV>(p, s);
    launch<PH_SPAT>(p, s);
    launch<PH_GO>(p, s);
    launch<PH_NORM>(p, s, 1, 1, 0, 0, 0, 0);
    launch<PH_PERM>(p, s, 0, 0); launch<PH_M1G>(p, s, 0); launch<PH_M2G>(p, s, 0);
    launch<PH_CONV>(p, s, 2);
    launch<PH_NORM>(p, s, 2, 0, (1 + 1) << 1, -1, 0, 0);
    launch<PH_MIX>(p, s);
    for (int q = 0; q < 3; ++q) launch<PH_RKV>(p, s, q);
    for (int q = 0; q < 3; ++q) launch<PH_L1>(p, s, q);
    for (int q = 0; q < 3; ++q) launch<PH_L2>(p, s, q);
    launch<PH_KKN>(p, s);
    launch<PH_SCAN>(p, s);
    launch<PH_ROUT>(p, s);
    launch<PH_RO>(p, s);
    launch<PH_NORM>(p, s, 2, 1, 0, -1, 0, 0);
    launch<PH_F1>(p, s, 1);
    launch<PH_F2>(p, s, 1, 2);
    launch<PH_CONV>(p, s, 3);
    launch<PH_NORM>(p, s, 3, 0, 0, -1, 0, 0);
    launch<PH_QKV>(p, s, 1);
    launch<PH_ATT>(p, s, 0);
    launch<PH_COMB>(p, s, 1, f2i(0.8f - 0.6f * expf(-0.9f)), RC);
    launch<PH_OPROJ>(p, s, 1, 3, RC);
    launch<PH_NORM>(p, s, 3, 1, 0, 1, RC, 0);
    launch<PH_PERM>(p, s, 1, RC); launch<PH_M1G>(p, s, 1); launch<PH_M2G>(p, s, 1);
    launch<PH_NORM>(p, s, 0, 0, (3 + 1) << 1, -1, RC, 1);
#endif
}
```

```cpp
#include <hip/hip_runtime.h>
#include <stdint.h>
#include <math.h>
#include <string.h>

namespace {
constexpr int D = 1024, RC = 256, RL = 16384, R = RC + RL, FF = 2816, NTHR = 512;
typedef unsigned short bf16_t;
typedef float f32x4 __attribute__((ext_vector_type(4)));
typedef unsigned u32x4 __attribute__((ext_vector_type(4)));
typedef unsigned u32x2 __attribute__((ext_vector_type(2)));

struct Params { const float* in[41]; float* out; unsigned char* ws; };

constexpr size_t MiB = 1u << 20;
constexpr size_t WS_MOD = 1 * MiB;
constexpr size_t WS_TAB = 2 * MiB;
constexpr size_t WS_ROUTE = 3 * MiB;
constexpr size_t WS_KN = 4 * MiB;
constexpr size_t WS_CTL = 0;
constexpr int CW_MOE = 8192;
constexpr size_t WS_RTG = WS_ROUTE + 512 * 1024;
constexpr size_t WS_SLOT = WS_ROUTE + 768 * 1024;
constexpr size_t WS_BS = 6 * MiB;
constexpr size_t WS_XL = 8 * MiB;
constexpr size_t WS_H = 73 * MiB;
constexpr size_t WS_S = 106 * MiB;
constexpr size_t WS_QKV = WS_S;
constexpr size_t WS_O = WS_S + 98 * MiB;
constexpr size_t WS_A2 = WS_S + 228 * MiB;
constexpr size_t WS_VT = WS_S + 300 * MiB;
constexpr size_t WS_O0 = WS_S + 340 * MiB;
constexpr size_t WS_ACT = WS_S;
constexpr size_t WS_U = WS_S;
constexpr size_t WS_VP = WS_S + 33 * MiB;
constexpr size_t WS_VN = WS_S + 98 * MiB;
constexpr size_t WS_MIX = WS_S;
constexpr size_t WS_DEC = WS_S;
constexpr size_t WS_AP = WS_S + 130 * MiB;
constexpr size_t WS_RR = WS_S + 196 * MiB;
constexpr size_t WS_KK = WS_S + 229 * MiB;
constexpr size_t WS_VV = WS_S + 262 * MiB;
constexpr size_t WS_L1W = WS_S + 295 * MiB;
constexpr size_t WS_L1A = WS_S + 300 * MiB;
constexpr size_t WS_L1G = WS_S + 305 * MiB;
constexpr size_t WS_G = WS_S + 314 * MiB;
constexpr size_t WS_Y = WS_S + 347 * MiB;
constexpr size_t WS_A2R = WS_S + 478 * MiB;
constexpr size_t WS_HP = WS_S;
constexpr size_t WS_ACTM = WS_S + 69 * MiB;
constexpr size_t WS_YM = WS_S + 259 * MiB;
constexpr size_t WS_END = WS_S + 512 * MiB;
constexpr size_t WS_W = 620 * MiB;
constexpr size_t WS_WIN = WS_W;
constexpr size_t WS_WOUT = WS_W + 6 * MiB;
constexpr size_t WS_WF1 = WS_W + 8 * MiB;
constexpr size_t WS_WF2D = WS_W + 19 * MiB;
constexpr size_t WS_WF2M = WS_W + 96 * MiB;
constexpr size_t WS_WOUT2 = WS_W + 25 * MiB;
constexpr size_t WS_WL = WS_W + 27 * MiB;
constexpr size_t WS_WSPAT = WS_W + 4 * MiB;
constexpr size_t WS_WEND = WS_W + 140 * MiB;


__device__ __forceinline__ int ptid() { int t = (int)__builtin_amdgcn_workitem_id_x(); asm volatile("" : "+v"(t)); return t; }
#define WSB(off) ((bf16_t*)(p.ws + (off)))
template <int CTRL> __device__ __forceinline__ float dppmov(float v) { return __builtin_bit_cast(float, __builtin_amdgcn_update_dpp(0, __builtin_bit_cast(int, v), CTRL, 0xf, 0xf, true)); }
__device__ __forceinline__ float bf2f(unsigned b) { return __uint_as_float(b << 16); }
typedef __bf16 bf16x2_t __attribute__((ext_vector_type(2))); typedef float f32x2_t __attribute__((ext_vector_type(2)));
__device__ __forceinline__ unsigned pk2(float lo, float hi) { const f32x2_t v = {lo, hi}; const bf16x2_t b = __builtin_convertvector(v, bf16x2_t); return __builtin_bit_cast(unsigned, b); }
__device__ __forceinline__ unsigned f2bf(float f) { return pk2(f, 0.f) & 0xffffu; }
#define DPPF " row_mask:0xf bank_mask:0xf bound_ctrl:1\n\t"
__device__ __forceinline__ float wave_total1(float x) {
    float t; int r;
    asm volatile("s_nop 1\n\t"
        "v_add_f32_dpp %0, %2, %2 row_shr:1" DPPF
        "v_add_f32_dpp %0, %2, %0 row_shr:2" DPPF
        "v_add_f32_dpp %0, %2, %0 row_shr:3" DPPF
        "s_nop 1\n\t"
        "v_add_f32_dpp %0, %0, %0 row_shr:4 row_mask:0xf bank_mask:0xe\n\t"
        "s_nop 1\n\t"
        "v_add_f32_dpp %0, %0, %0 row_shr:8 row_mask:0xf bank_mask:0xc\n\t"
        "s_nop 1\n\t"
        "v_add_f32_dpp %0, %0, %0 row_bcast:15 row_mask:0xa bank_mask:0xf\n\t"
        "s_nop 1\n\t"
        "v_add_f32_dpp %0, %0, %0 row_bcast:31 row_mask:0xc bank_mask:0xf\n\t"
        "s_nop 1\n\t"
        "v_readlane_b32 %1, %0, 63\n\t"
        "s_nop 1"
        : "=&v"(t), "=s"(r) : "v"(x));
    return __builtin_bit_cast(float, r);
}
__device__ __forceinline__ void wave_total2(float x1, float x2, float& o1, float& o2) {
    float t1, t2; int r1, r2;
    asm volatile("s_nop 1\n\t"
        "v_add_f32_dpp %0, %4, %4 row_shr:1" DPPF
        "v_add_f32_dpp %1, %5, %5 row_shr:1" DPPF
        "v_add_f32_dpp %0, %4, %0 row_shr:2" DPPF
        "v_add_f32_dpp %1, %5, %1 row_shr:2" DPPF
        "v_add_f32_dpp %0, %4, %0 row_shr:3" DPPF
        "v_add_f32_dpp %1, %5, %1 row_shr:3" DPPF
        "s_nop 0\n\t"
        "v_add_f32_dpp %0, %0, %0 row_shr:4 row_mask:0xf bank_mask:0xe\n\t"
        "v_add_f32_dpp %1, %1, %1 row_shr:4 row_mask:0xf bank_mask:0xe\n\t"
        "s_nop 0\n\t"
        "v_add_f32_dpp %0, %0, %0 row_shr:8 row_mask:0xf bank_mask:0xc\n\t"
        "v_add_f32_dpp %1, %1, %1 row_shr:8 row_mask:0xf bank_mask:0xc\n\t"
        "s_nop 0\n\t"
        "v_add_f32_dpp %0, %0, %0 row_bcast:15 row_mask:0xa bank_mask:0xf\n\t"
        "v_add_f32_dpp %1, %1, %1 row_bcast:15 row_mask:0xa bank_mask:0xf\n\t"
        "s_nop 0\n\t"
        "v_add_f32_dpp %0, %0, %0 row_bcast:31 row_mask:0xc bank_mask:0xf\n\t"
        "v_add_f32_dpp %1, %1, %1 row_bcast:31 row_mask:0xc bank_mask:0xf\n\t"
        "s_nop 0\n\t"
        "v_readlane_b32 %2, %0, 63\n\t"
        "v_readlane_b32 %3, %1, 63\n\t"
        "s_nop 1"
        : "=&v"(t1), "=&v"(t2), "=s"(r1), "=s"(r2) : "v"(x1), "v"(x2));
    o1 = __builtin_bit_cast(float, r1); o2 = __builtin_bit_cast(float, r2);
}
__device__ __forceinline__ float wave_sum(float v) { return wave_total1(v); }
__device__ __forceinline__ float sigmoidf_(float x) { return __builtin_amdgcn_rcpf(1.f + __builtin_amdgcn_exp2f(x * -1.4426950408889634f)); }
__device__ __forceinline__ float tanhf_(float x) { const float e = __builtin_amdgcn_exp2f(fminf(x, 20.f) * 2.8853900817779268f); return 1.f - 2.f * __builtin_amdgcn_rcpf(1.f + e); }
__device__ __forceinline__ float siluf_(float x) { return x * __builtin_amdgcn_rcpf(1.f + __builtin_amdgcn_exp2f(x * -1.4426950408889634f)); }
__device__ __forceinline__ float geluf_(float v) {
    const float t = __builtin_amdgcn_rcpf(fabsf(v) * 0.2316418882f + 1.0f);
    float q = t * 0.5307027145f + (-0.7265760135f); q = q * t + 0.7107068705f; q = q * t + (-0.142248368f); q = q * t + 0.127414796f; q = q * t;
    const float e = __builtin_amdgcn_exp2f(v * v * (-0.72134752044f));
    const float m = v * (q * e);
    return v < 0.f ? m : v - m;
}

struct BPlain { const float* W; int ldb; __device__ __forceinline__ float operator()(int k, int n) const { return W[(size_t)k * ldb + n]; } };
struct BGateUp { const float* W1; const float* W3; int ldb; __device__ __forceinline__ float operator()(int k, int n) const { const uintptr_t a = (uintptr_t)W1, d = (uintptr_t)W3 - (uintptr_t)W1; return ((const __attribute__((address_space(1))) float*)(a + (uintptr_t)(n & 1) * d))[(size_t)k * ldb + (n >> 1)]; } };
__device__ __forceinline__ int qk_orig_col(int n) { if (n >= 2048) return n; const int p = n & 63; return (n & ~63) + ((p >> 5) << 5) + ((p & 1) << 4) + ((p & 31) >> 1); }
struct BQKV { const float* W; __device__ __forceinline__ float operator()(int k, int n) const { return W[(size_t)k * 3072 + qk_orig_col(n)]; } };
struct BLora1 { const float* W;   __device__ __forceinline__ float operator()(int k, int n) const { return n < 128 ? W[(size_t)(n >> 6) * 65536 + (size_t)k * 64 + (n & 63)] : 0.f; } };
struct BLora2 { const float* W;   __device__ __forceinline__ float operator()(int k, int n) const { const int z = n >> 10; return ((k >> 6) == z) ? W[(size_t)z * 65536 + (size_t)(k & 63) * 1024 + (n & 1023)] : 0.f; } };
struct BG1 { const float* W;   __device__ __forceinline__ float operator()(int k, int n) const { return n < 160 ? W[(size_t)k * 160 + n] : 0.f; } };
struct BG2 { const float* W;   __device__ __forceinline__ float operator()(int k, int n) const { return k < 160 ? W[(size_t)k * 1024 + n] : 0.f; } };

struct EpiQKV {
    bf16_t* QKV; const float* tab; float qscale;
    __device__ __forceinline__ void operator()(int row, int col0, float (&v)[8]) const {
        if (col0 < 2048 && row >= RC) {
            const int t = row - RC, p0 = col0 & 63, pos = (p0 >> 5) ? (t & 63) : (t >> 6), i0 = (p0 & 31) >> 1;
            const f32x4 t0 = *(const f32x4*)(tab + (pos * 16 + i0) * 2), t1 = *(const f32x4*)(tab + (pos * 16 + i0) * 2 + 4);
            const float cs[8] = {t0[0], t0[1], t0[2], t0[3], t1[0], t1[1], t1[2], t1[3]};
#pragma unroll
            for (int j = 0; j < 4; ++j) { const float c = cs[2 * j], s = cs[2 * j + 1], e = v[2 * j], o = v[2 * j + 1]; v[2 * j] = e * c - o * s; v[2 * j + 1] = o * c + e * s; }
        }
        if (col0 < 1024) {
#pragma unroll
            for (int j = 0; j < 8; ++j) v[j] *= qscale;
        }
        u32x4 w = {pk2(v[0], v[1]), pk2(v[2], v[3]), pk2(v[4], v[5]), pk2(v[6], v[7])};
        *(u32x4*)(QKV + (size_t)row * 3072 + col0) = w;
        if (col0 >= 2048) {
            bf16_t* vt = QKV + (WS_VT - WS_QKV) / 2 + (size_t)(col0 - 2048) * R + row;
#pragma unroll
            for (int j = 0; j < 4; ++j) { vt[(size_t)(2 * j) * R] = (bf16_t)(w[j] & 0xffffu); vt[(size_t)(2 * j + 1) * R] = (bf16_t)(w[j] >> 16); }
        }
    }
};
struct EpiResid {
    bf16_t* XL; const float* modl; int which; const int* route; int expert;
    const float* xin = nullptr; const float* cin = nullptr;
    __device__ __forceinline__ void operator()(int row, int col0, float (&v)[8]) const {
        const float* m = modl + (row < RC ? 6144 : 0) + which * 1024 + col0;
        float gate = 1.f;
        if (route) { const int* rt = route + (size_t)row * 4; gate = (rt[0] == expert ? __int_as_float(rt[2]) : 0.f) + (rt[1] == expert ? __int_as_float(rt[3]) : 0.f); }
        bf16_t* x = XL + (size_t)row * 1024 + col0;
        f32x4 a, b;
        if (xin) { const float* xs = row < RC ? cin + (size_t)row * 1024 + col0 : xin + (size_t)(row - RC) * 1024 + col0; a = *(const f32x4*)xs; b = *(const f32x4*)(xs + 4); }
        else { const u32x4 r = *(const u32x4*)x;
            a[0] = bf2f(r[0]); a[1] = __uint_as_float(r[0] & 0xffff0000u); a[2] = bf2f(r[1]); a[3] = __uint_as_float(r[1] & 0xffff0000u);
            b[0] = bf2f(r[2]); b[1] = __uint_as_float(r[2] & 0xffff0000u); b[2] = bf2f(r[3]); b[3] = __uint_as_float(r[3] & 0xffff0000u); }
        a[0] += m[0] * v[0] * gate; a[1] += m[1] * v[1] * gate; a[2] += m[2] * v[2] * gate; a[3] += m[3] * v[3] * gate;
        b[0] += m[4] * v[4] * gate; b[1] += m[5] * v[5] * gate; b[2] += m[6] * v[6] * gate; b[3] += m[7] * v[7] * gate;
        const u32x4 w = {pk2(a[0], a[1]), pk2(a[2], a[3]), pk2(b[0], b[1]), pk2(b[2], b[3])};
        *(u32x4*)x = w;
    }
};
struct EpiGateUp {
    bf16_t* ACT; int ld;
    __device__ __forceinline__ void operator()(int row, int col0, float (&v)[8]) const {
        float a[4];
#pragma unroll
        for (int j = 0; j < 4; ++j) a[j] = siluf_(v[2 * j]) * v[2 * j + 1];
        u32x2 w = {pk2(a[0], a[1]), pk2(a[2], a[3])};
        *(u32x2*)(ACT + (size_t)row * ld + (col0 >> 1)) = w;
    }
};
struct EpiGelu {
    bf16_t* U; bf16_t* VP;
    __device__ __forceinline__ void operator()(int row, int col0, float (&v)[8]) const {
#pragma unroll
        for (int j = 0; j < 8; ++j) v[j] = geluf_(v[j]);
        const u32x4 w = {pk2(v[0], v[1]), pk2(v[2], v[3]), pk2(v[4], v[5]), pk2(v[6], v[7])};
        *(u32x4*)((col0 < 1024 ? U + col0 : VP + (col0 - 1024)) + (size_t)row * 1024) = w;
    }
};
struct EpiStore {
    bf16_t* O; int ld; int act;
    __device__ __forceinline__ void operator()(int row, int col0, float (&v)[8]) const {
        if (col0 >= ld) return;
#pragma unroll
        for (int j = 0; j < 8; ++j) { if (act == 1) v[j] = tanhf_(v[j]); else if (act == 2) v[j] = sigmoidf_(v[j]); }
        u32x4 w = {pk2(v[0], v[1]), pk2(v[2], v[3]), pk2(v[4], v[5]), pk2(v[6], v[7])};
        *(u32x4*)(O + (size_t)row * ld + col0) = w;
    }
};
struct EpiDecay {
    _Float16* DEC; const float* w0;
    __device__ __forceinline__ void operator()(int row, int col0, float (&v)[8]) const {
        const int z = col0 >> 10, d0 = col0 & 1023;
        const f32x4 wa = *(const f32x4*)(w0 + z * 1024 + d0), wb = *(const f32x4*)(w0 + z * 1024 + d0 + 4);
        _Float16* p = DEC + ((size_t)z * R + row) * 1024 + d0;
#pragma unroll
        for (int h = 0; h < 2; ++h) {
            f32x4 o;
#pragma unroll
            for (int j = 0; j < 4; ++j) { const float y = -((h ? wb[j] : wa[j]) + v[h * 4 + j]); const float t = __builtin_amdgcn_exp2f(-fabsf(y) * 1.4426950408889634f);
                const float sp = fmaxf(y, 0.f) + __builtin_amdgcn_logf(1.f + t) * 0.6931471805599453f; const float wl = -sp - 0.5f; o[j] = __builtin_amdgcn_exp2f(-1.4426950408889634f * __builtin_amdgcn_exp2f(wl * 1.4426950408889634f)); }
            typedef _Float16 h4_t __attribute__((ext_vector_type(4)));
            *(h4_t*)(p + h * 4) = (h4_t){(_Float16)o[0], (_Float16)o[1], (_Float16)o[2], (_Float16)o[3]};
            __builtin_amdgcn_sched_barrier(0);
        }
    }
};
struct EpiAP {
    bf16_t* AP; const float* a0;
    __device__ __forceinline__ void operator()(int row, int col0, float (&v)[8]) const {
        const int z = col0 >> 10, d0 = col0 & 1023;
        float o[8];
#pragma unroll
        for (int j = 0; j < 8; ++j) o[j] = sigmoidf_(a0[z * 1024 + d0 + j] + v[j]);
        u32x4 w = {pk2(o[0], o[1]), pk2(o[2], o[3]), pk2(o[4], o[5]), pk2(o[6], o[7])};
        *(u32x4*)(AP + ((size_t)z * R + row) * 1024 + d0) = w;
    }
};


namespace pg8 {
#define PG8_LAS __attribute__((address_space(3)))
typedef unsigned short bf16_t;
typedef short bf16x8 __attribute__((ext_vector_type(8)));
typedef float f32x4 __attribute__((ext_vector_type(4)));
typedef unsigned u32x4 __attribute__((ext_vector_type(4)));
constexpr int BM = 256, BK = 64, HALF = 128, HTB = HALF * BK * 2  , STAGE_BYTES = 8 * HTB, NXCD = 8, WGM = 8;

__host__ __device__ __forceinline__ int lds_byte(int r, int c) { const int st = (r >> 4) * 2 + (c >> 5), rr = r & 15, cc = c & 31, ob = rr * 64 + cc * 2; return st * 1024 + (ob ^ (((ob >> 9) & 1) << 5)); }
__host__ __device__ __forceinline__ void stage_rc(int b, int& R, int& C) { const int st = b / 1024, sb = b % 1024, swz = sb ^ (((sb >> 9) & 1) << 5); R = (st >> 1) * 16 + swz / 64; C = (st & 1) * 32 + (swz % 64) / 2; }
__host__ __device__ __forceinline__ int perm32(int rho) { const int n = rho >> 4, i = rho & 15; return 8 * (i >> 2) + 4 * n + (i & 3); }

struct Unit { int pm, pn; };
struct Gemm { const bf16_t* A; const bf16_t* Bt; int M, N, K; };

struct StaticOrder {
    int nM, nN, nwg, G, c;
    __host__ __device__ void init(int M, int N, int G_, int c_) { nM = M / BM; nN = N / BM; nwg = nM * nN; G = G_; c = c_; }
    __host__ __device__ bool next(int i, Unit& u) const {
        const long L = (long)i * G + c; if (L >= nwg) return false;
        int wgid = (int)L; { const int q = nwg / NXCD, r = nwg % NXCD, xcd = wgid % NXCD, off = wgid / NXCD; wgid = (xcd < r ? xcd * (q + 1) : r * (q + 1) + (xcd - r) * q) + off; }
        const int nig = WGM * nN, gid = wgid / nig, fm = gid * WGM, gsz = (nM - fm) < WGM ? (nM - fm) : WGM;
        u.pm = fm + ((wgid % nig) % gsz); u.pn = (wgid % nig) / gsz; return true;
    }
    __device__ __forceinline__ void a_ready(const Unit&) const {}
    __device__ __forceinline__ void done(const Unit&) const {}
};

__device__ __forceinline__ unsigned cvt_pk_bf16(float lo, float hi) { unsigned r; asm volatile("v_cvt_pk_bf16_f32 %0, %1, %2" : "=v"(r) : "v"(lo), "v"(hi)); return r; }

template <class Epi, class Sched, bool ALIGN_EPI = false, bool SP2 = false>
__device__ __forceinline__ void gemm_phase(PG8_LAS unsigned char* lds, const Gemm g, const Sched& S, const Epi& E) {
    const int tid = ptid(), wid = __builtin_amdgcn_readfirstlane(tid >> 6), lane = tid & 63, wr = wid >> 2, wc = wid & 3, fr = lane & 15, fq = lane >> 4;
    const int K = g.K, nt = K / BK;
    unsigned voffA[2], voffB[2];
#pragma unroll
    for (int i = 0; i < 2; ++i) { int R, C; stage_rc(tid * 16 + i * 8192, R, C); const int Rb = Epi::PERM ? ((R & ~31) + perm32(R & 31)) : R;
        voffA[i] = (unsigned)(R * K + C) * 2u; voffB[i] = (unsigned)(Rb * K + C) * 2u; }
    const size_t kstep = (size_t)(BK * 2);
    const size_t hstep = (size_t)HALF * K * 2;
    const size_t tstep = 2 * hstep;
    const unsigned ldsw = (unsigned)wid * 1024u;
    const int aoff = lds_byte(wr * 64 + fr, fq * 8), boff = lds_byte(wc * 32 + fr, fq * 8);
#define PG8_SA(b, h) (((b) * 2 + (h)) * HTB)
#define PG8_SB(b, h) ((4 + (b) * 2 + (h)) * HTB)
#define PG8_STAGE(bufoff, gbase, voff) do { _Pragma("unroll") for (int _i = 0; _i < 2; ++_i) \
        __builtin_amdgcn_global_load_lds((const unsigned*)((const char*)(gbase) + (voff)[_i]), (PG8_LAS unsigned*)(lds + (bufoff) + ldsw + _i * 8192), 16, 0, 0); } while (0)
#define PG8_LDA(dst, b, h) do { _Pragma("unroll") for (int m = 0; m < 4; ++m) _Pragma("unroll") for (int k = 0; k < 2; ++k) dst[m][k] = *(const PG8_LAS bf16x8*)(lds + PG8_SA(b, h) + aoff + m * 2048 + k * 1024); } while (0)
#define PG8_LDB(dst, b, h) do { _Pragma("unroll") for (int n = 0; n < 2; ++n) _Pragma("unroll") for (int k = 0; k < 2; ++k) dst[n][k] = *(const PG8_LAS bf16x8*)(lds + PG8_SB(b, h) + boff + n * 2048 + k * 1024); } while (0)
#define PG8_MMA(ai, bj, At, Bt) do { __builtin_amdgcn_s_setprio(1); _Pragma("unroll") for (int m = 0; m < 4; ++m) _Pragma("unroll") for (int n = 0; n < 2; ++n) _Pragma("unroll") for (int k = 0; k < 2; ++k) \
        acc[ai][bj][m][n] = __builtin_amdgcn_mfma_f32_16x16x32_bf16(Bt[n][k], At[m][k], acc[ai][bj][m][n], 0, 0, 0); __builtin_amdgcn_s_setprio(0); } while (0)
#define PG8_WAIT_V(n) asm volatile("s_waitcnt vmcnt(" #n ")" ::: "memory")
#define PG8_WAIT_L(n) asm volatile("s_waitcnt lgkmcnt(" #n ")" ::: "memory")
#define PG8_BAR __builtin_amdgcn_s_barrier()
#define PG8_SCHED __builtin_amdgcn_sched_barrier(0)
    Unit cur, nxt; int ui = 0;
    if (!S.next(0, cur)) return;
    f32x4 acc[2][2][4][2];
#pragma unroll
    for (int a = 0; a < 2; ++a)
#pragma unroll
        for (int b = 0; b < 2; ++b)
#pragma unroll
            for (int m = 0; m < 4; ++m)
#pragma unroll
                for (int n = 0; n < 2; ++n) acc[a][b][m][n] = (f32x4){0.f, 0.f, 0.f, 0.f};
    bf16x8 At[4][2], B0[2][2], B1[2][2];
    const char* cA = (const char*)g.A + (size_t)cur.pm * tstep; const char* cB = (const char*)g.Bt + (size_t)cur.pn * tstep;
    S.a_ready(cur);
    if constexpr (SP2) {
        PG8_STAGE(PG8_SB(0, 0), cB, voffB); PG8_STAGE(PG8_SB(0, 1), cB + hstep, voffB); PG8_STAGE(PG8_SA(0, 0), cA, voffA); PG8_STAGE(PG8_SA(0, 1), cA + hstep, voffA);
        if (wr == 1) PG8_BAR;
        PG8_WAIT_V(2); PG8_BAR;
        PG8_STAGE(PG8_SB(1, 0), cB + kstep, voffB); PG8_STAGE(PG8_SA(1, 0), cA + kstep, voffA); PG8_STAGE(PG8_SB(1, 1), cB + hstep + kstep, voffB);
        PG8_WAIT_V(6); PG8_BAR;
    } else {
        PG8_STAGE(PG8_SB(0, 0), cB, voffB); PG8_STAGE(PG8_SA(0, 0), cA, voffA); PG8_STAGE(PG8_SB(0, 1), cB + hstep, voffB); PG8_STAGE(PG8_SA(0, 1), cA + hstep, voffA);
        if (wr == 1) PG8_BAR;
        PG8_WAIT_V(4); PG8_BAR;
        PG8_STAGE(PG8_SB(1, 0), cB + kstep, voffB); PG8_STAGE(PG8_SA(1, 0), cA + kstep, voffA); PG8_STAGE(PG8_SB(1, 1), cB + hstep + kstep, voffB);
        PG8_WAIT_V(6); PG8_BAR;
    }
    for (;;) {
        const bool has_next = S.next(ui + 1, nxt);
        const char* nA = has_next ? (const char*)g.A + (size_t)nxt.pm * tstep : cA; const char* nB = has_next ? (const char*)g.Bt + (size_t)nxt.pn * tstep : cB;
        for (int t = 0; t < nt; t += 2) {
            const bool last = (t == nt - 2);
            const char* a1 = cA + (size_t)(t + 1) * kstep;
            const char* a2 = last ? nA : cA + (size_t)(t + 2) * kstep; const char* b2 = last ? nB : cB + (size_t)(t + 2) * kstep;
            const char* a3 = a2 + kstep; const char* b3 = b2 + kstep;
            if (last && has_next) S.a_ready(nxt);
            if constexpr (SP2) {
            PG8_LDB(B0, 0, 0); PG8_LDB(B1, 0, 1); PG8_SCHED; PG8_LDA(At, 0, 0); PG8_STAGE(PG8_SA(1, 1), a1 + hstep, voffA);
            PG8_WAIT_V(8); PG8_WAIT_L(0); PG8_BAR; PG8_MMA(0, 0, At, B0); PG8_MMA(0, 1, At, B1); PG8_BAR; PG8_SCHED;
            PG8_LDA(At, 0, 1); PG8_STAGE(PG8_SB(0, 0), b2, voffB); PG8_STAGE(PG8_SB(0, 1), b2 + hstep, voffB); PG8_STAGE(PG8_SA(0, 0), a2, voffA);
            PG8_WAIT_V(8); PG8_WAIT_L(0); PG8_BAR; PG8_MMA(1, 0, At, B0); PG8_MMA(1, 1, At, B1); PG8_BAR; PG8_SCHED;
            PG8_LDB(B0, 1, 0); PG8_LDB(B1, 1, 1); PG8_SCHED; PG8_LDA(At, 1, 0); PG8_STAGE(PG8_SA(0, 1), a2 + hstep, voffA);
            PG8_WAIT_V(8); PG8_WAIT_L(0); PG8_BAR; PG8_MMA(0, 0, At, B0); PG8_MMA(0, 1, At, B1); PG8_BAR; PG8_SCHED;
            PG8_LDA(At, 1, 1); PG8_STAGE(PG8_SB(1, 0), b3, voffB); PG8_STAGE(PG8_SB(1, 1), b3 + hstep, voffB); PG8_STAGE(PG8_SA(1, 0), a3, voffA);
            PG8_WAIT_V(8); PG8_WAIT_L(0); PG8_BAR; PG8_MMA(1, 0, At, B0); PG8_MMA(1, 1, At, B1); PG8_BAR; PG8_SCHED;
            } else {
            PG8_LDB(B0, 0, 0); PG8_SCHED; PG8_LDA(At, 0, 0); PG8_STAGE(PG8_SA(1, 1), a1 + hstep, voffA);
            PG8_WAIT_L(8); PG8_BAR; PG8_WAIT_L(0); PG8_MMA(0, 0, At, B0); PG8_BAR; PG8_SCHED;
            PG8_LDB(B1, 0, 1); PG8_STAGE(PG8_SB(0, 0), b2, voffB);
            PG8_BAR; PG8_WAIT_L(0); PG8_MMA(0, 1, At, B1); PG8_BAR;
            PG8_LDA(At, 0, 1); PG8_STAGE(PG8_SA(0, 0), a2, voffA);
            PG8_BAR; PG8_WAIT_L(0); PG8_MMA(1, 0, At, B0); PG8_BAR; PG8_SCHED;
            PG8_STAGE(PG8_SB(0, 1), b2 + hstep, voffB);
            PG8_WAIT_V(6); PG8_BAR; PG8_MMA(1, 1, At, B1); PG8_BAR;
            PG8_LDB(B0, 1, 0); PG8_SCHED; PG8_LDA(At, 1, 0); PG8_STAGE(PG8_SA(0, 1), a2 + hstep, voffA);
            PG8_WAIT_L(8); PG8_BAR; PG8_WAIT_L(0); PG8_MMA(0, 0, At, B0); PG8_BAR; PG8_SCHED;
            PG8_LDB(B1, 1, 1); PG8_STAGE(PG8_SB(1, 0), b3, voffB);
            PG8_BAR; PG8_WAIT_L(0); PG8_MMA(0, 1, At, B1); PG8_BAR;
            PG8_LDA(At, 1, 1); PG8_STAGE(PG8_SA(1, 0), a3, voffA);
            PG8_BAR; PG8_WAIT_L(0); PG8_MMA(1, 0, At, B0); PG8_BAR; PG8_SCHED;
            PG8_STAGE(PG8_SB(1, 1), b3 + hstep, voffB);
            PG8_WAIT_V(6); PG8_BAR; PG8_MMA(1, 1, At, B1); PG8_BAR;
            }
        }
        if constexpr (ALIGN_EPI) { if (wr == 0) PG8_BAR; }
        if constexpr (!Epi::AFTER_DRAIN) { E(acc, cur, wr, wc, fr, fq); S.done(cur); }
        if (!has_next) break;
#pragma unroll
        for (int a = 0; a < 2; ++a)
#pragma unroll
            for (int b = 0; b < 2; ++b)
#pragma unroll
                for (int m = 0; m < 4; ++m)
#pragma unroll
                    for (int n = 0; n < 2; ++n) acc[a][b][m][n] = (f32x4){0.f, 0.f, 0.f, 0.f};
        cur = nxt; cA = nA; cB = nB; ++ui;
        if constexpr (ALIGN_EPI) { if (wr == 1) PG8_BAR; }
    }
    PG8_WAIT_V(0);
    if constexpr (!ALIGN_EPI) { if (wr == 0) PG8_BAR; }
    PG8_BAR;
    if constexpr (Epi::AFTER_DRAIN) { E.fused(acc, cur, wr, wc, fr, fq, lds, wid, lane); S.done(cur); }
#undef PG8_SA
#undef PG8_SB
#undef PG8_STAGE
#undef PG8_LDA
#undef PG8_LDB
#undef PG8_MMA
#undef PG8_WAIT_V
#undef PG8_WAIT_L
#undef PG8_BAR
#undef PG8_SCHED
}
}


template <class E> struct EpiA {
    static constexpr bool PERM = true, AFTER_DRAIN = false;
    E e; int row0;
    __device__ __forceinline__ void operator()(const pg8::f32x4 (&acc)[2][2][4][2], const pg8::Unit& u, int wr, int wc, int fr, int fq) const {
#pragma unroll
        for (int ai = 0; ai < 2; ++ai)
#pragma unroll
            for (int m = 0; m < 4; ++m)
#pragma unroll
                for (int bj = 0; bj < 2; ++bj) {
                    float v[8] = {acc[ai][bj][m][0][0], acc[ai][bj][m][0][1], acc[ai][bj][m][0][2], acc[ai][bj][m][0][3], acc[ai][bj][m][1][0], acc[ai][bj][m][1][1], acc[ai][bj][m][1][2], acc[ai][bj][m][1][3]};
                    e(row0 + u.pm * 256 + ai * 128 + wr * 64 + m * 16 + fr, u.pn * 256 + bj * 128 + wc * 32 + 8 * fq, v);
                    __builtin_amdgcn_sched_barrier(0);
                }
    }
};
template <class E>
__device__ __forceinline__ void gemm_fast(char* lds, const bf16_t* A, int row0, int M, int K, const bf16_t* Bt, int N, const E& e, int rot = 0) {
    asm volatile("" : "+s"(K));
    pg8::Gemm g{A + (size_t)row0 * K, Bt, M, N, K}; pg8::StaticOrder S; S.init(M, N, (int)gridDim.x, ((int)blockIdx.x + rot) % (int)gridDim.x);
    EpiA<E> ea{e, row0};
    pg8::gemm_phase<EpiA<E>, pg8::StaticOrder, true, true>((PG8_LAS unsigned char*)lds, g, S, ea);
}

struct EpiResid4 { bf16_t* XL; const float* modl; int which; const float* cin = nullptr;
    __device__ __forceinline__ void operator()(int row, int col0, f32x4 v) const {
        const f32x4 m = *(const f32x4*)(modl + 6144 + which * 1024 + col0); bf16_t* x = XL + (size_t)row * 1024 + col0;
        f32x4 a;
        if (cin) a = *(const f32x4*)(cin + (size_t)row * 1024 + col0);
        else { const u32x2 r = *(const u32x2*)x; a[0] = bf2f(r[0]); a[1] = __uint_as_float(r[0] & 0xffff0000u); a[2] = bf2f(r[1]); a[3] = __uint_as_float(r[1] & 0xffff0000u); }
        a += m * v;
        const u32x2 w = {pk2(a[0], a[1]), pk2(a[2], a[3])}; *(u32x2*)x = w; } };
struct EpiQKV4 { bf16_t* QKV; float qscale;
    __device__ __forceinline__ void operator()(int row, int col0, f32x4 v) const {
        if (col0 < 1024) v = v * qscale;
        u32x2 w = {pk2(v[0], v[1]), pk2(v[2], v[3])}; *(u32x2*)(QKV + (size_t)row * 3072 + col0) = w;
        if (col0 >= 2048) { bf16_t* vt = QKV + (WS_VT - WS_QKV) / 2 + (size_t)(col0 - 2048) * R + row;
            vt[0] = (bf16_t)(w[0] & 0xffffu); vt[R] = (bf16_t)(w[0] >> 16); vt[2 * (size_t)R] = (bf16_t)(w[1] & 0xffffu); vt[3 * (size_t)R] = (bf16_t)(w[1] >> 16); } } };
struct EpiGelu4 { bf16_t* U; bf16_t* VP;
    __device__ __forceinline__ void operator()(int row, int col0, f32x4 v) const {
        v = (f32x4){geluf_(v[0]), geluf_(v[1]), geluf_(v[2]), geluf_(v[3])};
        const u32x2 w = {pk2(v[0], v[1]), pk2(v[2], v[3])};
        *(u32x2*)((col0 < 1024 ? U + col0 : VP + (col0 - 1024)) + (size_t)row * 1024) = w; } };
template <class E4>
__device__ __forceinline__ void gemm_ctx(char* smem, const bf16_t* A, int K, const bf16_t* Bt, int N, const E4& e) {
    typedef short bf16x8_ __attribute__((ext_vector_type(8)));
    const int tid = ptid(), lane = tid & 63, wv = __builtin_amdgcn_readfirstlane(tid >> 6), fr = lane & 15, fq = lane >> 4;
    f32x4* P = (f32x4*)smem;
    const int nP = 4 * (N / 64), kw = K / 8;
    for (int pc = blockIdx.x; pc < nP; pc += gridDim.x) {
        const int r0 = (pc & 3) * 64, n0 = (pc >> 2) * 64;
        f32x4 acc[4][4];
#pragma unroll
        for (int a = 0; a < 4; ++a)
#pragma unroll
            for (int t = 0; t < 4; ++t) acc[a][t] = (f32x4){0.f, 0.f, 0.f, 0.f};
        const bf16_t* ap = A + (size_t)(r0 + fr) * K + wv * kw + fq * 8;
        const bf16_t* bp = Bt + (size_t)(n0 + fr) * K + wv * kw + fq * 8;
#pragma unroll 2
        for (int k = 0; k < kw; k += 32) {
            bf16x8_ af[4], bq[4];
#pragma unroll
            for (int a = 0; a < 4; ++a) { af[a] = *(const bf16x8_*)(ap + (size_t)16 * a * K + k); bq[a] = *(const bf16x8_*)(bp + (size_t)16 * a * K + k); }
#pragma unroll
            for (int a = 0; a < 4; ++a)
#pragma unroll
                for (int t = 0; t < 4; ++t) acc[a][t] = __builtin_amdgcn_mfma_f32_16x16x32_bf16(bq[t], af[a], acc[a][t], 0, 0, 0);
        }
        __syncthreads();
#pragma unroll
        for (int a = 0; a < 4; ++a)
#pragma unroll
            for (int t = 0; t < 4; ++t) P[(wv * 16 + a * 4 + t) * 64 + lane] = acc[a][t];
        __syncthreads();
#pragma unroll
        for (int i = 0; i < 2; ++i) {
            const int tt = (tid >> 6) + 8 * i; f32x4 sum = P[tt * 64 + lane];
#pragma unroll
            for (int w = 1; w < 8; ++w) sum = sum + P[(w * 16 + tt) * 64 + lane];
            e(r0 + 16 * (tt >> 2) + fr, n0 + 16 * (tt & 3) + 4 * fq, sum);
        }
    }
    __syncthreads();
}
template <class BMap>
__device__ __forceinline__ void conv_w(const BMap B, bf16_t* Bt, int N, int K, float* lds_, int& rot, int gi = -1, int gn = 0) {
    __attribute__((address_space(3))) float* lds = (__attribute__((address_space(3))) float*)lds_;
    const int tid = ptid(), nTk = K / 64, nT = (N / 256) * nTk, G_ = gn > 0 ? gn : (int)gridDim.x;
    const int t0 = ((gn > 0 ? gi : (int)blockIdx.x) - rot + G_) % G_; rot = (rot + nT) % G_;
    for (int t = t0; t < nT; t += G_) {
        const int n0 = (t / nTk) * 256, k0 = (t % nTk) * 64;
        __syncthreads();
        float v[8][4];
#pragma unroll
        for (int i = 0; i < 8; ++i)
#pragma unroll
            for (int q = 0; q < 4; ++q) v[i][q] = B(k0 + (tid >> 6) + 8 * i, n0 + (tid & 63) + 64 * q);
#pragma unroll
        for (int i = 0; i < 8; ++i)
#pragma unroll
            for (int q = 0; q < 4; ++q) lds[((tid >> 6) + 8 * i) * 257 + (tid & 63) + 64 * q] = v[i][q];
        __syncthreads();
#pragma unroll
        for (int q = 0; q < 4; ++q) {
            const int nl = (tid >> 3) + 64 * q, k8 = (tid & 7) * 8;
            u32x4 w = {pk2(lds[(k8 + 0) * 257 + nl], lds[(k8 + 1) * 257 + nl]), pk2(lds[(k8 + 2) * 257 + nl], lds[(k8 + 3) * 257 + nl]),
                       pk2(lds[(k8 + 4) * 257 + nl], lds[(k8 + 5) * 257 + nl]), pk2(lds[(k8 + 6) * 257 + nl], lds[(k8 + 7) * 257 + nl])};
            *(u32x4*)(Bt + (size_t)(n0 + nl) * K + k0 + k8) = w;
        }
    }
}

__device__ __forceinline__ void phase_mod(const Params& p, float* lds) {
    const int tid = ptid(), lane = tid & 63, wv = tid >> 6;
    float* MOD = (float*)(p.ws + WS_MOD);
    const float* c = p.in[1]; const float* cc = p.in[3]; const float* mw = p.in[5]; const float* mb = p.in[6];
    float* sl_c = lds + 1024; float* sl_x = lds + 2048;
    for (int k = tid; k < 1024; k += NTHR) { sl_c[k] = siluf_(c[k]); sl_x[k] = siluf_(cc[k]); }
    __syncthreads();
    for (int item = blockIdx.x; item < 4 * 96; item += gridDim.x) {
        const int i = item / 96, n = (item % 96) * 64 + lane;
        float sl = 0.f, sc = 0.f;
        const float* wp = mw + ((size_t)i * 1024 + wv * 128) * 6144 + n;
#pragma unroll 1
        for (int k8 = 0; k8 < 128; k8 += 32) {
            float w[32];
#pragma unroll
            for (int e = 0; e < 32; ++e) w[e] = wp[(size_t)(k8 + e) * 6144];
#pragma unroll
            for (int e = 0; e < 32; ++e) { sl += sl_c[wv * 128 + k8 + e] * w[e]; sc += sl_x[wv * 128 + k8 + e] * w[e]; }
        }
        lds[wv * 64 + lane] = sl; lds[512 + wv * 64 + lane] = sc;
        __syncthreads();
        if (wv == 0) {
            float a = 0.f, b = 0.f;
#pragma unroll
            for (int w = 0; w < 8; ++w) { a += lds[w * 64 + lane]; b += lds[512 + w * 64 + lane]; }
            const float bias = mb[i * 6144 + n];
            MOD[(i * 2 + 0) * 6144 + n] = a + bias; MOD[(i * 2 + 1) * 6144 + n] = b + bias;
        }
        __syncthreads();
    }
    float* tab = (float*)(p.ws + WS_TAB);
    for (int idx = blockIdx.x * NTHR + tid; idx < 256 * 16; idx += gridDim.x * NTHR) {
        const int pos = idx >> 4, f = idx & 15;
        const float inv = (float)pow(10000.0, -(double)f / 16.0);
        const float ang = (float)pos * inv;
        tab[idx * 2] = (float)cos((double)ang); tab[idx * 2 + 1] = (float)sin((double)ang);
    }
}

__device__ __forceinline__ void phase_norm(const Params& p, int layer, int which, int init, int route_j, int row_lo, int final_out, int comb_layer, char* smem) {
    const int tid = ptid(), lane = tid & 63, wv = tid >> 6;
    int* li = (int*)smem; float* lf = (float*)(smem + 4096);
    bf16_t* XL = (bf16_t*)(p.ws + WS_XL); bf16_t* H = (bf16_t*)(p.ws + WS_H);
    const float* g = final_out ? p.in[7] : p.in[4] + (layer * 2 + which) * 1024;
    const float* modb = (const float*)(p.ws + WS_MOD) + layer * 2 * 6144;
    const int nrows = (R - row_lo + (int)gridDim.x - 1) / (int)gridDim.x, rbase = row_lo + (int)blockIdx.x * nrows, rend = (rbase + nrows < R) ? rbase + nrows : R;
    if (route_j >= 0) { if (tid < 8) li[tid] = 0; __syncthreads(); }
    f32x4 xpre[4]; u32x2 xraw[4];
#define NORM_LOAD(row_, X) do { const int r_ = (row_); _Pragma("unroll") for (int j = 0; j < 4; ++j) { const int col = j * 256 + lane * 4; \
        if (init) { const float* src = r_ < RC ? p.in[2] + (size_t)r_ * 1024 : p.in[0] + (size_t)(r_ - RC) * 1024; X[j] = *(const f32x4*)(src + col); } \
        else xraw[j] = *(const u32x2*)(XL + (size_t)r_ * 1024 + col); } } while (0)
    if (rbase + wv < rend) NORM_LOAD(rbase + wv, xpre);
    for (int row = rbase + wv; row < rend; row += 8) {
        const bool isc = row < RC;
        const float* m = modb + (isc ? 6144 : 0);
        const float* shift = m + (which ? 3 : 0) * 1024; const float* scale = m + (which ? 4 : 1) * 1024;
        f32x4 x[4]; float ss = 0.f;
#pragma unroll
        for (int j = 0; j < 4; ++j) {
            if (init) x[j] = xpre[j];
            else { x[j][0] = bf2f(xraw[j][0]); x[j][1] = __uint_as_float(xraw[j][0] & 0xffff0000u); x[j][2] = bf2f(xraw[j][1]); x[j][3] = __uint_as_float(xraw[j][1] & 0xffff0000u); }
        }
        if (row + 8 < rend) NORM_LOAD(row + 8, xpre);
        int s0 = 0, s1 = 0; float cg0 = 0.f, cg1 = 0.f; const float* cm = nullptr;
        if (comb_layer >= 0) {
            const int* sl = (const int*)(p.ws + WS_SLOT) + (size_t)row * 2; const float* gg = (const float*)(p.ws + WS_RTG) + (size_t)row * 2;
            s0 = sl[0]; s1 = sl[1]; cg0 = gg[0]; cg1 = gg[1];
            cm = (const float*)(p.ws + WS_MOD) + comb_layer * 2 * 6144 + (isc ? 6144 : 0) + 5 * 1024;
        }
#pragma unroll
        for (int j = 0; j < 4; ++j) {
            const int col = j * 256 + lane * 4;
            if (comb_layer >= 0) {
                const bf16_t* Y = (const bf16_t*)(p.ws + WS_YM);
                const u32x2 a = *(const u32x2*)(Y + (size_t)s0 * 1024 + col), b = *(const u32x2*)(Y + (size_t)s1 * 1024 + col);
                const f32x4 mm = *(const f32x4*)(cm + col);
                x[j][0] += mm[0] * (cg0 * bf2f(a[0] & 0xffffu) + cg1 * bf2f(b[0] & 0xffffu)); x[j][1] += mm[1] * (cg0 * bf2f(a[0] >> 16) + cg1 * bf2f(b[0] >> 16));
                x[j][2] += mm[2] * (cg0 * bf2f(a[1] & 0xffffu) + cg1 * bf2f(b[1] & 0xffffu)); x[j][3] += mm[3] * (cg0 * bf2f(a[1] >> 16) + cg1 * bf2f(b[1] >> 16));
                if (!final_out) { const u32x2 xw = {pk2(x[j][0], x[j][1]), pk2(x[j][2], x[j][3])}; *(u32x2*)(XL + (size_t)row * 1024 + col) = xw; }
            }
            ss += x[j][0] * x[j][0] + x[j][1] * x[j][1] + x[j][2] * x[j][2] + x[j][3] * x[j][3];
        }
        ss = wave_sum(ss);
        const float rs = rsqrtf(ss * (1.f / 1024.f) + 1e-6f);
        float lg[8];
#pragma unroll
        for (int e = 0; e < 8; ++e) lg[e] = 0.f;
#pragma unroll
        for (int j = 0; j < 4; ++j) {
            const int col = j * 256 + lane * 4;
            const f32x4 gg = *(const f32x4*)(g + col);
            f32x4 h;
            if (final_out) { h = x[j] * rs * gg; *(f32x4*)(p.out + (size_t)(row - RC) * 1024 + col) = h; }
            else {
                const f32x4 sc = *(const f32x4*)(scale + col), sh = *(const f32x4*)(shift + col);
                h = x[j] * rs * gg * (1.f + sc) + sh;
                u32x2 w = {pk2(h[0], h[1]), pk2(h[2], h[3])};
                *(u32x2*)(H + (size_t)row * 1024 + col) = w;
                if (route_j >= 0) {
                    const float* rt = p.in[37] + (size_t)route_j * 8192 + (size_t)col * 8;
#pragma unroll
                    for (int q = 0; q < 4; ++q)
#pragma unroll
                        for (int e = 0; e < 8; ++e) lg[e] += h[q] * rt[q * 8 + e];
                }
            }
        }
        if (route_j >= 0 && !final_out) {
#pragma unroll
            for (int e = 0; e < 8; ++e) lg[e] = wave_sum(lg[e]);
            if (lane == 0) {
                int i0 = 0; float v0 = lg[0];
#pragma unroll
                for (int e = 1; e < 8; ++e) if (lg[e] > v0) { v0 = lg[e]; i0 = e; }
                int i1 = -1; float v1 = -3.0e38f;
#pragma unroll
                for (int e = 0; e < 8; ++e) if (e != i0 && lg[e] > v1) { v1 = lg[e]; i1 = e; }
                const float e1 = expf(v1 - v0), g0 = 1.f / (1.f + e1), g1 = e1 / (1.f + e1);
                const int i = row - rbase;
                li[16 + 4 * i] = i0; li[17 + 4 * i] = i1; li[18 + 4 * i] = atomicAdd(&li[i0], 1); li[19 + 4 * i] = atomicAdd(&li[i1], 1);
                lf[2 * i] = g0; lf[2 * i + 1] = g1;
            }
        }
    }
    if (route_j >= 0) {
        unsigned* gcnt = (unsigned*)(p.ws + WS_CTL) + CW_MOE + route_j * 256;
        __syncthreads();
        if (tid < 8) li[8 + tid] = (int)atomicAdd(gcnt + tid * 16, (unsigned)li[tid]);
        __syncthreads();
        for (int i = tid; i < rend - rbase; i += NTHR) {
            const int e0 = li[16 + 4 * i], e1 = li[17 + 4 * i];
            int* ro = (int*)(p.ws + WS_ROUTE) + (size_t)(rbase + i) * 4;
            ro[0] = e0; ro[1] = e1; ro[2] = li[8 + e0] + li[18 + 4 * i]; ro[3] = li[8 + e1] + li[19 + 4 * i];
            float* go = (float*)(p.ws + WS_RTG) + (size_t)(rbase + i) * 2; go[0] = lf[2 * i]; go[1] = lf[2 * i + 1];
        }
    }
}

#undef NORM_LOAD
__device__ __forceinline__ void moe_bases(const Params& p, int j, int (&base)[9]) {
    const unsigned* gcnt = (const unsigned*)(p.ws + WS_CTL) + CW_MOE + j * 256;
    base[0] = 0;
#pragma unroll
    for (int e = 0; e < 8; ++e) base[e + 1] = base[e] + (int)((__hip_atomic_load(gcnt + e * 16, __ATOMIC_RELAXED, __HIP_MEMORY_SCOPE_AGENT) + 255u) & ~255u);
}
__device__ __forceinline__ void phase_perm(const Params& p, int j, int row_lo, char* smem) {
    const int tid = ptid(), lane = tid & 63, wv = tid >> 6;
    int* lb = (int*)smem;
    { int base[9]; moe_bases(p, j, base); if (tid == 0) {
#pragma unroll
        for (int e = 0; e < 9; ++e) lb[e] = base[e]; } }
    __syncthreads();
    const bf16_t* H = (const bf16_t*)(p.ws + WS_H); bf16_t* HP = (bf16_t*)(p.ws + WS_HP);
    for (int row = row_lo + blockIdx.x * 8 + wv; row < R; row += gridDim.x * 8) {
        const int* ro = (const int*)(p.ws + WS_ROUTE) + (size_t)row * 4;
        const int s0 = lb[ro[0]] + ro[2], s1 = lb[ro[1]] + ro[3];
        const u32x4 a = *(const u32x4*)(H + (size_t)row * 1024 + lane * 8), b = *(const u32x4*)(H + (size_t)row * 1024 + 512 + lane * 8);
        *(u32x4*)(HP + (size_t)s0 * 1024 + lane * 8) = a; *(u32x4*)(HP + (size_t)s0 * 1024 + 512 + lane * 8) = b;
        *(u32x4*)(HP + (size_t)s1 * 1024 + lane * 8) = a; *(u32x4*)(HP + (size_t)s1 * 1024 + 512 + lane * 8) = b;
        if (lane == 0) { int* sl = (int*)(p.ws + WS_SLOT) + (size_t)row * 2; sl[0] = s0; sl[1] = s1; }
    }
}
struct MoeOrder {
    const int* lb; int nN, G, c, ntiles;
    __device__ __forceinline__ bool next(int i, pg8::Unit& u) const {
        const long L = (long)i * G + c; if (L >= (long)ntiles * nN) return false;
        const int t = (int)(L / nN), pn = (int)(L % nN); int e = 0;
#pragma unroll
        for (int q = 1; q < 8; ++q) e += (t * 256 >= lb[q]) ? 1 : 0;
        u.pm = t; u.pn = __builtin_amdgcn_readfirstlane(e) * nN + pn; return true;
    }
    __device__ __forceinline__ void a_ready(const pg8::Unit&) const {}
    __device__ __forceinline__ void done(const pg8::Unit&) const {}
};
struct EpiGateUpM { bf16_t* ACT;
    __device__ __forceinline__ void operator()(int row, int col0, float (&v)[8]) const {
        float a[4];
#pragma unroll
        for (int j = 0; j < 4; ++j) a[j] = siluf_(v[2 * j]) * v[2 * j + 1];
        u32x2 w = {pk2(a[0], a[1]), pk2(a[2], a[3])};
        const int eb = (__builtin_amdgcn_readfirstlane(col0) / (2 * FF)) * (2 * FF);
        *(u32x2*)(ACT + (size_t)row * FF + ((col0 - eb) >> 1)) = w;
    }
};
struct EpiStoreM { bf16_t* Y;
    __device__ __forceinline__ void operator()(int row, int col0, float (&v)[8]) const {
        u32x4 w = {pk2(v[0], v[1]), pk2(v[2], v[3]), pk2(v[4], v[5]), pk2(v[6], v[7])};
        *(u32x4*)(Y + (size_t)row * 1024 + (col0 & 1023)) = w;
    }
};
template <class E>
__device__ __forceinline__ void gemm_moe(char* lds, const Params& p, int j, const bf16_t* A, int K, const bf16_t* Bt, int nN, const E& e) {
    int* lb = (int*)(lds + 132 * 1024);
    { int base[9]; moe_bases(p, j, base); if (ptid() == 0) {
#pragma unroll
        for (int q = 0; q < 9; ++q) lb[q] = base[q]; } }
    __syncthreads();
    MoeOrder S; S.lb = lb; S.nN = nN; S.G = (int)gridDim.x; S.c = (int)blockIdx.x; S.ntiles = __builtin_amdgcn_readfirstlane(lb[8]) >> 8;
    pg8::Gemm g{A, Bt, 0, 0, K};
    EpiA<E> ea{e, 0};
    pg8::gemm_phase<EpiA<E>, MoeOrder, true, true>((PG8_LAS unsigned char*)lds, g, S, ea);
}

struct RwkvOrder {
    int G, c;
    __device__ __forceinline__ bool next(int i, pg8::Unit& u) const {
        const int L = i * G + c; if (L >= 975) return false;
        if (L < 780) { const int q = L / 260, rem = L - q * 260; u.pm = (q == 0 ? 0 : q + 1) * 65 + (rem >> 2); u.pn = q * 4 + (rem & 3); }
        else { const int q2 = (L - 780) / 65, pm = (L - 780) - q2 * 65; u.pm = (q2 == 0 ? 1 : q2 + 3) * 65 + pm; u.pn = 12 + q2; }
        return true;
    }
    __device__ __forceinline__ void a_ready(const pg8::Unit&) const {}
    __device__ __forceinline__ void done(const pg8::Unit&) const {}
};
struct EpiRwkv1 {
    unsigned char* ws;
    __device__ __forceinline__ void operator()(int row, int col0, float (&v)[8]) const {
        const int mi = row / R, lrow = row - mi * R;
        if (col0 < 3072) {
            const int q = col0 >> 10;
            u32x4 w = {pk2(v[0], v[1]), pk2(v[2], v[3]), pk2(v[4], v[5]), pk2(v[6], v[7])};
            *(u32x4*)((bf16_t*)(ws + WS_RR + (size_t)q * 33 * MiB) + (size_t)lrow * 1024 + (col0 & 1023)) = w;
        } else {
            const int q2 = (col0 - 3072) >> 8, c = (col0 - 3072) & 255;
            if (q2 < 2 && c >= 128) return;
#pragma unroll
            for (int j = 0; j < 8; ++j) { if (q2 == 0) v[j] = tanhf_(v[j]); else if (q2 == 2) v[j] = sigmoidf_(v[j]); }
            u32x4 w = {pk2(v[0], v[1]), pk2(v[2], v[3]), pk2(v[4], v[5]), pk2(v[6], v[7])};
            bf16_t* dst = q2 == 0 ? (bf16_t*)(ws + WS_L1W) + (size_t)lrow * 128 : (q2 == 1 ? (bf16_t*)(ws + WS_L1A) + (size_t)lrow * 128 : (bf16_t*)(ws + WS_L1G) + (size_t)lrow * 256);
            *(u32x4*)(dst + c) = w;
        }
    }
};
__device__ __forceinline__ void gemm_rwkv1(char* lds, const Params& p) {
    int K = 1024; asm volatile("" : "+s"(K));
    RwkvOrder S; S.G = (int)gridDim.x; S.c = (int)blockIdx.x;
    pg8::Gemm g{WSB(WS_MIX), WSB(WS_WIN), 0, 0, K};
    EpiA<EpiRwkv1> ea{EpiRwkv1{p.ws}, 0};
    pg8::gemm_phase<EpiA<EpiRwkv1>, RwkvOrder, true, true>((PG8_LAS unsigned char*)lds, g, S, ea);
}


namespace att {
using bf16x8 = __attribute__((ext_vector_type(8))) short;
using s16x4  = __attribute__((ext_vector_type(4))) short;
using f32x16 = __attribute__((ext_vector_type(16))) float;
constexpr int NW = 8, QBLK = 32, KVBLK = 64, LDQ = 3072, LDO = 2048;
constexpr float THR2 = 8.f;
constexpr int KPITCH = 144, VPITCH = 144, SHM_V = 128 * VPITCH  , SHM_K = KVBLK * KPITCH, SHM_ATTN = 3 * SHM_V + 3 * SHM_K + NW * 64 * 4;
#define KSWZ64(row, colB) ((row) * KPITCH + (colB))
#define SBAR() __builtin_amdgcn_sched_barrier(0)
__device__ __forceinline__ int crow(int r, int hi) { return (r & 3) + 8 * (r >> 2) + 4 * hi; }
__device__ __forceinline__ unsigned cvtpk(float lo, float hi) { unsigned r; asm volatile("v_cvt_pk_bf16_f32 %0, %1, %2" : "=v"(r) : "v"(lo), "v"(hi)); return r; }
__device__ __forceinline__ void partialSM(f32x16& p0, f32x16& p1, float& m_reg, float& alpha) {
    float pmax = fmaxf(fmaxf(p0[0], p0[1]), p0[2]);
#pragma unroll
    for (int r = 3; r < 15; r += 2) pmax = fmaxf(fmaxf(pmax, p0[r]), p0[r + 1]);
    pmax = fmaxf(fmaxf(pmax, p0[15]), p1[0]);
#pragma unroll
    for (int r = 1; r < 15; r += 2) pmax = fmaxf(fmaxf(pmax, p1[r]), p1[r + 1]);
    pmax = fmaxf(pmax, p1[15]);
    { auto rr = __builtin_amdgcn_permlane32_swap(__float_as_uint(pmax), __float_as_uint(pmax), false, false); pmax = fmaxf(__uint_as_float(rr[0]), __uint_as_float(rr[1])); }
    if (__builtin_expect(__all(pmax <= THR2), 1)) { alpha = 1.f; }
    else {
        const float d = fmaxf(pmax, 0.f); alpha = __builtin_amdgcn_exp2f(-d); m_reg += d;
#pragma unroll
        for (int r = 0; r < 16; ++r) { p0[r] -= d; p1[r] -= d; }
    }
#pragma unroll
    for (int r = 0; r < 16; ++r) p0[r] = __builtin_amdgcn_exp2f(p0[r]);
}
__device__ __forceinline__ void finishSM(f32x16& p0, f32x16& p1, float alpha, float& l_reg, bf16x8& pa0, bf16x8& pa1, bf16x8& pa2, bf16x8& pa3) {
#pragma unroll
    for (int r = 0; r < 16; ++r) p1[r] = __builtin_amdgcn_exp2f(p1[r]);
    float ps = 0;
#pragma unroll
    for (int r = 0; r < 16; ++r) ps += p0[r];
#pragma unroll
    for (int r = 0; r < 16; ++r) ps += p1[r];
    { auto rr = __builtin_amdgcn_permlane32_swap(__float_as_uint(ps), __float_as_uint(ps), false, false); ps = __uint_as_float(rr[0]) + __uint_as_float(rr[1]); }
    l_reg = l_reg * alpha + ps;
#define PK4(P, BASE, OUT) do { unsigned a0 = cvtpk(P[BASE + 0], P[BASE + 1]), a1 = cvtpk(P[BASE + 2], P[BASE + 3]);   \
    unsigned b0 = cvtpk(P[BASE + 4], P[BASE + 5]), b1 = cvtpk(P[BASE + 6], P[BASE + 7]);                              \
    u32x4 w = {a0, a1, b0, b1}; OUT = *reinterpret_cast<bf16x8*>(&w); } while (0)
    PK4(p0, 0, pa0); PK4(p0, 8, pa1); PK4(p1, 0, pa2); PK4(p1, 8, pa3);
#undef PK4
}
__device__ __forceinline__ void qkt(f32x16& p0, f32x16& p1, const char* Ks, const bf16x8* qr, int r32, int hi, float negm) {
#pragma unroll
    for (int r = 0; r < 16; ++r) { p0[r] = negm; p1[r] = negm; }
#pragma unroll
    for (int d0 = 0; d0 < 4; ++d0) { const int cb = (d0 * 16 + hi * 8) * 2;
        bf16x8 b0 = *reinterpret_cast<const bf16x8*>(Ks + KSWZ64(r32, cb));
        bf16x8 b1 = *reinterpret_cast<const bf16x8*>(Ks + KSWZ64(32 + r32, cb));
        p0 = __builtin_amdgcn_mfma_f32_32x32x16_bf16(b0, qr[d0], p0, 0, 0, 0);
        p1 = __builtin_amdgcn_mfma_f32_32x32x16_bf16(b1, qr[d0], p1, 0, 0, 0); }
}
__device__ __forceinline__ int v_st(int k, int c) { const int kk = k; return ((kk >> 3) * 4 + (c >> 5)) * 512 + ((kk & 7) * 32 + (c & 31)) * 2; }
__device__ __forceinline__ int v_rd_base(int lane) { return ((lane & 3) << 3) | (((lane >> 2) & 3) << 6) | (((lane >> 4) & 1) << 5) | (((lane >> 5) & 1) << 8); }
constexpr int v_rd_off(int d0, int ks, int half) { return d0 * 512 + ks * 4096 + half * 2048; }
template <int OFF> __device__ __forceinline__ s16x4 tr_read(int vb) { s16x4 r; asm volatile("ds_read_b64_tr_b16 %0, %1 offset:%2" : "=&v"(r) : "v"(vb), "i"(OFF) : "memory"); return r; }
struct VFrag { s16x4 l0, h0, l1, h1, l2, h2, l3, h3; };
template <int D0> __device__ __forceinline__ void pv_read(VFrag& f, int vb) {
    f.l0 = tr_read<v_rd_off(D0, 0, 0)>(vb); f.h0 = tr_read<v_rd_off(D0, 0, 1)>(vb); f.l1 = tr_read<v_rd_off(D0, 1, 0)>(vb); f.h1 = tr_read<v_rd_off(D0, 1, 1)>(vb);
    f.l2 = tr_read<v_rd_off(D0, 2, 0)>(vb); f.h2 = tr_read<v_rd_off(D0, 2, 1)>(vb); f.l3 = tr_read<v_rd_off(D0, 3, 0)>(vb); f.h3 = tr_read<v_rd_off(D0, 3, 1)>(vb);
}
__device__ __forceinline__ void pv_mma(f32x16& od, const VFrag& f, bf16x8 pa0, bf16x8 pa1, bf16x8 pa2, bf16x8 pa3) {
#define PK(L, H) (bf16x8){L[0], L[1], L[2], L[3], H[0], H[1], H[2], H[3]}
    od = __builtin_amdgcn_mfma_f32_32x32x16_bf16(pa0, PK(f.l0, f.h0), od, 0, 0, 0);
    od = __builtin_amdgcn_mfma_f32_32x32x16_bf16(pa1, PK(f.l1, f.h1), od, 0, 0, 0);
    od = __builtin_amdgcn_mfma_f32_32x32x16_bf16(pa2, PK(f.l2, f.h2), od, 0, 0, 0);
    od = __builtin_amdgcn_mfma_f32_32x32x16_bf16(pa3, PK(f.l3, f.h3), od, 0, 0, 0);
#undef PK
}
#define SGB_MFMA_VALU(nv) do { __builtin_amdgcn_sched_group_barrier(0x008, 1, 0); __builtin_amdgcn_sched_group_barrier(0x002, nv, 0); } while (0)
__device__ __forceinline__ void pv_sm(f32x16* o, int vb, bf16x8 pa0, bf16x8 pa1, bf16x8 pa2, bf16x8 pa3, f32x16& p0, f32x16& p1, float& m_reg, float& alpha, float& ps) {
    VFrag fa, fb;
#define PV_WAIT() do { asm volatile("s_waitcnt lgkmcnt(0)" ::: "memory"); SBAR(); } while (0)
    pv_read<0>(fa, vb); PV_WAIT();
    pv_read<1>(fb, vb); pv_mma(o[0], fa, pa0, pa1, pa2, pa3);
    float mx = fmaxf(fmaxf(p0[0], p0[1]), p0[2]);
#pragma unroll
    for (int r = 3; r < 15; r += 2) mx = fmaxf(fmaxf(mx, p0[r]), p0[r + 1]);
    mx = fmaxf(mx, p0[15]);
#pragma unroll
    for (int r = 0; r < 8; ++r) p0[r] = __builtin_amdgcn_exp2f(p0[r]);
    SGB_MFMA_VALU(4); SGB_MFMA_VALU(4); SGB_MFMA_VALU(4); SGB_MFMA_VALU(4);
    PV_WAIT();
    pv_read<2>(fa, vb); pv_mma(o[1], fb, pa0, pa1, pa2, pa3);
#pragma unroll
    for (int r = 0; r < 16; r += 2) mx = fmaxf(fmaxf(mx, p1[r]), p1[r + 1]);
    { auto rr = __builtin_amdgcn_permlane32_swap(__float_as_uint(mx), __float_as_uint(mx), false, false); mx = fmaxf(__uint_as_float(rr[0]), __uint_as_float(rr[1])); }
    const float d = mx > THR2 ? mx : 0.f;
    alpha = __builtin_amdgcn_exp2f(-d); m_reg += d;
#pragma unroll
    for (int r = 8; r < 16; ++r) p0[r] = __builtin_amdgcn_exp2f(p0[r]);
    SGB_MFMA_VALU(5); SGB_MFMA_VALU(5); SGB_MFMA_VALU(5); SGB_MFMA_VALU(5);
    PV_WAIT();
    pv_read<3>(fb, vb); pv_mma(o[2], fa, pa0, pa1, pa2, pa3);
#pragma unroll
    for (int r = 0; r < 8; ++r) p1[r] = __builtin_amdgcn_exp2f(p1[r]);
    float s0 = (p0[0] + p0[1]) + (p0[2] + p0[3]), s1 = (p0[4] + p0[5]) + (p0[6] + p0[7]), s2 = (p0[8] + p0[9]) + (p0[10] + p0[11]), s3 = (p0[12] + p0[13]) + (p0[14] + p0[15]);
    SGB_MFMA_VALU(5); SGB_MFMA_VALU(5); SGB_MFMA_VALU(5); SGB_MFMA_VALU(5);
    PV_WAIT();
    pv_mma(o[3], fb, pa0, pa1, pa2, pa3);
#pragma unroll
    for (int r = 8; r < 16; ++r) p1[r] = __builtin_amdgcn_exp2f(p1[r]);
    s0 += (p1[0] + p1[1]) + (p1[2] + p1[3]); s1 += (p1[4] + p1[5]) + (p1[6] + p1[7]); s2 += (p1[8] + p1[9]) + (p1[10] + p1[11]); s3 += (p1[12] + p1[13]) + (p1[14] + p1[15]);
    ps = (s0 + s1) + (s2 + s3);
    SGB_MFMA_VALU(6); SGB_MFMA_VALU(6); SGB_MFMA_VALU(6); SGB_MFMA_VALU(6);
    SBAR();
    if (__builtin_expect(__any(d > 0.f), 0)) {
#pragma unroll
        for (int r = 0; r < 16; ++r) { p0[r] *= alpha; p1[r] *= alpha; }
        ps *= alpha;
    }
#undef PV_WAIT
}
__device__ __forceinline__ void finishSM2(const f32x16& p0, const f32x16& p1, float alpha, float ps, float& l_reg, bf16x8& pa0, bf16x8& pa1, bf16x8& pa2, bf16x8& pa3) {
    { auto rr = __builtin_amdgcn_permlane32_swap(__float_as_uint(ps), __float_as_uint(ps), false, false); ps = __uint_as_float(rr[0]) + __uint_as_float(rr[1]); }
    l_reg = l_reg * alpha + ps;
#define PK4(P, BASE, OUT) do { unsigned a0 = cvtpk(P[BASE + 0], P[BASE + 1]), a1 = cvtpk(P[BASE + 2], P[BASE + 3]);   \
    unsigned b0 = cvtpk(P[BASE + 4], P[BASE + 5]), b1 = cvtpk(P[BASE + 6], P[BASE + 7]);                              \
    u32x4 w = {a0, a1, b0, b1}; OUT = *reinterpret_cast<bf16x8*>(&w); } while (0)
    PK4(p0, 0, pa0); PK4(p0, 8, pa1); PK4(p1, 0, pa2); PK4(p1, 8, pa3);
#undef PK4
}
__device__ __forceinline__ void attn_body(const bf16_t* __restrict__ Qb, const bf16_t* __restrict__ Kh, const bf16_t* __restrict__ Vh, float* __restrict__ Ob, int seq, char* lds) {
    const int tid = ptid(), wid = tid >> 6, lane = tid & 63, r32 = lane & 31, hi = lane >> 5;
    char* V_lds = lds; char* K_lds = lds + 3 * SHM_V;
    float* ws = (float*)(lds + 3 * SHM_V + 3 * SHM_K) + wid * 64; float* li_l = ws; float* al_l = ws + 32;
    float m_reg = 0.f, l_reg = 0; f32x16 o[4] = {}; bf16x8 qr[4];
    const bf16_t* Qw = Qb + (long)(wid * QBLK + r32) * LDQ + hi * 8;
#pragma unroll
    for (int d0 = 0; d0 < 4; ++d0) qr[d0] = *reinterpret_cast<const bf16x8*>(Qw + d0 * 16);
    const int sr = tid >> 4, sc = (tid & 15) * 8, vst0 = v_st(sr, sc), vst1 = v_st(32 + sr, sc);
    const int kr = tid >> 3, kc = (tid & 7) * 8, kst = KSWZ64(kr, kc * 2);
    const unsigned gvo0 = (unsigned)(sr * LDQ + sc) * 2u, gvo1 = (unsigned)((32 + sr) * LDQ + sc) * 2u, gko = (unsigned)(kr * LDQ + kc) * 2u;
    const int vb0 = (int)(uintptr_t)V_lds + v_rd_base(lane);
    struct { bf16x8 vs0, vs1, ks0; } sr_[2];
#define SLOAD(i, k0) do { const char* vb_ = (const char*)Vh + (size_t)(k0) * (LDQ * 2); const char* kb_ = (const char*)Kh + (size_t)(k0) * (LDQ * 2);     \
    sr_[i].vs0 = *reinterpret_cast<const bf16x8*>(vb_ + gvo0); sr_[i].vs1 = *reinterpret_cast<const bf16x8*>(vb_ + gvo1); sr_[i].ks0 = *reinterpret_cast<const bf16x8*>(kb_ + gko); } while (0)
#define SWRITE(b, i) do { *(bf16x8*)(V_lds + (b) * SHM_V + vst0) = sr_[i].vs0; *(bf16x8*)(V_lds + (b) * SHM_V + vst1) = sr_[i].vs1; *(bf16x8*)(K_lds + (b) * SHM_K + kst) = sr_[i].ks0; } while (0)
#define SWAIT() asm volatile("s_waitcnt vmcnt(3)" ::: "memory")
#define RESC(a) do { if (__any((a) < 1.f)) { if (hi == 0) al_l[r32] = (a); asm volatile("s_waitcnt lgkmcnt(0)" ::: "memory"); \
    _Pragma("unroll") for (int d = 0; d < 4; ++d) _Pragma("unroll") for (int r = 0; r < 16; ++r) o[d][r] *= al_l[crow(r, hi)]; } } while (0)
    f32x16 pA0, pA1, pB0, pB1; float alA, alB, psA = 0.f, psB = 0.f; bf16x8 pa0, pa1, pa2, pa3; const int NT = seq / KVBLK;
    constexpr int SE = 0, SO = 1;
    SLOAD(SE, 0); asm volatile("s_waitcnt vmcnt(0)" ::: "memory"); SWRITE(0, SE); __syncthreads();
    qkt(pA0, pA1, K_lds, qr, r32, hi, -m_reg); partialSM(pA0, pA1, m_reg, alA);
    SLOAD(SO, KVBLK); if (2 < NT) SLOAD(SE, 2 * KVBLK);
    SWAIT(); SWRITE(1, SO); RESC(alA); __syncthreads();
    int bc = 1, bn = 2, bp = 0;
#define ASTEP(j_, PX0, PX1, ALX, PSX, PY0, PY1, ALY, PSY, SLD, SWR, FIRST) do { \
        SBAR(); qkt(PX0, PX1, K_lds + bc * SHM_K, qr, r32, hi, -m_reg); \
        if (FIRST) finishSM(PY0, PY1, ALY, l_reg, pa0, pa1, pa2, pa3); else finishSM2(PY0, PY1, ALY, PSY, l_reg, pa0, pa1, pa2, pa3); SBAR(); \
        if ((j_) + 2 < NT) SLOAD(SLD, ((j_) + 2) * KVBLK); SBAR(); \
        pv_sm(o, vb0 + bp * SHM_V, pa0, pa1, pa2, pa3, PX0, PX1, m_reg, ALX, PSX); \
        SWAIT(); if ((j_) + 1 < NT) SWRITE(bn, SWR); \
        RESC(ALX); __syncthreads(); \
        { const int t_ = bc; bc = bn; bn = bp; bp = t_; } } while (0)
    ASTEP(1, pB0, pB1, alB, psB, pA0, pA1, alA, psA, SO, SE, true);
    for (int j = 2; j + 1 < NT; j += 2) {
        ASTEP(j, pA0, pA1, alA, psA, pB0, pB1, alB, psB, SE, SO, false);
        ASTEP(j + 1, pB0, pB1, alB, psB, pA0, pA1, alA, psA, SO, SE, false);
    }
#undef ASTEP
    finishSM2(pB0, pB1, alB, psB, l_reg, pa0, pa1, pa2, pa3); SBAR();
    { VFrag f0; pv_read<0>(f0, vb0 + bp * SHM_V); asm volatile("s_waitcnt lgkmcnt(0)" ::: "memory"); SBAR(); pv_mma(o[0], f0, pa0, pa1, pa2, pa3);
      pv_read<1>(f0, vb0 + bp * SHM_V); asm volatile("s_waitcnt lgkmcnt(0)" ::: "memory"); SBAR(); pv_mma(o[1], f0, pa0, pa1, pa2, pa3);
      pv_read<2>(f0, vb0 + bp * SHM_V); asm volatile("s_waitcnt lgkmcnt(0)" ::: "memory"); SBAR(); pv_mma(o[2], f0, pa0, pa1, pa2, pa3);
      pv_read<3>(f0, vb0 + bp * SHM_V); asm volatile("s_waitcnt lgkmcnt(0)" ::: "memory"); SBAR(); pv_mma(o[3], f0, pa0, pa1, pa2, pa3); }
    if (hi == 0) li_l[r32] = l_reg; asm volatile("s_waitcnt lgkmcnt(0)" ::: "memory");
    float rli[16];
#pragma unroll
    for (int r = 0; r < 16; ++r) rli[r] = __builtin_amdgcn_rcpf(li_l[crow(r, hi)]);
    float* Ow = Ob + (long)(wid * QBLK) * LDO;
#pragma unroll
    for (int r = 0; r < 16; ++r) { const int orow = crow(r, hi);
#pragma unroll
        for (int d0 = 0; d0 < 4; ++d0) Ow[(long)orow * LDO + d0 * 32 + r32] = o[d0][r] * rli[r]; }
    __syncthreads();
#undef SLOAD
#undef SWRITE
#undef SWAIT
#undef RESC
}


__device__ __forceinline__ void qkt0(f32x16& p0, f32x16& p1, const char* Ks, const bf16x8* qr, int r32, int hi) {
    p0 = f32x16{}; p1 = f32x16{};
#pragma unroll
    for (int d0 = 0; d0 < 4; ++d0) { const int cb = (d0 * 16 + hi * 8) * 2;
        bf16x8 b0 = *reinterpret_cast<const bf16x8*>(Ks + KSWZ64(r32, cb));
        bf16x8 b1 = *reinterpret_cast<const bf16x8*>(Ks + KSWZ64(32 + r32, cb));
        p0 = __builtin_amdgcn_mfma_f32_32x32x16_bf16(b0, qr[d0], p0, 0, 0, 0);
        p1 = __builtin_amdgcn_mfma_f32_32x32x16_bf16(b1, qr[d0], p1, 0, 0, 0); }
}
struct VFragT { bf16x8 f[4]; };
template <int D0> __device__ __forceinline__ void pv_readT(VFragT& f, const char* vbp) {
#pragma unroll
    for (int ks = 0; ks < 4; ++ks) f.f[ks] = *reinterpret_cast<const bf16x8*>(vbp + D0 * 32 * VPITCH + ks * 32);
}
__device__ __forceinline__ void pv_mmaT(f32x16& od, const VFragT& f, bf16x8 pa0, bf16x8 pa1, bf16x8 pa2, bf16x8 pa3) {
    od = __builtin_amdgcn_mfma_f32_32x32x16_bf16(pa0, f.f[0], od, 0, 0, 0);
    od = __builtin_amdgcn_mfma_f32_32x32x16_bf16(pa1, f.f[1], od, 0, 0, 0);
    od = __builtin_amdgcn_mfma_f32_32x32x16_bf16(pa2, f.f[2], od, 0, 0, 0);
    od = __builtin_amdgcn_mfma_f32_32x32x16_bf16(pa3, f.f[3], od, 0, 0, 0);
}
__device__ __forceinline__ void pack_p(const f32x16& p0, const f32x16& p1, bf16x8& pa0, bf16x8& pa1, bf16x8& pa2, bf16x8& pa3) {
#define PK4(P, BASE, OUT) do { unsigned a0 = cvtpk(P[BASE + 0], P[BASE + 1]), a1 = cvtpk(P[BASE + 2], P[BASE + 3]);   \
    unsigned b0 = cvtpk(P[BASE + 4], P[BASE + 5]), b1 = cvtpk(P[BASE + 6], P[BASE + 7]);                              \
    u32x4 w = {a0, a1, b0, b1}; OUT = *reinterpret_cast<bf16x8*>(&w); } while (0)
    PK4(p0, 0, pa0); PK4(p0, 8, pa1); PK4(p1, 0, pa2); PK4(p1, 8, pa3);
#undef PK4
}
__device__ __forceinline__ void pv_exp(f32x16* o, const char* vb, VFragT& fa, bf16x8 pa0, bf16x8 pa1, bf16x8 pa2, bf16x8 pa3, f32x16& p0, f32x16& p1, float& lpart, const char* kpre, bf16x8 (&kf)[8], int r32, int hi) {
    VFragT fb;
#define PV_WAIT() do { asm volatile("s_waitcnt lgkmcnt(0)" ::: "memory"); SBAR(); } while (0)
    PV_WAIT();
    pv_readT<1>(fb, vb); pv_mmaT(o[0], fa, pa0, pa1, pa2, pa3);
#pragma unroll
    for (int r = 0; r < 8; ++r) p0[r] = __builtin_amdgcn_exp2f(p0[r]);
    SGB_MFMA_VALU(2); SGB_MFMA_VALU(2); SGB_MFMA_VALU(2); SGB_MFMA_VALU(2);
    PV_WAIT();
    pv_readT<2>(fa, vb); pv_mmaT(o[1], fb, pa0, pa1, pa2, pa3);
#pragma unroll
    for (int r = 8; r < 16; ++r) p0[r] = __builtin_amdgcn_exp2f(p0[r]);
    float s0 = (p0[0] + p0[1]) + (p0[2] + p0[3]), s1 = (p0[4] + p0[5]) + (p0[6] + p0[7]);
    SGB_MFMA_VALU(4); SGB_MFMA_VALU(4); SGB_MFMA_VALU(4); SGB_MFMA_VALU(4);
    PV_WAIT();
    pv_readT<3>(fb, vb); pv_mmaT(o[2], fa, pa0, pa1, pa2, pa3);
#pragma unroll
    for (int r = 0; r < 8; ++r) p1[r] = __builtin_amdgcn_exp2f(p1[r]);
    float s2 = (p0[8] + p0[9]) + (p0[10] + p0[11]), s3 = (p0[12] + p0[13]) + (p0[14] + p0[15]);
    SGB_MFMA_VALU(4); SGB_MFMA_VALU(4); SGB_MFMA_VALU(4); SGB_MFMA_VALU(4);
    PV_WAIT();
#pragma unroll
    for (int d0 = 0; d0 < 4; ++d0) { const int cb = (d0 * 16 + hi * 8) * 2; kf[2 * d0] = *reinterpret_cast<const bf16x8*>(kpre + KSWZ64(r32, cb)); kf[2 * d0 + 1] = *reinterpret_cast<const bf16x8*>(kpre + KSWZ64(32 + r32, cb)); }
    pv_mmaT(o[3], fb, pa0, pa1, pa2, pa3);
#pragma unroll
    for (int r = 8; r < 16; ++r) p1[r] = __builtin_amdgcn_exp2f(p1[r]);
    s0 += (p1[0] + p1[1]) + (p1[2] + p1[3]); s1 += (p1[4] + p1[5]) + (p1[6] + p1[7]); s2 += (p1[8] + p1[9]) + (p1[10] + p1[11]); s3 += (p1[12] + p1[13]) + (p1[14] + p1[15]);
    lpart += (s0 + s1) + (s2 + s3);
    SGB_MFMA_VALU(6); SGB_MFMA_VALU(6); SGB_MFMA_VALU(6); SGB_MFMA_VALU(6);
    SBAR();
#undef PV_WAIT
}
struct FuseArgs { float lam, gs; const float* sub; bf16_t* A2b; unsigned* o0g; };
template <int MODE>
__device__ __forceinline__ void attn_body_fast(const bf16_t* __restrict__ Qb, const bf16_t* __restrict__ Kh, const bf16_t* __restrict__ Vh, float* __restrict__ Ob, int seq, char* lds, const FuseArgs fa_) {
    const int tid = ptid(), wid = __builtin_amdgcn_readfirstlane(tid >> 6), lane = tid & 63, r32 = lane & 31, hi = lane >> 5;
    char* V_lds = lds; char* K_lds = lds + 3 * SHM_V;
    float* ws = (float*)(lds + 3 * SHM_V + 3 * SHM_K) + wid * 64; float* li_l = ws;
    volatile int* badflag = (volatile int*)(lds + 3 * SHM_V + 3 * SHM_K + NW * 64 * 4);
    float lpart = 0.f; f32x16 o[4] = {}; bf16x8 qr[4];
    const bf16_t* Qw = Qb + (long)(wid * QBLK + r32) * LDQ + hi * 8;
#pragma unroll
    for (int d0 = 0; d0 < 4; ++d0) qr[d0] = *reinterpret_cast<const bf16x8*>(Qw + d0 * 16);
    const int vd = tid >> 2, vc = (tid & 3) * 2, vstT = vd * VPITCH + vc * 16;
    const int kr = tid >> 3, kc = (tid & 7) * 8, krs = (kr & ~0xC) | ((kr & 4) << 1) | ((kr & 8) >> 1), kst = KSWZ64(krs, kc * 2);
    const unsigned gvo = (unsigned)(vd * R + vc * 8) * 2u, gko = (unsigned)(kr * LDQ + kc) * 2u;
    const char* vb0 = V_lds + r32 * VPITCH + hi * 16;
    struct { bf16x8 vs0, vs1, ks0; } sr_[2];
#define TCL(t_) ((t_) < NT ? (t_) : NT - 1)
#define SLOAD(i, t_) do { const char* vb_ = (const char*)Vh + (size_t)(TCL(t_) * KVBLK) * 2; const char* kb_ = (const char*)Kh + (size_t)(TCL((t_) + 1) * KVBLK) * (LDQ * 2);     \
    sr_[i].vs0 = *reinterpret_cast<const bf16x8*>(vb_ + gvo); sr_[i].vs1 = *reinterpret_cast<const bf16x8*>(vb_ + gvo + 16); sr_[i].ks0 = *reinterpret_cast<const bf16x8*>(kb_ + gko); } while (0)
#define SWRITE(bv, bk, i) do { *(bf16x8*)(V_lds + (bv) * SHM_V + vstT) = sr_[i].vs0; *(bf16x8*)(V_lds + (bv) * SHM_V + vstT + 16) = sr_[i].vs1; *(bf16x8*)(K_lds + (bk) * SHM_K + kst) = sr_[i].ks0; } while (0)
#define SWAIT() asm volatile("s_waitcnt vmcnt(3)" ::: "memory")
    f32x16 pA0, pA1, pB0, pB1; bf16x8 pa0, pa1, pa2, pa3; const int NT = seq / KVBLK;
    constexpr int SE = 0, SO = 1;
    if (MODE == 0 && tid == 0) *badflag = 0;
    bf16x8 kf[8];
    {
        const bf16x8 k0r = *reinterpret_cast<const bf16x8*>((const char*)Kh + gko);
        SLOAD(SE, 0); asm volatile("s_waitcnt vmcnt(0)" ::: "memory");
        *(bf16x8*)(K_lds + kst) = k0r; SWRITE(0, 1, SE); __syncthreads();
    }
    qkt0(pA0, pA1, K_lds, qr, r32, hi);
#pragma unroll
    for (int r = 0; r < 16; ++r) { pA0[r] = __builtin_amdgcn_exp2f(pA0[r]); pA1[r] = __builtin_amdgcn_exp2f(pA1[r]); lpart += pA0[r] + pA1[r]; }
    SLOAD(SO, 1); SLOAD(SE, 2);
#pragma unroll
    for (int d0 = 0; d0 < 4; ++d0) { const int cb = (d0 * 16 + hi * 8) * 2; kf[2 * d0] = *reinterpret_cast<const bf16x8*>(K_lds + SHM_K + KSWZ64(r32, cb)); kf[2 * d0 + 1] = *reinterpret_cast<const bf16x8*>(K_lds + SHM_K + KSWZ64(32 + r32, cb)); }
    SWAIT(); SWRITE(1, 2, SO); __syncthreads();
    int bc = 1, bn = 2, bp = 0;
#define FSTEP(j_, PX0, PX1, PY0, PY1, SLD, SWR) do { \
        SBAR(); VFragT fa0_; pv_readT<0>(fa0_, vb0 + bp * SHM_V); \
        PX0 = f32x16{}; PX1 = f32x16{}; \
        _Pragma("unroll") for (int d0 = 0; d0 < 4; ++d0) { PX0 = __builtin_amdgcn_mfma_f32_32x32x16_bf16(kf[2 * d0], qr[d0], PX0, 0, 0, 0); PX1 = __builtin_amdgcn_mfma_f32_32x32x16_bf16(kf[2 * d0 + 1], qr[d0], PX1, 0, 0, 0); } \
        pack_p(PY0, PY1, pa0, pa1, pa2, pa3); SBAR(); \
        SLOAD(SLD, (j_) + 2); SBAR(); \
        pv_exp(o, vb0 + bp * SHM_V, fa0_, pa0, pa1, pa2, pa3, PX0, PX1, lpart, K_lds + bn * SHM_K, kf, r32, hi); \
        SWAIT(); SWRITE(bn, bp, SWR); \
        __syncthreads(); \
        { const int t_ = bc; bc = bn; bn = bp; bp = t_; } } while (0)
    for (int j = 1; j + 1 < NT; j += 2) {
        FSTEP(j, pB0, pB1, pA0, pA1, SO, SE);
        FSTEP(j + 1, pA0, pA1, pB0, pB1, SE, SO);
    }
    FSTEP(NT - 1, pB0, pB1, pA0, pA1, SO, SE);
#undef TCL
#undef FSTEP
    pack_p(pB0, pB1, pa0, pa1, pa2, pa3); SBAR();
    { VFragT f0; pv_readT<0>(f0, vb0 + bp * SHM_V); asm volatile("s_waitcnt lgkmcnt(0)" ::: "memory"); SBAR(); pv_mmaT(o[0], f0, pa0, pa1, pa2, pa3);
      pv_readT<1>(f0, vb0 + bp * SHM_V); asm volatile("s_waitcnt lgkmcnt(0)" ::: "memory"); SBAR(); pv_mmaT(o[1], f0, pa0, pa1, pa2, pa3);
      pv_readT<2>(f0, vb0 + bp * SHM_V); asm volatile("s_waitcnt lgkmcnt(0)" ::: "memory"); SBAR(); pv_mmaT(o[2], f0, pa0, pa1, pa2, pa3);
      pv_readT<3>(f0, vb0 + bp * SHM_V); asm volatile("s_waitcnt lgkmcnt(0)" ::: "memory"); SBAR(); pv_mmaT(o[3], f0, pa0, pa1, pa2, pa3); }
    float l_reg;
    { auto rr = __builtin_amdgcn_permlane32_swap(__float_as_uint(lpart), __float_as_uint(lpart), false, false); l_reg = __uint_as_float(rr[0]) + __uint_as_float(rr[1]); }
    const bool bad = !(l_reg > 1e-30f && l_reg < 1e30f);
    if (__any(bad) && lane == 0) *badflag = 1;
    if (hi == 0) li_l[r32] = l_reg; asm volatile("s_waitcnt lgkmcnt(0)" ::: "memory");
    float rli[16];
#pragma unroll
    for (int r = 0; r < 16; ++r) rli[r] = __builtin_amdgcn_rcpf(li_l[crow(r, hi)]);
    unsigned* O0 = fa_.o0g + (size_t)wid * 32 * 64 + lane;
    if (MODE == 0) {
        float* Ow = Ob + (long)(wid * QBLK) * LDO;
#pragma unroll
        for (int r = 0; r < 16; ++r) { const int orow = crow(r, hi);
#pragma unroll
            for (int d0 = 0; d0 < 4; ++d0) Ow[(long)orow * LDO + d0 * 32 + r32] = o[d0][r] * rli[r]; }
        __syncthreads();
        const int redo = *badflag;
        __syncthreads();
        if (redo) attn_body(Qb, Kh, Vh, Ob, seq, lds);
    } else if (MODE == 1) {
#pragma unroll
        for (int d0 = 0; d0 < 4; ++d0)
#pragma unroll
            for (int r = 0; r < 16; r += 2) O0[(d0 * 8 + (r >> 1)) * 64] = pk2(o[d0][r] * rli[r], o[d0][r + 1] * rli[r + 1]);
        __syncthreads();
    } else {
        float qq[16];
#pragma unroll
        for (int r = 0; r < 16; ++r) qq[r] = 0.f;
#pragma unroll
        for (int d0 = 0; d0 < 4; ++d0)
#pragma unroll
            for (int r = 0; r < 16; r += 2) {
                const unsigned w = O0[(d0 * 8 + (r >> 1)) * 64];
                o[d0][r] = bf2f(w & 0xffffu) - fa_.lam * (o[d0][r] * rli[r]); o[d0][r + 1] = bf2f(w >> 16) - fa_.lam * (o[d0][r + 1] * rli[r + 1]);
                qq[r] += o[d0][r] * o[d0][r]; qq[r + 1] += o[d0][r + 1] * o[d0][r + 1];
            }
#pragma unroll
        for (int r = 0; r < 16; ++r) {
            float v = qq[r];
            v += dppmov<0xB1>(v); v += dppmov<0x4E>(v); v += dppmov<0x141>(v); v += dppmov<0x140>(v); v += __shfl_xor(v, 16);
            qq[r] = rsqrtf(v * (1.f / 128.f) + 1e-5f);
        }
        float gg[4];
#pragma unroll
        for (int d0 = 0; d0 < 4; ++d0) gg[d0] = fa_.sub[d0 * 32 + r32] * fa_.gs;
        bf16_t* Aw = fa_.A2b + (size_t)(wid * QBLK) * 1024;
        __syncthreads();
        char* stg = lds + wid * (32 * 272);
#pragma unroll
        for (int r = 0; r < 16; ++r) { const int orow = crow(r, hi);
#pragma unroll
            for (int d0 = 0; d0 < 4; ++d0) *(bf16_t*)(stg + orow * 272 + (d0 * 32 + r32) * 2) = (bf16_t)f2bf(o[d0][r] * qq[r] * gg[d0]); }
#pragma unroll
        for (int i = 0; i < 8; ++i) { const int row = (lane >> 4) + 4 * i, ch = lane & 15;
            const u32x4 w = *(const u32x4*)(stg + row * 272 + ch * 16);
            *(u32x4*)(Aw + (size_t)row * 1024 + ch * 8) = w; }
        __syncthreads();
    }
#undef SLOAD
#undef SWRITE
#undef SWAIT
}
}

__device__ __forceinline__ void comb_rows(const Params& p, int j, float lam, float lam_init, int row_lo, int row_hi, int h) {
    const int lane = ptid() & 63, wv = ptid() >> 6;
    const float* O = (const float*)(p.ws + WS_O); bf16_t* A2 = (bf16_t*)(p.ws + WS_A2); const float* sub = p.in[10] + j * 128;
    for (int row = row_lo + wv; row < row_hi; row += 8) {
        const float* o0 = O + (size_t)row * 2048 + h * 256 + lane * 2;
        const float d0 = o0[0] - lam * o0[128], d1 = o0[1] - lam * o0[129];
        const float rs = rsqrtf(wave_sum(d0 * d0 + d1 * d1) * (1.f / 128.f) + 1e-5f);
        *(unsigned*)(A2 + (size_t)row * 1024 + h * 128 + lane * 2) = pk2(d0 * rs * sub[lane * 2] * (1.f - lam_init), d1 * rs * sub[lane * 2 + 1] * (1.f - lam_init));
    }
}
__device__ __forceinline__ void phase_attn_fused(const Params& p, int j, float lam_init, int with_ctx, char* lds) {
    const bf16_t* QKV = (const bf16_t*)(p.ws + WS_QKV); float* O = (float*)(p.ws + WS_O); bf16_t* A2 = (bf16_t*)(p.ws + WS_A2);
    const int lane = ptid() & 63;
    const float* lp = p.in[9] + j * 256;
    const float lam = expf(wave_sum(lp[lane] * lp[64 + lane])) - expf(wave_sum(lp[128 + lane] * lp[192 + lane])) + lam_init;
    volatile int* badflag = (volatile int*)(lds + 3 * att::SHM_V + 3 * att::SHM_K + att::NW * 64 * 4);
    const int nlat = 64 * 8, nU = nlat + (with_ctx ? 8 : 0);
    for (int u = blockIdx.x; u < nU; u += gridDim.x) {
        int head, row0, nkeys;
        if (u < nlat) { const int k = u >> 8, b = u & 255, xcd = b & 7, idx = b >> 3; head = 4 * k + (xcd >> 1); row0 = RC + ((xcd & 1) * 32 + idx) * 256; nkeys = R; }
        else { head = u - nlat; row0 = 0; nkeys = RC; }
        if (ptid() == 0) *badflag = 0;
        const att::FuseArgs fa{lam, 1.f - lam_init, p.in[10] + j * 128, A2 + (size_t)row0 * 1024 + head * 128, (unsigned*)(p.ws + WS_O0) + (size_t)blockIdx.x * 16384};
        const bf16_t* VTh = (const bf16_t*)(p.ws + WS_VT) + (size_t)head * 128 * R;
        const bf16_t* Qb = QKV + (size_t)row0 * 3072 + head * 128; const bf16_t* Kb = QKV + 1024 + head * 128; const bf16_t* Vb = QKV + 2048 + head * 128;
        att::attn_body_fast<1>(Qb, Kb, VTh, nullptr, nkeys, lds, fa);
        att::attn_body_fast<2>(Qb + 64, Kb + 64, VTh, nullptr, nkeys, lds, fa);
        const int redo = *badflag;
        __syncthreads();
        if (redo) {
            att::attn_body(Qb, Kb, Vb, O + (size_t)row0 * 2048 + head * 256, nkeys, lds);
            att::attn_body(Qb + 64, Kb + 64, Vb, O + (size_t)row0 * 2048 + head * 256 + 128, nkeys, lds);
            asm volatile("s_waitcnt vmcnt(0)" ::: "memory"); __syncthreads();
            comb_rows(p, j, lam, lam_init, row0, row0 + 256, head);
            __syncthreads();
        }
    }
}

__device__ __forceinline__ void phase_lnv(const Params& p) {
    const int lane = ptid() & 63, wv = ptid() >> 6;
    const bf16_t* VP = (const bf16_t*)(p.ws + WS_VP); bf16_t* VN = (bf16_t*)(p.ws + WS_VN);
    const float* lg = p.in[13]; const float* lb = p.in[14];
    const int rstep = gridDim.x * 8;
    u32x2 xr[4];
    { const int r0 = blockIdx.x * 8 + wv;
#pragma unroll
      for (int j = 0; j < 4; ++j) xr[j] = *(const u32x2*)(VP + (size_t)(r0 < R ? r0 : R - 1) * 1024 + j * 256 + lane * 4); }
    for (int row = blockIdx.x * 8 + wv; row < R; row += rstep) {
        f32x4 x[4]; float s = 0.f;
#pragma unroll
        for (int j = 0; j < 4; ++j) { x[j][0] = bf2f(xr[j][0]); x[j][1] = __uint_as_float(xr[j][0] & 0xffff0000u); x[j][2] = bf2f(xr[j][1]); x[j][3] = __uint_as_float(xr[j][1] & 0xffff0000u); s += x[j][0] + x[j][1] + x[j][2] + x[j][3]; }
        { const int rn = row + rstep < R ? row + rstep : R - 1;
#pragma unroll
          for (int j = 0; j < 4; ++j) xr[j] = *(const u32x2*)(VP + (size_t)rn * 1024 + j * 256 + lane * 4); }
        const float mean = wave_sum(s) * (1.f / 1024.f);
        float q = 0.f;
#pragma unroll
        for (int j = 0; j < 4; ++j) { x[j] = x[j] - mean; q += x[j][0] * x[j][0] + x[j][1] * x[j][1] + x[j][2] * x[j][2] + x[j][3] * x[j][3]; }
        const float rs = rsqrtf(wave_sum(q) * (1.f / 1024.f) + 1e-5f);
#pragma unroll
        for (int j = 0; j < 4; ++j) {
            const int col = j * 256 + lane * 4;
            const f32x4 h = x[j] * rs * *(const f32x4*)(lg + col) + *(const f32x4*)(lb + col);
            u32x2 w = {pk2(h[0], h[1]), pk2(h[2], h[3])};
            *(u32x2*)(VN + (size_t)row * 1024 + col) = w;
        }
    }
}


__device__ __forceinline__ void phase_spat(const Params& p, char* smem) {
    typedef short bf16x8_ __attribute__((ext_vector_type(8)));
    constexpr int LDS_ = 136;
    const int tid = ptid(), lane = tid & 63, wv = __builtin_amdgcn_readfirstlane(tid >> 6), fr = lane & 15, fq = lane >> 4;
    const bf16_t* VN = (const bf16_t*)(p.ws + WS_VN); const bf16_t* U = (const bf16_t*)(p.ws + WS_U); bf16_t* A2 = (bf16_t*)(p.ws + WS_A2);
    const bf16_t* WSb = (const bf16_t*)(p.ws + WS_WSPAT); const float* bs = p.in[16];
    bf16_t* Wl = (bf16_t*)smem; bf16_t* VT = (bf16_t*)(smem + 128 * LDS_ * 2);
    const int m0 = 32 * (wv >> 1), n0 = 64 * (wv & 1);
    for (int u = blockIdx.x; u < 130 * 8; u += gridDim.x) {
        const int c = u >> 3, g = u & 7;
        __syncthreads();
#pragma unroll
        for (int i = 0; i < 4; ++i) {
            const int idx = tid + 512 * i, rr = idx >> 4, c8 = (idx & 15) * 8;
            *(u32x4*)(Wl + rr * LDS_ + c8) = *(const u32x4*)(WSb + (size_t)g * 16384 + rr * 128 + c8);
            const u32x4 raw = *(const u32x4*)(VN + (size_t)(c * 128 + rr) * 1024 + g * 128 + c8);
#pragma unroll
            for (int e = 0; e < 4; ++e) { VT[(c8 + 2 * e) * LDS_ + rr] = (bf16_t)(raw[e] & 0xffffu); VT[(c8 + 2 * e + 1) * LDS_ + rr] = (bf16_t)(raw[e] >> 16); }
        }
        __syncthreads();
        f32x4 acc[2][4];
#pragma unroll
        for (int a = 0; a < 2; ++a)
#pragma unroll
            for (int t = 0; t < 4; ++t) acc[a][t] = (f32x4){0.f, 0.f, 0.f, 0.f};
#pragma unroll
        for (int ks = 0; ks < 4; ++ks) {
            bf16x8_ af[2];
#pragma unroll
            for (int a = 0; a < 2; ++a) af[a] = *(const bf16x8_*)(Wl + (m0 + 16 * a + fr) * LDS_ + ks * 32 + fq * 8);
#pragma unroll
            for (int t = 0; t < 4; ++t) { const bf16x8_ bq = *(const bf16x8_*)(VT + (n0 + 16 * t + fr) * LDS_ + ks * 32 + fq * 8);
#pragma unroll
                for (int a = 0; a < 2; ++a) acc[a][t] = __builtin_amdgcn_mfma_f32_16x16x32_bf16(bq, af[a], acc[a][t], 0, 0, 0); }
        }
#pragma unroll
        for (int a = 0; a < 2; ++a) {
            const int pp = m0 + 16 * a + fr; const float bias = bs[g * 128 + pp];
#pragma unroll
            for (int t = 0; t < 4; ++t) {
                const size_t off = (size_t)(c * 128 + pp) * 1024 + g * 128 + n0 + 16 * t + 4 * fq;
                const u32x2 uu = *(const u32x2*)(U + off);
                u32x2 w = {pk2(bf2f(uu[0] & 0xffffu) * (acc[a][t][0] + bias), bf2f(uu[0] >> 16) * (acc[a][t][1] + bias)), pk2(bf2f(uu[1] & 0xffffu) * (acc[a][t][2] + bias), bf2f(uu[1] >> 16) * (acc[a][t][3] + bias))};
                *(u32x2*)(A2 + off) = w;
            }
        }
    }
    __syncthreads();
}

__device__ __forceinline__ void phase_mix(const Params& p) {
    const int lane = ptid() & 63, wv = ptid() >> 6;
    const bf16_t* H = (const bf16_t*)(p.ws + WS_H); bf16_t* MX = (bf16_t*)(p.ws + WS_MIX);
    const float* mix = p.in[18];
    for (int row = blockIdx.x * 8 + wv; row < R; row += gridDim.x * 8) {
        const bool hp = (row != 0 && row != RC), hn = (row != RC - 1 && row != R - 1);
#pragma unroll
        for (int j = 0; j < 4; ++j) {
            const int col = j * 256 + lane * 4;
            const u32x2 c = *(const u32x2*)(H + (size_t)row * 1024 + col);
            u32x2 a = {0u, 0u}, b = {0u, 0u};
            if (hp) a = *(const u32x2*)(H + (size_t)(row - 1) * 1024 + col);
            if (hn) b = *(const u32x2*)(H + (size_t)(row + 1) * 1024 + col);
            float hc[4] = {bf2f(c[0] & 0xffffu), bf2f(c[0] >> 16), bf2f(c[1] & 0xffffu), bf2f(c[1] >> 16)};
            float ha[4] = {bf2f(a[0] & 0xffffu), bf2f(a[0] >> 16), bf2f(a[1] & 0xffffu), bf2f(a[1] >> 16)};
            float hb[4] = {bf2f(b[0] & 0xffffu), bf2f(b[0] >> 16), bf2f(b[1] & 0xffffu), bf2f(b[1] >> 16)};
            float ts[4];
#pragma unroll
            for (int e = 0; e < 4; ++e) ts[e] = 0.5f * (ha[e] + hb[e]) - hc[e];
#pragma unroll
            for (int q = 0; q < 6; ++q) {
                const f32x4 mq = *(const f32x4*)(mix + q * 1024 + col);
                u32x2 w = {pk2(hc[0] + ts[0] * mq[0], hc[1] + ts[1] * mq[1]), pk2(hc[2] + ts[2] * mq[2], hc[3] + ts[3] * mq[3])};
                *(u32x2*)(MX + ((size_t)q * R + row) * 1024 + col) = w;
            }
        }
    }
}

__device__ __forceinline__ void phase_kkn(const Params& p) {
    const int lane = ptid() & 63, wv = ptid() >> 6;
    const bf16_t* KK = (const bf16_t*)(p.ws + WS_KK); float* KN = (float*)(p.ws + WS_KN);
    const float* kk_ = p.in[28];
    for (int row = blockIdx.x * 8 + wv; row < R; row += gridDim.x * 8) {
        float ss = 0.f;
#pragma unroll
        for (int j = 0; j < 2; ++j) {
            const int col = lane * 16 + j * 8;
            const u32x4 raw = *(const u32x4*)(KK + (size_t)row * 1024 + col);
#pragma unroll
            for (int e = 0; e < 4; ++e) { const float a = bf2f(raw[e] & 0xffffu) * kk_[col + 2 * e], b = bf2f(raw[e] >> 16) * kk_[col + 2 * e + 1]; ss += a * a + b * b; }
        }
        ss += __shfl_xor(ss, 1); ss += __shfl_xor(ss, 2);
        if ((lane & 3) == 0) KN[(size_t)row * 16 + (lane >> 2)] = 1.f / fmaxf(sqrtf(ss), 1e-12f);
    }
}

__device__ __forceinline__ int scan_row(int z, int n) { return z == 0 ? n : (n < RC ? RC - 1 - n : R + RC - 1 - n); }

namespace ck {
using bf16x8 = __attribute__((ext_vector_type(8))) short;
constexpr int LD = 72, MBUF = 64 * LD * 2;
constexpr int NCH = 260;
constexpr int NUH = 2 * 16 * NCH;
constexpr size_t WS_CK1 = 649 * MiB;
constexpr size_t WS_CK2 = WS_S + 412 * MiB;
constexpr size_t WS_CK3 = WS_S + 65 * MiB;
constexpr size_t WS_CKS = 780 * MiB;
typedef __bf16 bf16x2n __attribute__((ext_vector_type(2))); typedef float f32x2n __attribute__((ext_vector_type(2)));
__device__ __forceinline__ unsigned cvt2(float lo, float hi) { const f32x2n v = {lo, hi}; const bf16x2n b = __builtin_convertvector(v, bf16x2n); return __builtin_bit_cast(unsigned, b); }
__device__ __forceinline__ bf16_t* slot(char* smem, int i) { return (bf16_t*)(smem + i * MBUF); }
__device__ __forceinline__ void mm_lds(const bf16_t* A, const bf16_t* B, f32x4 (&acc)[2], int m0, int n0, int fr, int fq) {
#pragma unroll
    for (int ks = 0; ks < 2; ++ks) {
        const bf16x8 af = *(const bf16x8*)(A + (m0 + fr) * LD + ks * 32 + fq * 8);
#pragma unroll
        for (int t = 0; t < 2; ++t) {
            const bf16x8 bfr = *(const bf16x8*)(B + (n0 + 16 * t + fr) * LD + ks * 32 + fq * 8);
            acc[t] = __builtin_amdgcn_mfma_f32_16x16x32_bf16(bfr, af, acc[t], 0, 0, 0);
        }
    }
}
__device__ __forceinline__ void st_row(bf16_t* D, const f32x4 (&acc)[2], int m0, int n0, int fr, int fq) {
#pragma unroll
    for (int t = 0; t < 2; ++t) { u32x2 w = {pk2(acc[t][0], acc[t][1]), pk2(acc[t][2], acc[t][3])}; *(u32x2*)(D + (m0 + fr) * LD + n0 + 16 * t + 4 * fq) = w; }
}
__device__ __forceinline__ void st_tr(bf16_t* D, const f32x4 (&acc)[2], int m0, int n0, int fr, int fq) {
#pragma unroll
    for (int t = 0; t < 2; ++t)
#pragma unroll
        for (int r = 0; r < 4; ++r) D[(n0 + 16 * t + 4 * fq + r) * LD + m0 + fr] = (bf16_t)f2bf(acc[t][r]);
}
template <bool STRICT> __device__ __forceinline__ void mask_tri(f32x4 (&acc)[2], int m0, int n0, int fr, int fq) {
#pragma unroll
    for (int t = 0; t < 2; ++t)
#pragma unroll
        for (int r = 0; r < 4; ++r) { const int s_ = m0 + fr, t_ = n0 + 16 * t + 4 * fq + r; if (STRICT ? !(s_ < t_) : !(s_ <= t_)) acc[t][r] = 0.f; }
}
struct PrepRaw { float kn[8], kkc, kac; _Float16 w[8]; bf16_t k[8], ap[8], r[8], v[8]; };
template <bool FULL>
__device__ __forceinline__ void prep_load(const Params& p, int z, int head, int cg, PrepRaw& q) {
    const int tid = ptid(), j = tid & 63, tq = tid >> 6, col = head * 64 + j;
    const bf16_t* RRb = (const bf16_t*)(p.ws + WS_RR); const bf16_t* KKb = (const bf16_t*)(p.ws + WS_KK); const bf16_t* VVb = (const bf16_t*)(p.ws + WS_VV);
    const _Float16* DEC = (const _Float16*)(p.ws + WS_DEC); const bf16_t* AP = (const bf16_t*)(p.ws + WS_AP); const float* KN = (const float*)(p.ws + WS_KN);
    q.kkc = p.in[28][col]; q.kac = p.in[29][col];
    const _Float16* DECz = DEC + (size_t)z * R * 1024; const bf16_t* APz = AP + (size_t)z * R * 1024;
#pragma unroll
    for (int e = 0; e < 8; ++e) {
        const unsigned row = (unsigned)scan_row(z, cg * 64 + tq * 8 + e), off = row * 1024u + (unsigned)col, o2 = off * 2u, o4 = off * 4u;
#define LDB(T, base, boff) (*(const T*)((const char*)(base) + (boff)))
        q.k[e] = LDB(bf16_t, KKb, o2); q.ap[e] = LDB(bf16_t, APz, o2); q.kn[e] = LDB(float, KN, (row * 16u + (unsigned)head) * 4u); q.w[e] = LDB(_Float16, DECz, o2);
        if (FULL) { q.r[e] = LDB(bf16_t, RRb, o2); q.v[e] = LDB(bf16_t, VVb, o2); }
#undef LDB
    }
}
template <bool FULL>
__device__ __forceinline__ void prep_compute(const Params& p, char* smem, int head, const PrepRaw& q) {
    const int tid = ptid(), j = tid & 63, tq = tid >> 6, col = head * 64 + j;
    float* G = (float*)(smem + 14 * MBUF); float* WE = G + 512;
    const float kkc = q.kkc, kac = q.kac;
    float w[8], a[8], b[8], kd[8], r[8], vv[8];
#pragma unroll
    for (int e = 0; e < 8; ++e) {
        const float kraw = bf2f(q.k[e]), ap = bf2f(q.ap[e]);
        const float kkv = kraw * kkc * q.kn[e];
        w[e] = (float)q.w[e]; a[e] = -kkv; b[e] = kkv * ap; kd[e] = kraw * (1.f + (ap - 1.f) * kac);
        if (FULL) { r[e] = bf2f(q.r[e]); vv[e] = bf2f(q.v[e]); }
    }
    float lp[8]; lp[0] = w[0];
#pragma unroll
    for (int e = 1; e < 8; ++e) lp[e] = lp[e - 1] * w[e];
    G[tq * 64 + j] = lp[7];
    __syncthreads();
    float pre = 1.f, wend = 1.f;
#pragma unroll
    for (int q = 0; q < 8; ++q) { const float g = G[q * 64 + j]; pre *= (q < tq) ? g : 1.f; wend *= g; }
    if (FULL && tq == 0) WE[j] = wend;
    bf16_t* At = slot(smem, 0); bf16_t* AtT = slot(smem, 1); bf16_t* Rt = slot(smem, 2); bf16_t* Bt = slot(smem, 3); bf16_t* Kt = slot(smem, 4);
    bf16_t* BhT = slot(smem, 5); bf16_t* Kh = slot(smem, 6); bf16_t* VA = slot(smem, 7);
    unsigned atp[4], bhp[4], vap[4]; float atv[8], btv[8], bhv[8], rtv[8], ktv[8], khv[8];
#pragma unroll
    for (int e = 0; e < 8; ++e) {
        const int t = tq * 8 + e;
        const float Wt = pre * lp[e], Wm1 = e == 0 ? pre : pre * lp[e - 1], iw = __builtin_amdgcn_rcpf(Wt);
        const float at = a[e] * Wm1, bt = b[e] * iw;
        atv[e] = at; btv[e] = bt; bhv[e] = bt * wend;
        if (FULL) { const float kt = kd[e] * iw; rtv[e] = r[e] * Wt; ktv[e] = kt; khv[e] = kt * wend; }
    }
#pragma unroll
    for (int e = 0; e < 8; e += 2) {
        const int t = tq * 8 + e;
        const unsigned pa = cvt2(atv[e], atv[e + 1]), pb = cvt2(btv[e], btv[e + 1]);
        At[t * LD + j] = (bf16_t)(pa & 0xffffu); At[(t + 1) * LD + j] = (bf16_t)(pa >> 16); Bt[t * LD + j] = (bf16_t)(pb & 0xffffu); Bt[(t + 1) * LD + j] = (bf16_t)(pb >> 16);
        if (FULL) { const unsigned pr = cvt2(rtv[e], rtv[e + 1]), pk = cvt2(ktv[e], ktv[e + 1]), ph = cvt2(khv[e], khv[e + 1]);
            Rt[t * LD + j] = (bf16_t)(pr & 0xffffu); Rt[(t + 1) * LD + j] = (bf16_t)(pr >> 16); Kt[t * LD + j] = (bf16_t)(pk & 0xffffu); Kt[(t + 1) * LD + j] = (bf16_t)(pk >> 16);
            Kh[t * LD + j] = (bf16_t)(ph & 0xffffu); Kh[(t + 1) * LD + j] = (bf16_t)(ph >> 16); }
    }
    if (FULL) {
#pragma unroll
        for (int e = 0; e < 4; ++e) { atp[e] = cvt2(atv[2 * e], atv[2 * e + 1]); bhp[e] = cvt2(bhv[2 * e], bhv[2 * e + 1]); vap[e] = (unsigned)q.v[2 * e] | ((unsigned)q.v[2 * e + 1] << 16); }
        *(u32x4*)(AtT + j * LD + tq * 8) = (u32x4){atp[0], atp[1], atp[2], atp[3]};
        *(u32x4*)(BhT + j * LD + tq * 8) = (u32x4){bhp[0], bhp[1], bhp[2], bhp[3]};
        *(u32x4*)(VA + j * LD + tq * 8) = (u32x4){vap[0], vap[1], vap[2], vap[3]};
    }
    __syncthreads();
}
__device__ __forceinline__ void unit_ids(int half, int ul, int& z, int& head, int& cg) { const int zh = ul & 31; z = zh >> 4; head = zh & 15; cg = half * NCH + (ul >> 5); }

__device__ __forceinline__ void phase_c1(const Params& p, int half, char* smem) {
    const int tid = ptid(), lane = tid & 63, wv = __builtin_amdgcn_readfirstlane(tid >> 6), fr = lane & 15, fq = lane >> 4, m0 = 16 * (wv >> 1), n0 = 32 * (wv & 1);
    const int G = (int)gridDim.x, u0 = (int)blockIdx.x;
    if (u0 >= NUH) return;
#define C1_LOAD(Q, ul_) do { int ux_ = (ul_); ux_ = ux_ < NUH ? ux_ : u0; int z_, head_, cg_; unit_ids(half, ux_, z_, head_, cg_); prep_load<false>(p, z_, head_, cg_, Q); } while (0)
#define C1_BODY(Q, ul_) do { int z_, head_, cg_; unit_ids(half, (ul_), z_, head_, cg_); prep_compute<false>(p, smem, head_, Q); \
        f32x4 acc[2] = {{0.f, 0.f, 0.f, 0.f}, {0.f, 0.f, 0.f, 0.f}}; \
        mm_lds(slot(smem, 3), slot(smem, 0), acc, m0, n0, fr, fq); mask_tri<true>(acc, m0, n0, fr, fq); \
        float* M = (float*)(p.ws + WS_CK1) + (size_t)(ul_) * 4096; \
        _Pragma("unroll") for (int t = 0; t < 2; ++t) *(f32x4*)(M + (m0 + fr) * 64 + n0 + 16 * t + 4 * fq) = acc[t]; \
        __syncthreads(); } while (0)
    PrepRaw q0, q1, q2;
    C1_LOAD(q0, u0); C1_LOAD(q1, u0 + G);
#pragma unroll 1
    for (int ul = u0; ul < NUH; ul += 3 * G) {
        C1_LOAD(q2, ul + 2 * G); C1_BODY(q0, ul);
        C1_LOAD(q0, ul + 3 * G); if (ul + G < NUH) { C1_BODY(q1, ul + G); }
        C1_LOAD(q1, ul + 4 * G); if (ul + 2 * G < NUH) { C1_BODY(q2, ul + 2 * G); }
    }
#undef C1_LOAD
#undef C1_BODY
}
__device__ __forceinline__ void phase_c2(const Params& p, char* smem) {
    const int tid = ptid(), lane = tid & 63, wv = __builtin_amdgcn_readfirstlane(tid >> 6);
    float* Ms = (float*)(smem + wv * 16384);
    const int G8 = (int)gridDim.x * 8, u0 = wv * (int)gridDim.x + (int)blockIdx.x;
    f32x4 mreg[16];
    if (u0 < NUH) {
        const float* M = (const float*)(p.ws + WS_CK1) + (size_t)u0 * 4096;
#pragma unroll
        for (int i = 0; i < 16; ++i) mreg[i] = *(const f32x4*)(M + i * 256 + lane * 4);
    }
    for (int ul = u0; ul < NUH; ul += G8) {
#pragma unroll
        for (int i = 0; i < 16; ++i) *(f32x4*)(Ms + i * 256 + lane * 4) = mreg[i];
        if (ul + G8 < NUH) {
            const float* M = (const float*)(p.ws + WS_CK1) + (size_t)(ul + G8) * 4096;
#pragma unroll
            for (int i = 0; i < 16; ++i) mreg[i] = *(const f32x4*)(M + i * 256 + lane * 4);
        }
        typedef float f32x2p __attribute__((ext_vector_type(2)));
        f32x2p xx[32];
#pragma unroll
        for (int q = 0; q < 32; ++q) xx[q] = (f32x2p){0.f, 0.f};
        xx[31][1] = lane == 63 ? 1.f : 0.f;
#pragma unroll
        for (int s_ = 62; s_ >= 0; --s_) {
            f32x2p acc2 = {0.f, 0.f}; float acc1 = 0.f;
#pragma unroll
            for (int q4 = ((s_ + 1) & ~3); q4 < 64; q4 += 4) {
                const f32x4 mrow = *(const f32x4*)(Ms + s_ * 64 + q4);
#pragma unroll
                for (int pr = 0; pr < 2; ++pr) { const int q = q4 + 2 * pr;
                    if (q > s_) acc2 = acc2 + (f32x2p){mrow[2 * pr], mrow[2 * pr + 1]} * xx[q >> 1];
                    else if (q + 1 > s_) acc1 += mrow[2 * pr + 1] * xx[q >> 1][1]; }
            }
            xx[s_ >> 1][s_ & 1] = lane == s_ ? 1.f : (acc2[0] + acc2[1]) + acc1;
        }
        float x[64];
#pragma unroll
        for (int q = 0; q < 64; ++q) x[q] = xx[q >> 1][q & 1];
        bf16_t* To = (bf16_t*)(p.ws + WS_CK2) + (size_t)ul * 4096;
#pragma unroll
        for (int q = 0; q < 64; ++q) To[q * 64 + lane] = (bf16_t)f2bf(x[q]);
    }
}
__device__ __forceinline__ void phase_c3(const Params& p, int half, char* smem) {
    const int tid = ptid(), lane = tid & 63, wv = __builtin_amdgcn_readfirstlane(tid >> 6), fr = lane & 15, fq = lane >> 4, m0 = 16 * (wv >> 1), n0 = 32 * (wv & 1);
    bf16_t* Y = (bf16_t*)(p.ws + WS_Y);
    const float* WE = (const float*)(smem + 14 * MBUF) + 512;
    PrepRaw pq; u32x4 traw = {0u, 0u, 0u, 0u};
    const int trr = tid >> 3, tc8 = (tid & 7) * 8;
    if ((int)blockIdx.x < NUH) { int z, head, cg; unit_ids(half, (int)blockIdx.x, z, head, cg); prep_load<true>(p, z, head, cg, pq); traw = *(const u32x4*)((const bf16_t*)(p.ws + WS_CK2) + (size_t)blockIdx.x * 4096 + trr * 64 + tc8); }
    for (int ul = blockIdx.x; ul < NUH; ul += gridDim.x) {
        int z, head, cg; unit_ids(half, ul, z, head, cg);
        prep_compute<true>(p, smem, head, pq);
        const int uln = ul + (int)gridDim.x;
        if (uln < NUH) { int z2, head2, cg2; unit_ids(half, uln, z2, head2, cg2); prep_load<true>(p, z2, head2, cg2, pq); }
        bf16_t* At = slot(smem, 0); bf16_t* AtT = slot(smem, 1); bf16_t* Rt = slot(smem, 2); bf16_t* Bt = slot(smem, 3); bf16_t* Kt = slot(smem, 4);
        bf16_t* BhT = slot(smem, 5); bf16_t* Kh = slot(smem, 6); bf16_t* VA = slot(smem, 7); bf16_t* Mak = slot(smem, 8); bf16_t* MrbT = slot(smem, 9);
        bf16_t* Tm = slot(smem, 12); bf16_t* TT = slot(smem, 13); bf16_t* G1T = slot(smem, 10); bf16_t* G2T = slot(smem, 11); bf16_t* Hm = slot(smem, 3); bf16_t* FT = slot(smem, 0); bf16_t* QT = slot(smem, 4);
        const f32x4 Z4 = {0.f, 0.f, 0.f, 0.f};
        f32x4 mrk[2] = {Z4, Z4};
        {
            const int rr = trr, c8 = tc8;
            const u32x4 raw = traw;
            if (uln < NUH) traw = *(const u32x4*)((const bf16_t*)(p.ws + WS_CK2) + (size_t)uln * 4096 + trr * 64 + tc8);
            *(u32x4*)(Tm + rr * LD + c8) = raw;
#pragma unroll
            for (int e = 0; e < 4; ++e) { TT[(c8 + 2 * e) * LD + rr] = (bf16_t)(raw[e] & 0xffffu); TT[(c8 + 2 * e + 1) * LD + rr] = (bf16_t)(raw[e] >> 16); }
        }
        { f32x4 acc[2] = {Z4, Z4}; mm_lds(Kt, At, acc, m0, n0, fr, fq); mask_tri<true>(acc, m0, n0, fr, fq); st_row(Mak, acc, m0, n0, fr, fq); }
        { f32x4 acc[2] = {Z4, Z4}; mm_lds(Bt, Rt, acc, m0, n0, fr, fq); mask_tri<false>(acc, m0, n0, fr, fq); st_tr(MrbT, acc, m0, n0, fr, fq); }
        { mm_lds(Kt, Rt, mrk, m0, n0, fr, fq); mask_tri<false>(mrk, m0, n0, fr, fq); }
        __syncthreads();
        { f32x4 acc[2] = {Z4, Z4}; mm_lds(Tm, MrbT, acc, m0, n0, fr, fq); st_tr(G1T, acc, m0, n0, fr, fq); }
        { f32x4 acc[2] = {Z4, Z4}; mm_lds(Tm, BhT, acc, m0, n0, fr, fq); st_tr(G2T, acc, m0, n0, fr, fq); }
        { f32x4 acc[2] = {Z4, Z4}; mm_lds(Mak, TT, acc, m0, n0, fr, fq); st_row(Hm, acc, m0, n0, fr, fq); }
        __syncthreads();
        bf16_t* EP = (bf16_t*)(p.ws + WS_CK1) + (size_t)ul * 8192;
        {
            f32x4 acc[2];
#pragma unroll
            for (int t = 0; t < 2; ++t) { const u32x2 rw = *(const u32x2*)(Rt + (m0 + fr) * LD + n0 + 16 * t + 4 * fq); acc[t] = (f32x4){bf2f(rw[0] & 0xffffu), bf2f(rw[0] >> 16), bf2f(rw[1] & 0xffffu), bf2f(rw[1] >> 16)}; }
            mm_lds(G1T, AtT, acc, m0, n0, fr, fq);
#pragma unroll
            for (int t = 0; t < 2; ++t) { u32x2 w = {pk2(acc[t][0], acc[t][1]), pk2(acc[t][2], acc[t][3])}; *(u32x2*)(EP + (m0 + fr) * 64 + n0 + 16 * t + 4 * fq) = w; }
        }
        {
            f32x4 acc[2];
#pragma unroll
            for (int t = 0; t < 2; ++t)
#pragma unroll
                for (int r = 0; r < 4; ++r) acc[t][r] = (m0 + fr == n0 + 16 * t + 4 * fq + r) ? WE[m0 + fr] : 0.f;
            mm_lds(G2T, AtT, acc, m0, n0, fr, fq);
#pragma unroll
            for (int t = 0; t < 2; ++t) { u32x2 w = {pk2(acc[t][0], acc[t][1]), pk2(acc[t][2], acc[t][3])}; *(u32x2*)(EP + 4096 + (m0 + fr) * 64 + n0 + 8 * fq + 4 * t) = w; }
        }
        { mm_lds(Hm, MrbT, mrk, m0, n0, fr, fq); st_tr(FT, mrk, m0, n0, fr, fq); }
        {
            f32x4 acc[2];
#pragma unroll
            for (int t = 0; t < 2; ++t) { const u32x2 rw = *(const u32x2*)(Kh + (m0 + fr) * LD + n0 + 16 * t + 4 * fq); acc[t] = (f32x4){bf2f(rw[0] & 0xffffu), bf2f(rw[0] >> 16), bf2f(rw[1] & 0xffffu), bf2f(rw[1] >> 16)}; }
            mm_lds(Hm, BhT, acc, m0, n0, fr, fq); st_tr(QT, acc, m0, n0, fr, fq);
        }
        __syncthreads();
        {
            f32x4 acc[2] = {Z4, Z4}; mm_lds(FT, VA, acc, m0, n0, fr, fq);
            const int row = scan_row(z, cg * 64 + m0 + fr);
#pragma unroll
            for (int t = 0; t < 2; ++t) { u32x2 w = {pk2(acc[t][0], acc[t][1]), pk2(acc[t][2], acc[t][3])}; *(u32x2*)(Y + ((size_t)z * R + row) * 1024 + head * 64 + n0 + 16 * t + 4 * fq) = w; }
        }
        {
            f32x4 acc[2] = {Z4, Z4}; mm_lds(VA, QT, acc, m0, n0, fr, fq);
            bf16_t* SV = (bf16_t*)(p.ws + WS_CK3) + (size_t)ul * 4096;
#pragma unroll
            for (int t = 0; t < 2; ++t) { u32x2 w = {pk2(acc[t][0], acc[t][1]), pk2(acc[t][2], acc[t][3])}; *(u32x2*)(SV + (m0 + fr) * 64 + n0 + 16 * t + 4 * fq) = w; }
        }
        __syncthreads();
    }
}
__device__ __forceinline__ void phase_c4(const Params& p, int half, char* smem) {
    const int tid = ptid(), lane = tid & 63, wv = __builtin_amdgcn_readfirstlane(tid >> 6), fr = lane & 15, fq = lane >> 4;
    const int b = (int)blockIdx.x;
    if (b >= 64) return;
    constexpr int G = 5, NG = NCH / G, NGP = (NG + 1 + 3) / 4 * 4  , PTB = 64 * 144, STEPB = PTB + 32 * 144, BUFB = G * STEPB;
    const int zh = (b & 7) + 8 * (b >> 4), rb = 32 * ((b >> 3) & 1);
    const bf16_t* PTb = (const bf16_t*)(p.ws + WS_CK1) + (size_t)zh * 8192 + 4096;
    const bf16_t* SVb = (const bf16_t*)(p.ws + WS_CK3) + (size_t)zh * 4096;
    if (wv >= 2) {
        const int L = tid - 128, L2 = L - 128;
        const bool isPT = L < 128;
        const bf16_t* gA = PTb + (L >> 3) * 64 + (L & 7) * 8;
        const bf16_t* gB = isPT ? PTb + (48 + (L >> 3)) * 64 + (L & 7) * 8 : SVb + (rb + (L2 >> 3)) * 64 + (L2 & 7) * 8;
        const int strideB = isPT ? 32 * 8192 : 32 * 4096;
        const int ldsA = (L >> 3) * 144 + (L & 7) * 16, ldsB = isPT ? (48 + (L >> 3)) * 144 + (L & 7) * 16 : PTB + (L2 >> 3) * 144 + (L2 & 7) * 16;
        u32x4 ra[4][G][2];
#define C4_LOADG(set, g) do { _Pragma("unroll") for (int s_ = 0; s_ < G; ++s_) { int c_ = (g) * G + s_; c_ = c_ < NCH - 1 ? c_ : NCH - 1; ra[set][s_][0] = *(const u32x4*)(gA + (size_t)c_ * (32 * 8192)); ra[set][s_][1] = *(const u32x4*)(gB + (size_t)c_ * strideB); } } while (0)
#define C4_WRITEG(set, buf) do { _Pragma("unroll") for (int s_ = 0; s_ < G; ++s_) { *(u32x4*)(smem + (buf) * BUFB + s_ * STEPB + ldsA) = ra[set][s_][0]; *(u32x4*)(smem + (buf) * BUFB + s_ * STEPB + ldsB) = ra[set][s_][1]; } } while (0)
        bf16_t* scg = (bf16_t*)(p.ws + WS_CK2) + (size_t)zh * 4096 + (size_t)(rb + (L2 >> 3)) * 64 + (L2 & 7) * 8;
        bf16_t* cag = (bf16_t*)(p.ws + WS_CKS) + (size_t)zh * 4096 + (size_t)(rb + (L2 >> 3)) * 64 + (L2 & 7) * 8;
#define C4_FLUSH(buf, grp) do { const int grp_ = (grp); if (!isPT && grp_ >= 0 && grp_ < NG) { _Pragma("unroll") for (int s_ = 0; s_ < G; ++s_) { const int c_ = grp_ * G + s_ + 1; \
            const u32x4 v_ = *(const u32x4*)(smem + (buf) * BUFB + s_ * STEPB + ldsB); if (c_ < NCH) *(u32x4*)(scg + (size_t)c_ * (32 * 4096)) = v_; else if (!half) *(u32x4*)cag = v_; } } } while (0)
        C4_LOADG(0, 0); C4_LOADG(1, 1); C4_LOADG(2, 2); C4_LOADG(3, 3); C4_WRITEG(0, 0); C4_LOADG(0, 4);
        __syncthreads();
#pragma unroll 1
        for (int g = 0; g < NGP; g += 4) {
            C4_FLUSH(1, g - 1); C4_WRITEG(1, 1); C4_LOADG(1, g + 5); __syncthreads();
            C4_FLUSH(0, g);     C4_WRITEG(2, 0); C4_LOADG(2, g + 6); __syncthreads();
            C4_FLUSH(1, g + 1); C4_WRITEG(3, 1); C4_LOADG(3, g + 7); __syncthreads();
            C4_FLUSH(0, g + 2); C4_WRITEG(0, 0); C4_LOADG(0, g + 8); __syncthreads();
        }
#undef C4_FLUSH
#undef C4_LOADG
#undef C4_WRITEG
    } else {
        const int i0 = rb + 16 * wv;
        bf16_t* SCb = (bf16_t*)(p.ws + WS_CK2) + (size_t)zh * 4096 + (size_t)(i0 + fr) * 64 + 4 * fq;
        bf16_t* carry = (bf16_t*)(p.ws + WS_CKS) + (size_t)zh * 4096 + (size_t)(i0 + fr) * 64 + 4 * fq;
        u32x2 sa[2][2];
#pragma unroll
        for (int ks = 0; ks < 2; ++ks)
#pragma unroll
            for (int q = 0; q < 2; ++q) { sa[ks][q] = (u32x2){0u, 0u}; if (half) sa[ks][q] = *(const u32x2*)(carry + 32 * ks + 16 * q); *(u32x2*)(SCb + 32 * ks + 16 * q) = sa[ks][q]; }
        const int aoff = fr * 144 + fq * 16, soff = PTB + (16 * wv + fr) * 144 + fq * 8;
        u32x4 fa[2][4][2]; u32x2 fs[2][4];
#define C4_FRAGS(B, sp) do { const char* sp_ = (sp); _Pragma("unroll") for (int t = 0; t < 4; ++t) { _Pragma("unroll") for (int ks = 0; ks < 2; ++ks) \
            fa[B][t][ks] = *(const u32x4*)(sp_ + t * 16 * 144 + aoff + 64 * ks); fs[B][t] = *(const u32x2*)(sp_ + soff + 32 * t); } } while (0)
#define C4_COMP(B, sp) do { f32x4 acc[4]; \
            _Pragma("unroll") for (int t = 0; t < 4; ++t) acc[t] = (f32x4){bf2f(fs[B][t][0] & 0xffffu), bf2f(fs[B][t][0] >> 16), bf2f(fs[B][t][1] & 0xffffu), bf2f(fs[B][t][1] >> 16)}; \
            _Pragma("unroll") for (int ks = 0; ks < 2; ++ks) { const u32x4 bw = {sa[ks][0][0], sa[ks][0][1], sa[ks][1][0], sa[ks][1][1]}; const bf16x8 bop = __builtin_bit_cast(bf16x8, bw); \
                _Pragma("unroll") for (int t = 0; t < 4; ++t) acc[t] = __builtin_amdgcn_mfma_f32_16x16x32_bf16(__builtin_bit_cast(bf16x8, fa[B][t][ks]), bop, acc[t], 0, 0, 0); } \
            _Pragma("unroll") for (int ks = 0; ks < 2; ++ks) _Pragma("unroll") for (int q = 0; q < 2; ++q) { \
                sa[ks][q] = (u32x2){cvt2(acc[2 * ks + q][0], acc[2 * ks + q][1]), cvt2(acc[2 * ks + q][2], acc[2 * ks + q][3])}; \
                *(u32x2*)((sp) + soff + 64 * ks + 32 * q) = sa[ks][q]; } } while (0)
#define C4_GROUP(bufp) do { char* bp_ = (bufp); C4_FRAGS(0, bp_); \
            C4_FRAGS(1, bp_ + 1 * STEPB); C4_COMP(0, bp_); C4_FRAGS(0, bp_ + 2 * STEPB); C4_COMP(1, bp_ + 1 * STEPB); C4_FRAGS(1, bp_ + 3 * STEPB); C4_COMP(0, bp_ + 2 * STEPB); \
            C4_FRAGS(0, bp_ + 4 * STEPB); C4_COMP(1, bp_ + 3 * STEPB); C4_COMP(0, bp_ + 4 * STEPB); } while (0)
        __syncthreads();
#pragma unroll 1
        for (int g = 0; g < NGP; g += 2) {
            if (g < NG) { C4_GROUP(smem); }
            __syncthreads();
            if (g < NG) { C4_GROUP(smem + BUFB); }
            __syncthreads();
        }
#undef C4_FRAGS
#undef C4_COMP
#undef C4_GROUP
    }
}
__device__ __forceinline__ void phase_c5(const Params& p, int half) {
    const int tid = ptid(), lane = tid & 63, wv = __builtin_amdgcn_readfirstlane(tid >> 6), fr = lane & 15, fq = lane >> 4, m0 = 16 * (wv >> 1), n0 = 32 * (wv & 1);
    bf16_t* Y = (bf16_t*)(p.ws + WS_Y);
    struct C5Set { bf16x8 af[2], bq[2][2]; u32x2 y[2]; bf16_t* yp; };
#define C5_LOAD(S, ul_) do { int z, head, cg; unit_ids(half, (ul_), z, head, cg); \
        const bf16_t* ET = (const bf16_t*)(p.ws + WS_CK1) + (size_t)(ul_) * 8192; const bf16_t* SC = (const bf16_t*)(p.ws + WS_CK2) + (size_t)(ul_) * 4096; \
        _Pragma("unroll") for (int ks = 0; ks < 2; ++ks) { S.af[ks] = *(const bf16x8*)(ET + (m0 + fr) * 64 + ks * 32 + fq * 8); \
            _Pragma("unroll") for (int t = 0; t < 2; ++t) S.bq[ks][t] = *(const bf16x8*)(SC + (n0 + 16 * t + fr) * 64 + ks * 32 + fq * 8); } \
        S.yp = Y + ((size_t)z * R + scan_row(z, cg * 64 + m0 + fr)) * 1024 + head * 64 + n0 + 4 * fq; \
        _Pragma("unroll") for (int t = 0; t < 2; ++t) S.y[t] = *(const u32x2*)(S.yp + 16 * t); } while (0)
#define C5_DO(S) do { f32x4 acc[2]; _Pragma("unroll") for (int t = 0; t < 2; ++t) acc[t] = (f32x4){bf2f(S.y[t][0] & 0xffffu), bf2f(S.y[t][0] >> 16), bf2f(S.y[t][1] & 0xffffu), bf2f(S.y[t][1] >> 16)}; \
        _Pragma("unroll") for (int ks = 0; ks < 2; ++ks) _Pragma("unroll") for (int t = 0; t < 2; ++t) acc[t] = __builtin_amdgcn_mfma_f32_16x16x32_bf16(S.bq[ks][t], S.af[ks], acc[t], 0, 0, 0); \
        _Pragma("unroll") for (int t = 0; t < 2; ++t) { u32x2 w_ = {pk2(acc[t][0], acc[t][1]), pk2(acc[t][2], acc[t][3])}; *(u32x2*)(S.yp + 16 * t) = w_; } } while (0)
    C5Set A, B;
    const int G = (int)gridDim.x;
    if ((int)blockIdx.x < NUH) C5_LOAD(A, (int)blockIdx.x);
    for (int ul = blockIdx.x; ul < NUH; ul += 2 * G) {
        const bool hb = ul + G < NUH;
        if (hb) C5_LOAD(B, ul + G);
        C5_DO(A);
        if (hb) { if (ul + 2 * G < NUH) C5_LOAD(A, ul + 2 * G); C5_DO(B); }
    }
#undef C5_LOAD
#undef C5_DO
}
}

__device__ __forceinline__ void phase_bsum(const Params& p, int b0) {
    const int lane = ptid() & 63, wv = ptid() >> 6;
    const int gi = (int)blockIdx.x - b0, gn = (int)gridDim.x - b0;
    if (gi < 0) return;
    const bf16_t* RRb = (const bf16_t*)(p.ws + WS_RR); const bf16_t* KKb = (const bf16_t*)(p.ws + WS_KK); const bf16_t* AP = (const bf16_t*)(p.ws + WS_AP);
    float* BS = (float*)(p.ws + WS_BS);
    const float* k_a = p.in[29]; const float* r_k = p.in[30];
    for (int row = gi * 8 + wv; row < R; row += gn * 8) {
        const int c0 = lane * 16;
        float r[16], k[16], a0[16], a1[16];
#define LD16(dst, ptr) do { _Pragma("unroll") for (int q = 0; q < 2; ++q) { const u32x4 raw = *(const u32x4*)((ptr) + q * 8); _Pragma("unroll") for (int e = 0; e < 4; ++e) { dst[q * 8 + 2 * e] = bf2f(raw[e] & 0xffffu); dst[q * 8 + 2 * e + 1] = bf2f(raw[e] >> 16); } } } while (0)
        LD16(r, RRb + (size_t)row * 1024 + c0); LD16(k, KKb + (size_t)row * 1024 + c0);
        LD16(a0, AP + (size_t)row * 1024 + c0); LD16(a1, AP + ((size_t)R + row) * 1024 + c0);
#undef LD16
        float bsum = 0.f;
#pragma unroll
        for (int e = 0; e < 16; ++e) {
            const float ka = k_a[c0 + e], kd0 = k[e] * (1.f + (a0[e] - 1.f) * ka), kd1 = k[e] * (1.f + (a1[e] - 1.f) * ka);
            bsum += r[e] * (kd0 + kd1) * r_k[c0 + e];
        }
        bsum += __shfl_xor(bsum, 1); bsum += __shfl_xor(bsum, 2);
        if ((lane & 3) == 0) BS[(size_t)row * 16 + (lane >> 2)] = bsum;
    }
}

__device__ __forceinline__ void phase_rout(const Params& p) {
    const int lane = ptid() & 63, wv = ptid() >> 6;
    const bf16_t* Y = (const bf16_t*)(p.ws + WS_Y);
    const bf16_t* VVb = (const bf16_t*)(p.ws + WS_VV); const bf16_t* G = (const bf16_t*)(p.ws + WS_G);
    bf16_t* A2 = (bf16_t*)(p.ws + WS_A2R);
    const float* lw = p.in[31]; const float* lb = p.in[32];
    for (int row = blockIdx.x * 8 + wv; row < R; row += gridDim.x * 8) {
        const int c0 = lane * 16;
        float y[16], v[16], g[16];
#pragma unroll
        for (int q = 0; q < 2; ++q) { const u32x4 ya = *(const u32x4*)(Y + (size_t)row * 1024 + c0 + q * 8), yb = *(const u32x4*)(Y + ((size_t)R + row) * 1024 + c0 + q * 8);
#pragma unroll
            for (int e = 0; e < 4; ++e) { y[q * 8 + 2 * e] = bf2f(ya[e] & 0xffffu) + bf2f(yb[e] & 0xffffu); y[q * 8 + 2 * e + 1] = bf2f(ya[e] >> 16) + bf2f(yb[e] >> 16); } }
#define LD16(dst, ptr) do { _Pragma("unroll") for (int q = 0; q < 2; ++q) { const u32x4 raw = *(const u32x4*)((ptr) + q * 8); _Pragma("unroll") for (int e = 0; e < 4; ++e) { dst[q * 8 + 2 * e] = bf2f(raw[e] & 0xffffu); dst[q * 8 + 2 * e + 1] = bf2f(raw[e] >> 16); } } } while (0)
        LD16(v, VVb + (size_t)row * 1024 + c0); LD16(g, G + (size_t)row * 1024 + c0);
#undef LD16
        const float bsum = ((const float*)(p.ws + WS_BS))[(size_t)row * 16 + (lane >> 2)];
        float s = 0.f;
#pragma unroll
        for (int e = 0; e < 16; ++e) s += y[e];
        s += __shfl_xor(s, 1); s += __shfl_xor(s, 2);
        const float mean = s * (1.f / 64.f);
        float q2 = 0.f;
#pragma unroll
        for (int e = 0; e < 16; ++e) { y[e] -= mean; q2 += y[e] * y[e]; }
        q2 += __shfl_xor(q2, 1); q2 += __shfl_xor(q2, 2);
        const float rs = rsqrtf(q2 * (1.f / 64.f) + 64e-5f);
        unsigned w[8];
#pragma unroll
        for (int e = 0; e < 8; ++e) {
            const float o0 = (y[2 * e] * rs * lw[c0 + 2 * e] + lb[c0 + 2 * e] + bsum * v[2 * e]) * g[2 * e];
            const float o1 = (y[2 * e + 1] * rs * lw[c0 + 2 * e + 1] + lb[c0 + 2 * e + 1] + bsum * v[2 * e + 1]) * g[2 * e + 1];
            w[e] = pk2(o0, o1);
        }
        *(u32x4*)(A2 + (size_t)row * 1024 + c0) = (u32x4){w[0], w[1], w[2], w[3]};
        *(u32x4*)(A2 + (size_t)row * 1024 + c0 + 8) = (u32x4){w[4], w[5], w[6], w[7]};
    }
}


__device__ __forceinline__ void conv_layer(const Params& p, int layer, float* lds, int rot0 = 0, int gi = -1, int gn = 0) {
    int rot = rot0;
    if (layer == 3) {
    } else if (layer == 0) {
        const int j = 0;
        conv_w(BQKV{p.in[8] + (size_t)j * 1024 * 3072}, WSB(WS_WIN), 3072, 1024, lds, rot, gi, gn);
        conv_w(BPlain{p.in[11] + (size_t)j * 1024 * 1024, 1024}, WSB(WS_WOUT), 1024, 1024, lds, rot, gi, gn);
    } else if (layer == 1) {
        conv_w(BPlain{p.in[12], 2048}, WSB(WS_WIN), 2048, 1024, lds, rot, gi, gn);
        for (int i = blockIdx.x * NTHR + ptid(); i < 8 * 128 * 128 / 2; i += gridDim.x * NTHR) ((unsigned*)(p.ws + WS_WSPAT))[i] = pk2(p.in[15][2 * i], p.in[15][2 * i + 1]);
        conv_w(BPlain{p.in[17], 1024}, WSB(WS_WOUT), 1024, 1024, lds, rot, gi, gn);
    } else {
#pragma unroll
        for (int q = 0; q < 3; ++q) conv_w(BPlain{p.in[19] + (size_t)q * 1024 * 1024, 1024}, WSB(WS_WIN) + (size_t)q * 1024 * 1024, 1024, 1024, lds, rot, gi, gn);
        conv_w(BPlain{p.in[33], 1024}, WSB(WS_WOUT2), 1024, 1024, lds, rot, gi, gn);
        conv_w(BLora1{p.in[21]}, WSB(WS_WIN) + (size_t)3 * 1024 * 1024, 256, 1024, lds, rot, gi, gn);
        conv_w(BLora1{p.in[24]}, WSB(WS_WIN) + (size_t)3 * 1024 * 1024 + 256 * 1024, 256, 1024, lds, rot, gi, gn);
        conv_w(BG1{p.in[26]}, WSB(WS_WIN) + (size_t)3 * 1024 * 1024 + 2 * 256 * 1024, 256, 1024, lds, rot, gi, gn);
        conv_w(BLora2{p.in[22]}, WSB(WS_WL), 2048, 128, lds, rot, gi, gn);
        conv_w(BLora2{p.in[25]}, WSB(WS_WL) + 256 * 1024, 2048, 128, lds, rot, gi, gn);
        conv_w(BG2{p.in[27]}, WSB(WS_WL) + 2 * 256 * 1024, 1024, 256, lds, rot, gi, gn);
    }
    if (layer == 0 || layer == 2) {
        const int j = layer >> 1;
        conv_w(BGateUp{p.in[34] + (size_t)j * 1024 * FF, p.in[35] + (size_t)j * 1024 * FF, FF}, WSB(WS_WF1), 2 * FF, 1024, lds, rot, gi, gn);
        conv_w(BPlain{p.in[36] + (size_t)j * FF * 1024, 1024}, WSB(WS_WF2D), 1024, FF, lds, rot, gi, gn);
    } else {
        const int j = layer >> 1;
#pragma unroll 1
        for (int e = 0; e < 8; ++e) {
            const size_t wo = ((size_t)j * 8 + e) * 1024 * FF;
            conv_w(BGateUp{p.in[38] + wo, p.in[39] + wo, FF}, WSB(WS_WF1) + (size_t)e * 2 * FF * 1024, 2 * FF, 1024, lds, rot, gi, gn);
            if (e >= 4) conv_w(BPlain{p.in[40] + wo, 1024}, WSB(WS_WF2M) + (size_t)e * 1024 * FF, 1024, FF, lds, rot, gi, gn);
        }
    }
}

__device__ __forceinline__ void conv_tail(const Params& p, float* lds, int j) {
    const int b0 = 1430 % (int)gridDim.x, gi = (int)blockIdx.x - b0, gn = (int)gridDim.x - b0;
    if (gi < 0) return;
    int rot = 0;
#pragma unroll 1
    for (int e = 0; e < 2; ++e) { const size_t wo = ((size_t)j * 8 + e) * 1024 * FF; conv_w(BPlain{p.in[40] + wo, 1024}, WSB(WS_WF2M) + (size_t)e * 1024 * FF, 1024, FF, lds, rot, gi, gn); }
}
__device__ __forceinline__ void conv_moe_tail(const Params& p, float* lds, const char* smem, int j) {
    const int units = (__builtin_amdgcn_readfirstlane(((const int*)(smem + 132 * 1024))[8]) >> 8) * 22;
    const int G = (int)gridDim.x; int b0 = units % G; if (G - b0 < G / 2) b0 = 0;
    const int gi = (int)blockIdx.x - b0, gn = G - b0;
    if (gi < 0) return;
    int rot = 0;
#pragma unroll 1
    for (int e = 2; e < 4; ++e) { const size_t wo = ((size_t)j * 8 + e) * 1024 * FF; conv_w(BPlain{p.in[40] + wo, 1024}, WSB(WS_WF2M) + (size_t)e * 1024 * FF, 1024, FF, lds, rot, gi, gn); }
}
__device__ __forceinline__ void conv_attn3(const Params& p, float* lds, int b0) {
    const int gi = (int)blockIdx.x - b0, gn = (int)gridDim.x - b0;
    if (gi < 0) return;
    int rot = 0;
    conv_w(BQKV{p.in[8] + (size_t)1024 * 3072}, WSB(WS_WIN), 3072, 1024, lds, rot, gi, gn);
    conv_w(BPlain{p.in[11] + (size_t)1024 * 1024, 1024}, WSB(WS_WOUT), 1024, 1024, lds, rot, gi, gn);
}
__device__ __forceinline__ void conv_l2_tail(const Params& p, float* lds, const char* smem) {
    const int units = (__builtin_amdgcn_readfirstlane(((const int*)(smem + 132 * 1024))[8]) >> 8) * 4;
    const int G = (int)gridDim.x; int b0 = units % G; if (G - b0 < G / 2) b0 = 0;
    const int gi = (int)blockIdx.x - b0;
    if (gi < 0) return;
    conv_layer(p, 2, lds, 0, gi, G - b0);
}

#define XB_TMO      128
#define XB_XCNT(j)  (256  + 64 * (j))
#define XB_XSUB(j)  (1280 + 64 * (j))
#define XB_XGEN(j)  (2304 + 64 * (j))
#define XB_TOP      3328
#define XB_TOPGEN   3392
#define XCD_BAR_WORDS 3456
#define XB_SPIN_CAP (1u << 22)
#define LAS __attribute__((address_space(3)))

__device__ __forceinline__ unsigned xb_ld(unsigned* p)              { return __hip_atomic_load(p, __ATOMIC_RELAXED, __HIP_MEMORY_SCOPE_AGENT); }
__device__ __forceinline__ unsigned xb_add(unsigned* p, unsigned v) { return __hip_atomic_fetch_add(p, v, __ATOMIC_RELAXED, __HIP_MEMORY_SCOPE_AGENT); }
__device__ __forceinline__ unsigned xb_xcc_id() { return (unsigned)__builtin_amdgcn_s_getreg((3 << 11) | 20) & 0xFu; }
#define XB_SPIN(cond, bar) do { unsigned _sp = 0; while (cond) { __builtin_amdgcn_s_sleep(1); \
    if ((++_sp & 255u) == 0u) { if (xb_ld(&(bar)[XB_TMO])) break; if (_sp > XB_SPIN_CAP) { atomicAdd(&(bar)[XB_TMO], 1u); break; } } } } while (0)

struct XcdBarrier {
    unsigned* bar; unsigned x;
    volatile LAS unsigned* st;
};

__device__ __forceinline__ XcdBarrier xcd_barrier_post(unsigned* bar, volatile LAS unsigned* st) {
    XcdBarrier b; b.bar = bar; b.x = xb_xcc_id(); b.st = st;
    if (ptid() == 0) (void)xb_add(&bar[XB_XCNT(b.x)], 1u);
    return b;
}
__device__ __forceinline__ void xcd_barrier_complete(unsigned* bar, unsigned x, unsigned& nloc, unsigned& nx) {
    const unsigned G = gridDim.x * gridDim.y * gridDim.z;
    unsigned sum, cnt, mine, sp = 0u;
    for (;;) {
        sum = 0u; cnt = 0u; mine = 0u;
#pragma unroll
        for (unsigned j = 0; j < 16; ++j) { const unsigned c = xb_ld(&bar[XB_XCNT(j)]); sum += c; cnt += (c > 0u) ? 1u : 0u; mine = (j == x) ? c : mine; }
        if (sum == G) break;
        __builtin_amdgcn_s_sleep(1);
        if ((++sp & 255u) == 0u) { if (xb_ld(&bar[XB_TMO])) break; if (sp > XB_SPIN_CAP) { atomicAdd(&bar[XB_TMO], 1u); break; } }
    }
    nloc = mine > 0u ? mine : 1u; nx = cnt > 0u ? cnt : 1u;
}

__device__ __forceinline__ void xcd_barrier(const XcdBarrier& b) {
    asm volatile("s_waitcnt vmcnt(0)" ::: "memory");
    __syncthreads();
    if (ptid() == 0) {
        unsigned* bar = b.bar;
        __builtin_amdgcn_s_waitcnt(0);
        unsigned nloc = b.st[0], nx = b.st[1];
        if (nloc == 0u) { xcd_barrier_complete(bar, b.x, nloc, nx); b.st[0] = nloc; b.st[1] = nx; }
        const unsigned old = xb_add(&bar[XB_XSUB(b.x)], 1u);
        const unsigned gen = old / nloc;
        if (old + 1u == (gen + 1u) * nloc) {
            __builtin_amdgcn_fence(__ATOMIC_RELEASE, "agent");
            asm volatile("s_waitcnt vmcnt(0)" ::: "memory");
            const unsigned og = xb_add(&bar[XB_TOP], 1u);
            const unsigned tg = og / nx;
            if (og + 1u == (tg + 1u) * nx) xb_add(&bar[XB_TOPGEN], 1u);
            else XB_SPIN(xb_ld(&bar[XB_TOPGEN]) == tg, bar);
            __builtin_amdgcn_fence(__ATOMIC_ACQUIRE, "agent");
            xb_add(&bar[XB_XGEN(b.x)], 1u);
            asm volatile("s_waitcnt vmcnt(0)" ::: "memory");
        } else {
            XB_SPIN(xb_ld(&bar[XB_XGEN(b.x)]) == gen, bar);
            __builtin_amdgcn_fence(__ATOMIC_ACQUIRE, "agent");
            asm volatile("s_waitcnt vmcnt(0)" ::: "memory");
        }
    }
    __syncthreads();
}


#define AS4 __attribute__((address_space(4)))
__device__ __forceinline__ Params fresh_params() {
    Params q;
#if defined(__HIP_DEVICE_COMPILE__)
    const AS4 unsigned long long* ka = (const AS4 unsigned long long*)__builtin_amdgcn_kernarg_segment_ptr();
    asm volatile("" : "+s"(ka));
#pragma unroll
    for (int i = 0; i < 41; ++i) q.in[i] = (const float*)(const __attribute__((address_space(1))) float*)ka[i];
    q.out = (float*)(__attribute__((address_space(1))) float*)ka[41]; q.ws = (unsigned char*)(__attribute__((address_space(1))) unsigned char*)ka[42];
#endif
    return q;
}
__global__ void __launch_bounds__(NTHR, 2) mega(Params p_unused) {
    extern __shared__ __attribute__((aligned(16))) char smem[];
    float* lds = (float*)smem;
#define PH(...) do { const Params p = fresh_params(); bf16_t* XL = (bf16_t*)(p.ws + WS_XL); const bf16_t* H = (const bf16_t*)(p.ws + WS_H); const float* MOD = (const float*)(p.ws + WS_MOD); (void)XL; (void)H; (void)MOD; __VA_ARGS__; } while (0)
    volatile LAS unsigned* st = (volatile LAS unsigned*)(smem + 143 * 1024);
    if (ptid() == 0) { st[0] = 0u; st[1] = 0u; st[2] = 0u; st[3] = 0u; }
    __syncthreads();
    PH((void)xcd_barrier_post((unsigned*)(p.ws + WS_CTL), st));
#define GB() do { XcdBarrier b_; b_.bar = (unsigned*)(fresh_params().ws + WS_CTL); b_.x = xb_xcc_id(); b_.st = st; xcd_barrier(b_); } while (0)
    const float QS = 0.125f * 1.4426950408889634f;
    PH(phase_mod(p, lds)); PH(conv_layer(p, 0, lds, 128)); GB();
    PH(phase_norm(p, 0, 0, 1, -1, 0, 0, -1, smem)); GB();
    PH(gemm_ctx(smem, H, 1024, WSB(WS_WIN), 3072, EpiQKV4{WSB(WS_QKV), QS})); PH(gemm_fast(smem, H, RC, R - RC, 1024, WSB(WS_WIN), 3072, EpiQKV{WSB(WS_QKV), (const float*)(p.ws + WS_TAB), QS})); GB();
    PH(phase_attn_fused(p, 0, 0.2f, 1, smem)); GB();
    PH(gemm_ctx(smem, WSB(WS_A2), 1024, WSB(WS_WOUT), 1024, EpiResid4{XL, MOD + 0 * 2 * 6144, 2, p.in[2]})); PH(gemm_fast(smem, WSB(WS_A2), RC, R - RC, 1024, WSB(WS_WOUT), 1024, EpiResid{XL, MOD + 0 * 2 * 6144, 2, nullptr, 0, p.in[0], p.in[2]})); GB();
    PH(phase_norm(p, 0, 1, 0, -1, 0, 0, -1, smem)); GB();
    PH(gemm_fast(smem, H, 0, R, 1024, WSB(WS_WF1), 2 * FF, EpiGateUp{WSB(WS_ACT), FF})); PH(conv_tail(p, lds, 0)); GB();
    PH(gemm_ctx(smem, WSB(WS_ACT), FF, WSB(WS_WF2D), 1024, EpiResid4{XL, MOD + 0 * 2 * 6144, 5})); PH(gemm_fast(smem, WSB(WS_ACT), RC, R - RC, FF, WSB(WS_WF2D), 1024, EpiResid{XL, MOD + 0 * 2 * 6144, 5, nullptr, 0})); GB();
    PH(conv_layer(p, 1, lds)); PH(phase_norm(p, 1, 0, 0, -1, 0, 0, -1, smem)); GB();
    PH(gemm_ctx(smem, H, 1024, WSB(WS_WIN), 2048, EpiGelu4{WSB(WS_U), WSB(WS_VP)})); PH(gemm_fast(smem, H, RC, R - RC, 1024, WSB(WS_WIN), 2048, EpiGelu{WSB(WS_U), WSB(WS_VP)})); GB();
    PH(phase_lnv(p)); GB();
    PH(phase_spat(p, smem)); GB();
    PH(gemm_ctx(smem, WSB(WS_A2), 1024, WSB(WS_WOUT), 1024, EpiResid4{XL, MOD + 1 * 2 * 6144, 2})); PH(gemm_fast(smem, WSB(WS_A2), RC, R - RC, 1024, WSB(WS_WOUT), 1024, EpiResid{XL, MOD + 1 * 2 * 6144, 2, nullptr, 0})); GB();
    PH(phase_norm(p, 1, 1, 0, 0, 0, 0, -1, smem)); GB();
    PH(phase_perm(p, 0, 0, smem)); GB();
    PH(gemm_moe(smem, p, 0, WSB(WS_HP), 1024, WSB(WS_WF1), 22, EpiGateUpM{WSB(WS_ACTM)})); PH(conv_moe_tail(p, lds, smem, 0)); GB();
    PH(gemm_moe(smem, p, 0, WSB(WS_ACTM), FF, WSB(WS_WF2M), 4, EpiStoreM{WSB(WS_YM)})); PH(conv_l2_tail(p, lds, smem)); GB();
    PH(phase_norm(p, 2, 0, 0, -1, 0, 0, 1, smem)); GB();
    PH(phase_mix(p)); GB();
    PH(gemm_rwkv1(smem, p)); GB();
    PH(gemm_fast(smem, WSB(WS_L1W), 0, R, 128, WSB(WS_WL), 2048, EpiDecay{(_Float16*)(p.ws + WS_DEC), p.in[20]}));
    PH(gemm_fast(smem, WSB(WS_L1A), 0, R, 128, WSB(WS_WL) + 256 * 1024, 2048, EpiAP{WSB(WS_AP), p.in[23]}, 248));
    PH(gemm_fast(smem, WSB(WS_L1G), 0, R, 256, WSB(WS_WL) + 2 * 256 * 1024, 1024, EpiStore{WSB(WS_G), 1024, 0}, 240));
    PH(phase_kkn(p)); GB();
#pragma unroll 1
    for (int half = 0; half < 1; ++half) {
        PH(ck::phase_c1(p, half, smem)); __syncthreads();
        PH(ck::phase_c2(p, smem)); __syncthreads();
        PH(ck::phase_c3(p, half, smem)); GB();
        PH(ck::phase_c4(p, half, smem)); PH(phase_bsum(p, gridDim.x > 64 ? 64 : 0)); PH(conv_attn3(p, lds, gridDim.x > 64 ? 64 : 0)); GB();
        PH(ck::phase_c5(p, half)); GB();
    }
    PH(phase_rout(p)); GB();
    PH(gemm_ctx(smem, WSB(WS_A2R), 1024, WSB(WS_WOUT2), 1024, EpiResid4{XL, MOD + 2 * 2 * 6144, 2})); PH(gemm_fast(smem, WSB(WS_A2R), RC, R - RC, 1024, WSB(WS_WOUT2), 1024, EpiResid{XL, MOD + 2 * 2 * 6144, 2, nullptr, 0})); GB();
    PH(phase_norm(p, 2, 1, 0, -1, 0, 0, -1, smem)); GB();
    PH(gemm_fast(smem, H, 0, R, 1024, WSB(WS_WF1), 2 * FF, EpiGateUp{WSB(WS_ACT), FF})); PH(conv_tail(p, lds, 1)); GB();
    PH(gemm_ctx(smem, WSB(WS_ACT), FF, WSB(WS_WF2D), 1024, EpiResid4{XL, MOD + 2 * 2 * 6144, 5})); PH(gemm_fast(smem, WSB(WS_ACT), RC, R - RC, FF, WSB(WS_WF2D), 1024, EpiResid{XL, MOD + 2 * 2 * 6144, 5, nullptr, 0})); GB();
    PH(conv_layer(p, 3, lds)); PH(phase_norm(p, 3, 0, 0, -1, 0, 0, -1, smem)); GB();
    PH(gemm_ctx(smem, H, 1024, WSB(WS_WIN), 3072, EpiQKV4{WSB(WS_QKV), QS})); PH(gemm_fast(smem, H, RC, R - RC, 1024, WSB(WS_WIN), 3072, EpiQKV{WSB(WS_QKV), (const float*)(p.ws + WS_TAB), QS})); GB();
    PH(phase_attn_fused(p, 1, 0.8f - 0.6f * 0.40656965974059911f, 0, smem)); GB();
    PH(gemm_fast(smem, WSB(WS_A2), RC, R - RC, 1024, WSB(WS_WOUT), 1024, EpiResid{XL, MOD + 3 * 2 * 6144, 2, nullptr, 0})); GB();
    PH(phase_norm(p, 3, 1, 0, 1, RC, 0, -1, smem)); GB();
    PH(phase_perm(p, 1, RC, smem)); GB();
    PH(gemm_moe(smem, p, 1, WSB(WS_HP), 1024, WSB(WS_WF1), 22, EpiGateUpM{WSB(WS_ACTM)})); PH(conv_moe_tail(p, lds, smem, 1)); GB();
    PH(gemm_moe(smem, p, 1, WSB(WS_ACTM), FF, WSB(WS_WF2M), 4, EpiStoreM{WSB(WS_YM)})); GB();
    PH(phase_norm(p, 0, 0, 0, -1, RC, 1, 3, smem));
#undef GB
#undef PH
}

constexpr int LDS_BYTES = 144 * 1024;
}

extern "C" void kernel_launch(void* const* d_in, const int* in_sizes, int n_in, void* d_out, int out_size, void* d_ws, size_t ws_size, hipStream_t stream) {
    Params p; memset(&p, 0, sizeof(p));
    for (int i = 0; i < 41; ++i) p.in[i] = (const float*)d_in[i];
    p.out = (float*)d_out; p.ws = (unsigned char*)d_ws;
    hipStream_t s = stream;
    (void)hipMemsetAsync(d_ws, 0, 1 * MiB, s);
    static int grid = 0;
    if (!grid) {
        int dev = 0, cus = 0;
        (void)hipGetDevice(&dev); (void)hipDeviceGetAttribute(&cus, hipDeviceAttributeMultiprocessorCount, dev);
        (void)hipFuncSetAttribute((const void*)mega, hipFuncAttributeMaxDynamicSharedMemorySize, LDS_BYTES);
        grid = cus > 0 ? cus : 256;
    }
    hipLaunchKernelGGL(mega, dim3(grid), dim3(NTHR), LDS_BYTES, s, p);
}
```

```cpp
#include <hip/hip_runtime.h>
#include <stdint.h>
#include <math.h>
#include <string.h>

namespace {
constexpr int D = 1024, RC = 256, RL = 16384, R = RC + RL, FF = 2816, NTHR = 512;
typedef unsigned short bf16_t;
typedef float f32x4 __attribute__((ext_vector_type(4)));
typedef unsigned u32x4 __attribute__((ext_vector_type(4)));
typedef unsigned u32x2 __attribute__((ext_vector_type(2)));

struct Params { const float* in[41]; float* out; unsigned char* ws; };

constexpr size_t MiB = 1u << 20;
constexpr size_t WS_MOD = 1 * MiB;
constexpr size_t WS_TAB = 2 * MiB;
constexpr size_t WS_ROUTE = 3 * MiB;
constexpr size_t WS_KN = 4 * MiB;
constexpr size_t WS_CTL = 0;
constexpr int CW_MOE = 8192;
constexpr size_t WS_RTG = WS_ROUTE + 512 * 1024;
constexpr size_t WS_SLOT = WS_ROUTE + 768 * 1024;
constexpr size_t WS_BS = 6 * MiB;
constexpr size_t WS_XL = 8 * MiB;
constexpr size_t WS_H = 73 * MiB;
constexpr size_t WS_S = 106 * MiB;
constexpr size_t WS_QKV = WS_S;
constexpr size_t WS_O = WS_S + 98 * MiB;
constexpr size_t WS_A2 = WS_S + 228 * MiB;
constexpr size_t WS_VT = WS_S + 300 * MiB;
constexpr size_t WS_O0 = WS_S + 340 * MiB;
constexpr size_t WS_ACT = WS_S;
constexpr size_t WS_U = WS_S;
constexpr size_t WS_VP = WS_S + 33 * MiB;
constexpr size_t WS_VN = WS_S + 98 * MiB;
constexpr size_t WS_MIX = WS_S;
constexpr size_t WS_DEC = WS_S;
constexpr size_t WS_AP = WS_S + 130 * MiB;
constexpr size_t WS_RR = WS_S + 196 * MiB;
constexpr size_t WS_KK = WS_S + 229 * MiB;
constexpr size_t WS_VV = WS_S + 262 * MiB;
constexpr size_t WS_L1W = WS_S + 295 * MiB;
constexpr size_t WS_L1A = WS_S + 300 * MiB;
constexpr size_t WS_L1G = WS_S + 305 * MiB;
constexpr size_t WS_G = WS_S + 314 * MiB;
constexpr size_t WS_Y = WS_S + 347 * MiB;
constexpr size_t WS_A2R = WS_S + 478 * MiB;
constexpr size_t WS_HP = WS_S;
constexpr size_t WS_ACTM = WS_S + 69 * MiB;
constexpr size_t WS_YM = WS_S + 259 * MiB;
constexpr size_t WS_END = WS_S + 512 * MiB;
constexpr size_t WS_W = 620 * MiB;
constexpr size_t WS_WIN = WS_W;
constexpr size_t WS_WOUT = WS_W + 6 * MiB;
constexpr size_t WS_WF1 = WS_W + 8 * MiB;
constexpr size_t WS_WF2D = WS_W + 19 * MiB;
constexpr size_t WS_WF2M = WS_W + 96 * MiB;
constexpr size_t WS_WOUT2 = WS_W + 25 * MiB;
constexpr size_t WS_WL = WS_W + 27 * MiB;
constexpr size_t WS_WSPAT = WS_W + 4 * MiB;
constexpr size_t WS_WEND = WS_W + 140 * MiB;


__device__ __forceinline__ int ptid() { int t = (int)__builtin_amdgcn_workitem_id_x(); asm volatile("" : "+v"(t)); return t; }
#define WSB(off) ((bf16_t*)(p.ws + (off)))
template <int CTRL> __device__ __forceinline__ float dppmov(float v) { return __builtin_bit_cast(float, __builtin_amdgcn_update_dpp(0, __builtin_bit_cast(int, v), CTRL, 0xf, 0xf, true)); }
__device__ __forceinline__ float bf2f(unsigned b) { return __uint_as_float(b << 16); }
typedef __bf16 bf16x2_t __attribute__((ext_vector_type(2))); typedef float f32x2_t __attribute__((ext_vector_type(2)));
__device__ __forceinline__ unsigned pk2(float lo, float hi) { const f32x2_t v = {lo, hi}; const bf16x2_t b = __builtin_convertvector(v, bf16x2_t); return __builtin_bit_cast(unsigned, b); }
__device__ __forceinline__ unsigned f2bf(float f) { return pk2(f, 0.f) & 0xffffu; }
#define DPPF " row_mask:0xf bank_mask:0xf bound_ctrl:1\n\t"
__device__ __forceinline__ float wave_total1(float x) {
    float t; int r;
    asm volatile("s_nop 1\n\t"
        "v_add_f32_dpp %0, %2, %2 row_shr:1" DPPF
        "v_add_f32_dpp %0, %2, %0 row_shr:2" DPPF
        "v_add_f32_dpp %0, %2, %0 row_shr:3" DPPF
        "s_nop 1\n\t"
        "v_add_f32_dpp %0, %0, %0 row_shr:4 row_mask:0xf bank_mask:0xe\n\t"
        "s_nop 1\n\t"
        "v_add_f32_dpp %0, %0, %0 row_shr:8 row_mask:0xf bank_mask:0xc\n\t"
        "s_nop 1\n\t"
        "v_add_f32_dpp %0, %0, %0 row_bcast:15 row_mask:0xa bank_mask:0xf\n\t"
        "s_nop 1\n\t"
        "v_add_f32_dpp %0, %0, %0 row_bcast:31 row_mask:0xc bank_mask:0xf\n\t"
        "s_nop 1\n\t"
        "v_readlane_b32 %1, %0, 63\n\t"
        "s_nop 1"
        : "=&v"(t), "=s"(r) : "v"(x));
    return __builtin_bit_cast(float, r);
}
__device__ __forceinline__ void wave_total2(float x1, float x2, float& o1, float& o2) {
    float t1, t2; int r1, r2;
    asm volatile("s_nop 1\n\t"
        "v_add_f32_dpp %0, %4, %4 row_shr:1" DPPF
        "v_add_f32_dpp %1, %5, %5 row_shr:1" DPPF
        "v_add_f32_dpp %0, %4, %0 row_shr:2" DPPF
        "v_add_f32_dpp %1, %5, %1 row_shr:2" DPPF
        "v_add_f32_dpp %0, %4, %0 row_shr:3" DPPF
        "v_add_f32_dpp %1, %5, %1 row_shr:3" DPPF
        "s_nop 0\n\t"
        "v_add_f32_dpp %0, %0, %0 row_shr:4 row_mask:0xf bank_mask:0xe\n\t"
        "v_add_f32_dpp %1, %1, %1 row_shr:4 row_mask:0xf bank_mask:0xe\n\t"
        "s_nop 0\n\t"
        "v_add_f32_dpp %0, %0, %0 row_shr:8 row_mask:0xf bank_mask:0xc\n\t"
        "v_add_f32_dpp %1, %1, %1 row_shr:8 row_mask:0xf bank_mask:0xc\n\t"
        "s_nop 0\n\t"
        "v_add_f32_dpp %0, %0, %0 row_bcast:15 row_mask:0xa bank_mask:0xf\n\t"
        "v_add_f32_dpp %1, %1, %1 row_bcast:15 row_mask:0xa bank_mask:0xf\n\t"
        "s_nop 0\n\t"
        "v_add_f32_dpp %0, %0, %0 row_bcast:31 row_mask:0xc bank_mask:0xf\n\t"
        "v_add_f32_dpp %1, %1, %1 row_bcast:31 row_mask:0xc bank_mask:0xf\n\t"
        "s_nop 0\n\t"
        "v_readlane_b32 %2, %0, 63\n\t"
        "v_readlane_b32 %3, %1, 63\n\t"
        "s_nop 1"
        : "=&v"(t1), "=&v"(t2), "=s"(r1), "=s"(r2) : "v"(x1), "v"(x2));
    o1 = __builtin_bit_cast(float, r1); o2 = __builtin_bit_cast(float, r2);
}
__device__ __forceinline__ float wave_sum(float v) { return wave_total1(v); }
__device__ __forceinline__ float sigmoidf_(float x) { return __builtin_amdgcn_rcpf(1.f + __builtin_amdgcn_exp2f(x * -1.4426950408889634f)); }
__device__ __forceinline__ float tanhf_(float x) { const float e = __builtin_amdgcn_exp2f(fminf(x, 20.f) * 2.8853900817779268f); return 1.f - 2.f * __builtin_amdgcn_rcpf(1.f + e); }
__device__ __forceinline__ float siluf_(float x) { return x * __builtin_amdgcn_rcpf(1.f + __builtin_amdgcn_exp2f(x * -1.4426950408889634f)); }
__device__ __forceinline__ float geluf_(float v) {
    const float t = __builtin_amdgcn_rcpf(fabsf(v) * 0.2316418882f + 1.0f);
    float q = t * 0.5307027145f + (-0.7265760135f); q = q * t + 0.7107068705f; q = q * t + (-0.142248368f); q = q * t + 0.127414796f; q = q * t;
    const float e = __builtin_amdgcn_exp2f(v * v * (-0.72134752044f));
    const float m = v * (q * e);
    return v < 0.f ? m : v - m;
}

struct BPlain { const float* W; int ldb; __device__ __forceinline__ float operator()(int k, int n) const { return W[(size_t)k * ldb + n]; } };
struct BGateUp { const float* W1; const float* W3; int ldb; __device__ __forceinline__ float operator()(int k, int n) const { const uintptr_t a = (uintptr_t)W1, d = (uintptr_t)W3 - (uintptr_t)W1; return ((const __attribute__((address_space(1))) float*)(a + (uintptr_t)(n & 1) * d))[(size_t)k * ldb + (n >> 1)]; } };
__device__ __forceinline__ int qk_orig_col(int n) { if (n >= 2048) return n; const int p = n & 63; return (n & ~63) + ((p >> 5) << 5) + ((p & 1) << 4) + ((p & 31) >> 1); }
struct BQKV { const float* W; __device__ __forceinline__ float operator()(int k, int n) const { return W[(size_t)k * 3072 + qk_orig_col(n)]; } };
struct BLora1 { const float* W;   __device__ __forceinline__ float operator()(int k, int n) const { return n < 128 ? W[(size_t)(n >> 6) * 65536 + (size_t)k * 64 + (n & 63)] : 0.f; } };
struct BLora2 { const float* W;   __device__ __forceinline__ float operator()(int k, int n) const { const int z = n >> 10; return ((k >> 6) == z) ? W[(size_t)z * 65536 + (size_t)(k & 63) * 1024 + (n & 1023)] : 0.f; } };
struct BG1 { const float* W;   __device__ __forceinline__ float operator()(int k, int n) const { return n < 160 ? W[(size_t)k * 160 + n] : 0.f; } };
struct BG2 { const float* W;   __device__ __forceinline__ float operator()(int k, int n) const { return k < 160 ? W[(size_t)k * 1024 + n] : 0.f; } };

struct EpiQKV {
    bf16_t* QKV; const float* tab; float qscale;
    __device__ __forceinline__ void operator()(int row, int col0, float (&v)[8]) const {
        if (col0 < 2048 && row >= RC) {
            const int t = row - RC, p0 = col0 & 63, pos = (p0 >> 5) ? (t & 63) : (t >> 6), i0 = (p0 & 31) >> 1;
            const f32x4 t0 = *(const f32x4*)(tab + (pos * 16 + i0) * 2), t1 = *(const f32x4*)(tab + (pos * 16 + i0) * 2 + 4);
            const float cs[8] = {t0[0], t0[1], t0[2], t0[3], t1[0], t1[1], t1[2], t1[3]};
#pragma unroll
            for (int j = 0; j < 4; ++j) { const float c = cs[2 * j], s = cs[2 * j + 1], e = v[2 * j], o = v[2 * j + 1]; v[2 * j] = e * c - o * s; v[2 * j + 1] = o * c + e * s; }
        }
        if (col0 < 1024) {
#pragma unroll
            for (int j = 0; j < 8; ++j) v[j] *= qscale;
        }
        u32x4 w = {pk2(v[0], v[1]), pk2(v[2], v[3]), pk2(v[4], v[5]), pk2(v[6], v[7])};
        *(u32x4*)(QKV + (size_t)row * 3072 + col0) = w;
        if (col0 >= 2048) {
            bf16_t* vt = QKV + (WS_VT - WS_QKV) / 2 + (size_t)(col0 - 2048) * R + row;
#pragma unroll
            for (int j = 0; j < 4; ++j) { vt[(size_t)(2 * j) * R] = (bf16_t)(w[j] & 0xffffu); vt[(size_t)(2 * j + 1) * R] = (bf16_t)(w[j] >> 16); }
        }
    }
};
struct EpiResid {
    bf16_t* XL; const float* modl; int which; const int* route; int expert;
    const float* xin = nullptr; const float* cin = nullptr;
    __device__ __forceinline__ void operator()(int row, int col0, float (&v)[8]) const {
        const float* m = modl + (row < RC ? 6144 : 0) + which * 1024 + col0;
        float gate = 1.f;
        if (route) { const int* rt = route + (size_t)row * 4; gate = (rt[0] == expert ? __int_as_float(rt[2]) : 0.f) + (rt[1] == expert ? __int_as_float(rt[3]) : 0.f); }
        bf16_t* x = XL + (size_t)row * 1024 + col0;
        f32x4 a, b;
        if (xin) { const float* xs = row < RC ? cin + (size_t)row * 1024 + col0 : xin + (size_t)(row - RC) * 1024 + col0; a = *(const f32x4*)xs; b = *(const f32x4*)(xs + 4); }
        else { const u32x4 r = *(const u32x4*)x;
            a[0] = bf2f(r[0]); a[1] = __uint_as_float(r[0] & 0xffff0000u); a[2] = bf2f(r[1]); a[3] = __uint_as_float(r[1] & 0xffff0000u);
            b[0] = bf2f(r[2]); b[1] = __uint_as_float(r[2] & 0xffff0000u); b[2] = bf2f(r[3]); b[3] = __uint_as_float(r[3] & 0xffff0000u); }
        a[0] += m[0] * v[0] * gate; a[1] += m[1] * v[1] * gate; a[2] += m[2] * v[2] * gate; a[3] += m[3] * v[3] * gate;
        b[0] += m[4] * v[4] * gate; b[1] += m[5] * v[5] * gate; b[2] += m[6] * v[6] * gate; b[3] += m[7] * v[7] * gate;
        const u32x4 w = {pk2(a[0], a[1]), pk2(a[2], a[3]), pk2(b[0], b[1]), pk2(b[2], b[3])};
        *(u32x4*)x = w;
    }
};
struct EpiGateUp {
    bf16_t* ACT; int ld;
    __device__ __forceinline__ void operator()(int row, int col0, float (&v)[8]) const {
        float a[4];
#pragma unroll
        for (int j = 0; j < 4; ++j) a[j] = siluf_(v[2 * j]) * v[2 * j + 1];
        u32x2 w = {pk2(a[0], a[1]), pk2(a[2], a[3])};
        *(u32x2*)(ACT + (size_t)row * ld + (col0 >> 1)) = w;
    }
};
struct EpiGelu {
    bf16_t* U; bf16_t* VP;
    __device__ __forceinline__ void operator()(int row, int col0, float (&v)[8]) const {
#pragma unroll
        for (int j = 0; j < 8; ++j) v[j] = geluf_(v[j]);
        const u32x4 w = {pk2(v[0], v[1]), pk2(v[2], v[3]), pk2(v[4], v[5]), pk2(v[6], v[7])};
        *(u32x4*)((col0 < 1024 ? U + col0 : VP + (col0 - 1024)) + (size_t)row * 1024) = w;
    }
};
struct EpiStore {
    bf16_t* O; int ld; int act;
    __device__ __forceinline__ void operator()(int row, int col0, float (&v)[8]) const {
        if (col0 >= ld) return;
#pragma unroll
        for (int j = 0; j < 8; ++j) { if (act == 1) v[j] = tanhf_(v[j]); else if (act == 2) v[j] = sigmoidf_(v[j]); }
        u32x4 w = {pk2(v[0], v[1]), pk2(v[2], v[3]), pk2(v[4], v[5]), pk2(v[6], v[7])};
        *(u32x4*)(O + (size_t)row * ld + col0) = w;
    }
};
struct EpiDecay {
    _Float16* DEC; const float* w0;
    __device__ __forceinline__ void operator()(int row, int col0, float (&v)[8]) const {
        const int z = col0 >> 10, d0 = col0 & 1023;
        const f32x4 wa = *(const f32x4*)(w0 + z * 1024 + d0), wb = *(const f32x4*)(w0 + z * 1024 + d0 + 4);
        _Float16* p = DEC + ((size_t)z * R + row) * 1024 + d0;
#pragma unroll
        for (int h = 0; h < 2; ++h) {
            f32x4 o;
#pragma unroll
            for (int j = 0; j < 4; ++j) { const float y = -((h ? wb[j] : wa[j]) + v[h * 4 + j]); const float t = __builtin_amdgcn_exp2f(-fabsf(y) * 1.4426950408889634f);
                const float sp = fmaxf(y, 0.f) + __builtin_amdgcn_logf(1.f + t) * 0.6931471805599453f; const float wl = -sp - 0.5f; o[j] = __builtin_amdgcn_exp2f(-1.4426950408889634f * __builtin_amdgcn_exp2f(wl * 1.4426950408889634f)); }
            typedef _Float16 h4_t __attribute__((ext_vector_type(4)));
            *(h4_t*)(p + h * 4) = (h4_t){(_Float16)o[0], (_Float16)o[1], (_Float16)o[2], (_Float16)o[3]};
            __builtin_amdgcn_sched_barrier(0);
        }
    }
};
struct EpiAP {
    bf16_t* AP; const float* a0;
    __device__ __forceinline__ void operator()(int row, int col0, float (&v)[8]) const {
        const int z = col0 >> 10, d0 = col0 & 1023;
        float o[8];
#pragma unroll
        for (int j = 0; j < 8; ++j) o[j] = sigmoidf_(a0[z * 1024 + d0 + j] + v[j]);
        u32x4 w = {pk2(o[0], o[1]), pk2(o[2], o[3]), pk2(o[4], o[5]), pk2(o[6], o[7])};
        *(u32x4*)(AP + ((size_t)z * R + row) * 1024 + d0) = w;
    }
};


namespace pg8 {
#define PG8_LAS __attribute__((address_space(3)))
typedef unsigned short bf16_t;
typedef short bf16x8 __attribute__((ext_vector_type(8)));
typedef float f32x4 __attribute__((ext_vector_type(4)));
typedef unsigned u32x4 __attribute__((ext_vector_type(4)));
constexpr int BM = 256, BK = 64, HALF = 128, HTB = HALF * BK * 2  , STAGE_BYTES = 8 * HTB, NXCD = 8, WGM = 8;

__host__ __device__ __forceinline__ int lds_byte(int r, int c) { const int st = (r >> 4) * 2 + (c >> 5), rr = r & 15, cc = c & 31, ob = rr * 64 + cc * 2; return st * 1024 + (ob ^ (((ob >> 9) & 1) << 5)); }
__host__ __device__ __forceinline__ void stage_rc(int b, int& R, int& C) { const int st = b / 1024, sb = b % 1024, swz = sb ^ (((sb >> 9) & 1) << 5); R = (st >> 1) * 16 + swz / 64; C = (st & 1) * 32 + (swz % 64) / 2; }
__host__ __device__ __forceinline__ int perm32(int rho) { const int n = rho >> 4, i = rho & 15; return 8 * (i >> 2) + 4 * n + (i & 3); }

struct Unit { int pm, pn; };
struct Gemm { const bf16_t* A; const bf16_t* Bt; int M, N, K; };

struct StaticOrder {
    int nM, nN, nwg, G, c;
    __host__ __device__ void init(int M, int N, int G_, int c_) { nM = M / BM; nN = N / BM; nwg = nM * nN; G = G_; c = c_; }
    __host__ __device__ bool next(int i, Unit& u) const {
        const long L = (long)i * G + c; if (L >= nwg) return false;
        int wgid = (int)L; { const int q = nwg / NXCD, r = nwg % NXCD, xcd = wgid % NXCD, off = wgid / NXCD; wgid = (xcd < r ? xcd * (q + 1) : r * (q + 1) + (xcd - r) * q) + off; }
        const int nig = WGM * nN, gid = wgid / nig, fm = gid * WGM, gsz = (nM - fm) < WGM ? (nM - fm) : WGM;
        u.pm = fm + ((wgid % nig) % gsz); u.pn = (wgid % nig) / gsz; return true;
    }
    __device__ __forceinline__ void a_ready(const Unit&) const {}
    __device__ __forceinline__ void done(const Unit&) const {}
};

__device__ __forceinline__ unsigned cvt_pk_bf16(float lo, float hi) { unsigned r; asm volatile("v_cvt_pk_bf16_f32 %0, %1, %2" : "=v"(r) : "v"(lo), "v"(hi)); return r; }

template <class Epi, class Sched, bool ALIGN_EPI = false, bool SP2 = false>
__device__ __forceinline__ void gemm_phase(PG8_LAS unsigned char* lds, const Gemm g, const Sched& S, const Epi& E) {
    const int tid = ptid(), wid = __builtin_amdgcn_readfirstlane(tid >> 6), lane = tid & 63, wr = wid >> 2, wc = wid & 3, fr = lane & 15, fq = lane >> 4;
    const int K = g.K, nt = K / BK;
    unsigned voffA[2], voffB[2];
#pragma unroll
    for (int i = 0; i < 2; ++i) { int R, C; stage_rc(tid * 16 + i * 8192, R, C); const int Rb = Epi::PERM ? ((R & ~31) + perm32(R & 31)) : R;
        voffA[i] = (unsigned)(R * K + C) * 2u; voffB[i] = (unsigned)(Rb * K + C) * 2u; }
    const size_t kstep = (size_t)(BK * 2);
    const size_t hstep = (size_t)HALF * K * 2;
    const size_t tstep = 2 * hstep;
    const unsigned ldsw = (unsigned)wid * 1024u;
    const int aoff = lds_byte(wr * 64 + fr, fq * 8), boff = lds_byte(wc * 32 + fr, fq * 8);
#define PG8_SA(b, h) (((b) * 2 + (h)) * HTB)
#define PG8_SB(b, h) ((4 + (b) * 2 + (h)) * HTB)
#define PG8_STAGE(bufoff, gbase, voff) do { _Pragma("unroll") for (int _i = 0; _i < 2; ++_i) \
        __builtin_amdgcn_global_load_lds((const unsigned*)((const char*)(gbase) + (voff)[_i]), (PG8_LAS unsigned*)(lds + (bufoff) + ldsw + _i * 8192), 16, 0, 0); } while (0)
#define PG8_LDA(dst, b, h) do { _Pragma("unroll") for (int m = 0; m < 4; ++m) _Pragma("unroll") for (int k = 0; k < 2; ++k) dst[m][k] = *(const PG8_LAS bf16x8*)(lds + PG8_SA(b, h) + aoff + m * 2048 + k * 1024); } while (0)
#define PG8_LDB(dst, b, h) do { _Pragma("unroll") for (int n = 0; n < 2; ++n) _Pragma("unroll") for (int k = 0; k < 2; ++k) dst[n][k] = *(const PG8_LAS bf16x8*)(lds + PG8_SB(b, h) + boff + n * 2048 + k * 1024); } while (0)
#define PG8_MMA(ai, bj, At, Bt) do { __builtin_amdgcn_s_setprio(1); _Pragma("unroll") for (int m = 0; m < 4; ++m) _Pragma("unroll") for (int n = 0; n < 2; ++n) _Pragma("unroll") for (int k = 0; k < 2; ++k) \
        acc[ai][bj][m][n] = __builtin_amdgcn_mfma_f32_16x16x32_bf16(Bt[n][k], At[m][k], acc[ai][bj][m][n], 0, 0, 0); __builtin_amdgcn_s_setprio(0); } while (0)
#define PG8_WAIT_V(n) asm volatile("s_waitcnt vmcnt(" #n ")" ::: "memory")
#define PG8_WAIT_L(n) asm volatile("s_waitcnt lgkmcnt(" #n ")" ::: "memory")
#define PG8_BAR __builtin_amdgcn_s_barrier()
#define PG8_SCHED __builtin_amdgcn_sched_barrier(0)
    Unit cur, nxt; int ui = 0;
    if (!S.next(0, cur)) return;
    f32x4 acc[2][2][4][2];
#pragma unroll
    for (int a = 0; a < 2; ++a)
#pragma unroll
        for (int b = 0; b < 2; ++b)
#pragma unroll
            for (int m = 0; m < 4; ++m)
#pragma unroll
                for (int n = 0; n < 2; ++n) acc[a][b][m][n] = (f32x4){0.f, 0.f, 0.f, 0.f};
    bf16x8 At[4][2], B0[2][2], B1[2][2];
    const char* cA = (const char*)g.A + (size_t)cur.pm * tstep; const char* cB = (const char*)g.Bt + (size_t)cur.pn * tstep;
    S.a_ready(cur);
    if constexpr (SP2) {
        PG8_STAGE(PG8_SB(0, 0), cB, voffB); PG8_STAGE(PG8_SB(0, 1), cB + hstep, voffB); PG8_STAGE(PG8_SA(0, 0), cA, voffA); PG8_STAGE(PG8_SA(0, 1), cA + hstep, voffA);
        if (wr == 1) PG8_BAR;
        PG8_WAIT_V(2); PG8_BAR;
        PG8_STAGE(PG8_SB(1, 0), cB + kstep, voffB); PG8_STAGE(PG8_SA(1, 0), cA + kstep, voffA); PG8_STAGE(PG8_SB(1, 1), cB + hstep + kstep, voffB);
        PG8_WAIT_V(6); PG8_BAR;
    } else {
        PG8_STAGE(PG8_SB(0, 0), cB, voffB); PG8_STAGE(PG8_SA(0, 0), cA, voffA); PG8_STAGE(PG8_SB(0, 1), cB + hstep, voffB); PG8_STAGE(PG8_SA(0, 1), cA + hstep, voffA);
        if (wr == 1) PG8_BAR;
        PG8_WAIT_V(4); PG8_BAR;
        PG8_STAGE(PG8_SB(1, 0), cB + kstep, voffB); PG8_STAGE(PG8_SA(1, 0), cA + kstep, voffA); PG8_STAGE(PG8_SB(1, 1), cB + hstep + kstep, voffB);
        PG8_WAIT_V(6); PG8_BAR;
    }
    for (;;) {
        const bool has_next = S.next(ui + 1, nxt);
        const char* nA = has_next ? (const char*)g.A + (size_t)nxt.pm * tstep : cA; const char* nB = has_next ? (const char*)g.Bt + (size_t)nxt.pn * tstep : cB;
        for (int t = 0; t < nt; t += 2) {
            const bool last = (t == nt - 2);
            const char* a1 = cA + (size_t)(t + 1) * kstep;
            const char* a2 = last ? nA : cA + (size_t)(t + 2) * kstep; const char* b2 = last ? nB : cB + (size_t)(t + 2) * kstep;
            const char* a3 = a2 + kstep; const char* b3 = b2 + kstep;
            if (last && has_next) S.a_ready(nxt);
            if constexpr (SP2) {
            PG8_LDB(B0, 0, 0); PG8_LDB(B1, 0, 1); PG8_SCHED; PG8_LDA(At, 0, 0); PG8_STAGE(PG8_SA(1, 1), a1 + hstep, voffA);
            PG8_WAIT_V(8); PG8_WAIT_L(0); PG8_BAR; PG8_MMA(0, 0, At, B0); PG8_MMA(0, 1, At, B1); PG8_BAR; PG8_SCHED;
            PG8_LDA(At, 0, 1); PG8_STAGE(PG8_SB(0, 0), b2, voffB); PG8_STAGE(PG8_SB(0, 1), b2 + hstep, voffB); PG8_STAGE(PG8_SA(0, 0), a2, voffA);
            PG8_WAIT_V(8); PG8_WAIT_L(0); PG8_BAR; PG8_MMA(1, 0, At, B0); PG8_MMA(1, 1, At, B1); PG8_BAR; PG8_SCHED;
            PG8_LDB(B0, 1, 0); PG8_LDB(B1, 1, 1); PG8_SCHED; PG8_LDA(At, 1, 0); PG8_STAGE(PG8_SA(0, 1), a2 + hstep, voffA);
            PG8_WAIT_V(8); PG8_WAIT_L(0); PG8_BAR; PG8_MMA(0, 0, At, B0); PG8_MMA(0, 1, At, B1); PG8_BAR; PG8_SCHED;
            PG8_LDA(At, 1, 1); PG8_STAGE(PG8_SB(1, 0), b3, voffB); PG8_STAGE(PG8_SB(1, 1), b3 + hstep, voffB); PG8_STAGE(PG8_SA(1, 0), a3, voffA);
            PG8_WAIT_V(8); PG8_WAIT_L(0); PG8_BAR; PG8_MMA(1, 0, At, B0); PG8_MMA(1, 1, At, B1); PG8_BAR; PG8_SCHED;
            } else {
            PG8_LDB(B0, 0, 0); PG8_SCHED; PG8_LDA(At, 0, 0); PG8_STAGE(PG8_SA(1, 1), a1 + hstep, voffA);
            PG8_WAIT_L(8); PG8_BAR; PG8_WAIT_L(0); PG8_MMA(0, 0, At, B0); PG8_BAR; PG8_SCHED;
            PG8_LDB(B1, 0, 1); PG8_STAGE(PG8_SB(0, 0), b2, voffB);
            PG8_BAR; PG8_WAIT_L(0); PG8_MMA(0, 1, At, B1); PG8_BAR;
            PG8_LDA(At, 0, 1); PG8_STAGE(PG8_SA(0, 0), a2, voffA);
            PG8_BAR; PG8_WAIT_L(0); PG8_MMA(1, 0, At, B0); PG8_BAR; PG8_SCHED;
            PG8_STAGE(PG8_SB(0, 1), b2 + hstep, voffB);
            PG8_WAIT_V(6); PG8_BAR; PG8_MMA(1, 1, At, B1); PG8_BAR;
            PG8_LDB(B0, 1, 0); PG8_SCHED; PG8_LDA(At, 1, 0); PG8_STAGE(PG8_SA(0, 1), a2 + hstep, voffA);
            PG8_WAIT_L(8); PG8_BAR; PG8_WAIT_L(0); PG8_MMA(0, 0, At, B0); PG8_BAR; PG8_SCHED;
            PG8_LDB(B1, 1, 1); PG8_STAGE(PG8_SB(1, 0), b3, voffB);
            PG8_BAR; PG8_WAIT_L(0); PG8_MMA(0, 1, At, B1); PG8_BAR;
            PG8_LDA(At, 1, 1); PG8_STAGE(PG8_SA(1, 0), a3, voffA);
            PG8_BAR; PG8_WAIT_L(0); PG8_MMA(1, 0, At, B0); PG8_BAR; PG8_SCHED;
            PG8_STAGE(PG8_SB(1, 1), b3 + hstep, voffB);
            PG8_WAIT_V(6); PG8_BAR; PG8_MMA(1, 1, At, B1); PG8_BAR;
            }
        }
        if constexpr (ALIGN_EPI) { if (wr == 0) PG8_BAR; }
        if constexpr (!Epi::AFTER_DRAIN) { E(acc, cur, wr, wc, fr, fq); S.done(cur); }
        if (!has_next) break;
#pragma unroll
        for (int a = 0; a < 2; ++a)
#pragma unroll
            for (int b = 0; b < 2; ++b)
#pragma unroll
                for (int m = 0; m < 4; ++m)
#pragma unroll
                    for (int n = 0; n < 2; ++n) acc[a][b][m][n] = (f32x4){0.f, 0.f, 0.f, 0.f};
        cur = nxt; cA = nA; cB = nB; ++ui;
        if constexpr (ALIGN_EPI) { if (wr == 1) PG8_BAR; }
    }
    PG8_WAIT_V(0);
    if constexpr (!ALIGN_EPI) { if (wr == 0) PG8_BAR; }
    PG8_BAR;
    if constexpr (Epi::AFTER_DRAIN) { E.fused(acc, cur, wr, wc, fr, fq, lds, wid, lane); S.done(cur); }
#undef PG8_SA
#undef PG8_SB
#undef PG8_STAGE
#undef PG8_LDA
#undef PG8_LDB
#undef PG8_MMA
#undef PG8_WAIT_V
#undef PG8_WAIT_L
#undef PG8_BAR
#undef PG8_SCHED
}
}


template <class E> struct EpiA {
    static constexpr bool PERM = true, AFTER_DRAIN = false;
    E e; int row0;
    __device__ __forceinline__ void operator()(const pg8::f32x4 (&acc)[2][2][4][2], const pg8::Unit& u, int wr, int wc, int fr, int fq) const {
#pragma unroll
        for (int ai = 0; ai < 2; ++ai)
#pragma unroll
            for (int m = 0; m < 4; ++m)
#pragma unroll
                for (int bj = 0; bj < 2; ++bj) {
                    float v[8] = {acc[ai][bj][m][0][0], acc[ai][bj][m][0][1], acc[ai][bj][m][0][2], acc[ai][bj][m][0][3], acc[ai][bj][m][1][0], acc[ai][bj][m][1][1], acc[ai][bj][m][1][2], acc[ai][bj][m][1][3]};
                    e(row0 + u.pm * 256 + ai * 128 + wr * 64 + m * 16 + fr, u.pn * 256 + bj * 128 + wc * 32 + 8 * fq, v);
                    __builtin_amdgcn_sched_barrier(0);
                }
    }
};
template <class E>
__device__ __forceinline__ void gemm_fast(char* lds, const bf16_t* A, int row0, int M, int K, const bf16_t* Bt, int N, const E& e, int rot = 0) {
    asm volatile("" : "+s"(K));
    pg8::Gemm g{A + (size_t)row0 * K, Bt, M, N, K}; pg8::StaticOrder S; S.init(M, N, (int)gridDim.x, ((int)blockIdx.x + rot) % (int)gridDim.x);
    EpiA<E> ea{e, row0};
    pg8::gemm_phase<EpiA<E>, pg8::StaticOrder, true, true>((PG8_LAS unsigned char*)lds, g, S, ea);
}

struct EpiResid4 { bf16_t* XL; const float* modl; int which; const float* cin = nullptr;
    __device__ __forceinline__ void operator()(int row, int col0, f32x4 v) const {
        const f32x4 m = *(const f32x4*)(modl + 6144 + which * 1024 + col0); bf16_t* x = XL + (size_t)row * 1024 + col0;
        f32x4 a;
        if (cin) a = *(const f32x4*)(cin + (size_t)row * 1024 + col0);
        else { const u32x2 r = *(const u32x2*)x; a[0] = bf2f(r[0]); a[1] = __uint_as_float(r[0] & 0xffff0000u); a[2] = bf2f(r[1]); a[3] = __uint_as_float(r[1] & 0xffff0000u); }
        a += m * v;
        const u32x2 w = {pk2(a[0], a[1]), pk2(a[2], a[3])}; *(u32x2*)x = w; } };
struct EpiQKV4 { bf16_t* QKV; float qscale;
    __device__ __forceinline__ void operator()(int row, int col0, f32x4 v) const {
        if (col0 < 1024) v = v * qscale;
        u32x2 w = {pk2(v[0], v[1]), pk2(v[2], v[3])}; *(u32x2*)(QKV + (size_t)row * 3072 + col0) = w;
        if (col0 >= 2048) { bf16_t* vt = QKV + (WS_VT - WS_QKV) / 2 + (size_t)(col0 - 2048) * R + row;
            vt[0] = (bf16_t)(w[0] & 0xffffu); vt[R] = (bf16_t)(w[0] >> 16); vt[2 * (size_t)R] = (bf16_t)(w[1] & 0xffffu); vt[3 * (size_t)R] = (bf16_t)(w[1] >> 16); } } };
struct EpiGelu4 { bf16_t* U; bf16_t* VP;
    __device__ __forceinline__ void operator()(int row, int col0, f32x4 v) const {
        v = (f32x4){geluf_(v[0]), geluf_(v[1]), geluf_(v[2]), geluf_(v[3])};
        const u32x2 w = {pk2(v[0], v[1]), pk2(v[2], v[3])};
        *(u32x2*)((col0 < 1024 ? U + col0 : VP + (col0 - 1024)) + (size_t)row * 1024) = w; } };
template <class E4>
__device__ __forceinline__ void gemm_ctx(char* smem, const bf16_t* A, int K, const bf16_t* Bt, int N, const E4& e) {
    typedef short bf16x8_ __attribute__((ext_vector_type(8)));
    const int tid = ptid(), lane = tid & 63, wv = __builtin_amdgcn_readfirstlane(tid >> 6), fr = lane & 15, fq = lane >> 4;
    f32x4* P = (f32x4*)smem;
    const int nP = 4 * (N / 64), kw = K / 8;
    for (int pc = blockIdx.x; pc < nP; pc += gridDim.x) {
        const int r0 = (pc & 3) * 64, n0 = (pc >> 2) * 64;
        f32x4 acc[4][4];
#pragma unroll
        for (int a = 0; a < 4; ++a)
#pragma unroll
            for (int t = 0; t < 4; ++t) acc[a][t] = (f32x4){0.f, 0.f, 0.f, 0.f};
        const bf16_t* ap = A + (size_t)(r0 + fr) * K + wv * kw + fq * 8;
        const bf16_t* bp = Bt + (size_t)(n0 + fr) * K + wv * kw + fq * 8;
#pragma unroll 2
        for (int k = 0; k < kw; k += 32) {
            bf16x8_ af[4], bq[4];
#pragma unroll
            for (int a = 0; a < 4; ++a) { af[a] = *(const bf16x8_*)(ap + (size_t)16 * a * K + k); bq[a] = *(const bf16x8_*)(bp + (size_t)16 * a * K + k); }
#pragma unroll
            for (int a = 0; a < 4; ++a)
#pragma unroll
                for (int t = 0; t < 4; ++t) acc[a][t] = __builtin_amdgcn_mfma_f32_16x16x32_bf16(bq[t], af[a], acc[a][t], 0, 0, 0);
        }
        __syncthreads();
#pragma unroll
        for (int a = 0; a < 4; ++a)
#pragma unroll
            for (int t = 0; t < 4; ++t) P[(wv * 16 + a * 4 + t) * 64 + lane] = acc[a][t];
        __syncthreads();
#pragma unroll
        for (int i = 0; i < 2; ++i) {
            const int tt = (tid >> 6) + 8 * i; f32x4 sum = P[tt * 64 + lane];
#pragma unroll
            for (int w = 1; w < 8; ++w) sum = sum + P[(w * 16 + tt) * 64 + lane];
            e(r0 + 16 * (tt >> 2) + fr, n0 + 16 * (tt & 3) + 4 * fq, sum);
        }
    }
    __syncthreads();
}
template <class BMap>
__device__ __forceinline__ void conv_w(const BMap B, bf16_t* Bt, int N, int K, float* lds_, int& rot, int gi = -1, int gn = 0) {
    __attribute__((address_space(3))) float* lds = (__attribute__((address_space(3))) float*)lds_;
    const int tid = ptid(), nTk = K / 64, nT = (N / 256) * nTk, G_ = gn > 0 ? gn : (int)gridDim.x;
    const int t0 = ((gn > 0 ? gi : (int)blockIdx.x) - rot + G_) % G_; rot = (rot + nT) % G_;
    for (int t = t0; t < nT; t += G_) {
        const int n0 = (t / nTk) * 256, k0 = (t % nTk) * 64;
        __syncthreads();
        float v[8][4];
#pragma unroll
        for (int i = 0; i < 8; ++i)
#pragma unroll
            for (int q = 0; q < 4; ++q) v[i][q] = B(k0 + (tid >> 6) + 8 * i, n0 + (tid & 63) + 64 * q);
#pragma unroll
        for (int i = 0; i < 8; ++i)
#pragma unroll
            for (int q = 0; q < 4; ++q) lds[((tid >> 6) + 8 * i) * 257 + (tid & 63) + 64 * q] = v[i][q];
        __syncthreads();
#pragma unroll
        for (int q = 0; q < 4; ++q) {
            const int nl = (tid >> 3) + 64 * q, k8 = (tid & 7) * 8;
            u32x4 w = {pk2(lds[(k8 + 0) * 257 + nl], lds[(k8 + 1) * 257 + nl]), pk2(lds[(k8 + 2) * 257 + nl], lds[(k8 + 3) * 257 + nl]),
                       pk2(lds[(k8 + 4) * 257 + nl], lds[(k8 + 5) * 257 + nl]), pk2(lds[(k8 + 6) * 257 + nl], lds[(k8 + 7) * 257 + nl])};
            *(u32x4*)(Bt + (size_t)(n0 + nl) * K + k0 + k8) = w;
        }
    }
}

__device__ __forceinline__ void phase_mod(const Params& p, float* lds) {
    const int tid = ptid(), lane = tid & 63, wv = tid >> 6;
    float* MOD = (float*)(p.ws + WS_MOD);
    const float* c = p.in[1]; const float* cc = p.in[3]; const float* mw = p.in[5]; const float* mb = p.in[6];
    float* sl_c = lds + 1024; float* sl_x = lds + 2048;
    for (int k = tid; k < 1024; k += NTHR) { sl_c[k] = siluf_(c[k]); sl_x[k] = siluf_(cc[k]); }
    __syncthreads();
    for (int item = blockIdx.x; item < 4 * 96; item += gridDim.x) {
        const int i = item / 96, n = (item % 96) * 64 + lane;
        float sl = 0.f, sc = 0.f;
        const float* wp = mw + ((size_t)i * 1024 + wv * 128) * 6144 + n;
#pragma unroll 1
        for (int k8 = 0; k8 < 128; k8 += 32) {
            float w[32];
#pragma unroll
            for (int e = 0; e < 32; ++e) w[e] = wp[(size_t)(k8 + e) * 6144];
#pragma unroll
            for (int e = 0; e < 32; ++e) { sl += sl_c[wv * 128 + k8 + e] * w[e]; sc += sl_x[wv * 128 + k8 + e] * w[e]; }
        }
        lds[wv * 64 + lane] = sl; lds[512 + wv * 64 + lane] = sc;
        __syncthreads();
        if (wv == 0) {
            float a = 0.f, b = 0.f;
#pragma unroll
            for (int w = 0; w < 8; ++w) { a += lds[w * 64 + lane]; b += lds[512 + w * 64 + lane]; }
            const float bias = mb[i * 6144 + n];
            MOD[(i * 2 + 0) * 6144 + n] = a + bias; MOD[(i * 2 + 1) * 6144 + n] = b + bias;
        }
        __syncthreads();
    }
    float* tab = (float*)(p.ws + WS_TAB);
    for (int idx = blockIdx.x * NTHR + tid; idx < 256 * 16; idx += gridDim.x * NTHR) {
        const int pos = idx >> 4, f = idx & 15;
        const float inv = (float)pow(10000.0, -(double)f / 16.0);
        const float ang = (float)pos * inv;
        tab[idx * 2] = (float)cos((double)ang); tab[idx * 2 + 1] = (float)sin((double)ang);
    }
}

__device__ __forceinline__ void phase_norm(const Params& p, int layer, int which, int init, int route_j, int row_lo, int final_out, int comb_layer, char* smem) {
    const int tid = ptid(), lane = tid & 63, wv = tid >> 6;
    int* li = (int*)smem; float* lf = (float*)(smem + 4096);
    bf16_t* XL = (bf16_t*)(p.ws + WS_XL); bf16_t* H = (bf16_t*)(p.ws + WS_H);
    const float* g = final_out ? p.in[7] : p.in[4] + (layer * 2 + which) * 1024;
    const float* modb = (const float*)(p.ws + WS_MOD) + layer * 2 * 6144;
    const int nrows = (R - row_lo + (int)gridDim.x - 1) / (int)gridDim.x, rbase = row_lo + (int)blockIdx.x * nrows, rend = (rbase + nrows < R) ? rbase + nrows : R;
    if (route_j >= 0) { if (tid < 8) li[tid] = 0; __syncthreads(); }
    f32x4 xpre[4]; u32x2 xraw[4];
#define NORM_LOAD(row_, X) do { const int r_ = (row_); _Pragma("unroll") for (int j = 0; j < 4; ++j) { const int col = j * 256 + lane * 4; \
        if (init) { const float* src = r_ < RC ? p.in[2] + (size_t)r_ * 1024 : p.in[0] + (size_t)(r_ - RC) * 1024; X[j] = *(const f32x4*)(src + col); } \
        else xraw[j] = *(const u32x2*)(XL + (size_t)r_ * 1024 + col); } } while (0)
    f32x4 rtv[4][8];
    if (route_j >= 0) {
#pragma unroll
        for (int j = 0; j < 4; ++j)
#pragma unroll
            for (int i = 0; i < 8; ++i) rtv[j][i] = *(const f32x4*)(p.in[37] + (size_t)route_j * 8192 + (size_t)(j * 256 + lane * 4) * 8 + i * 4);
    }
#define rtw(j_, i_) rtv[j_][(i_) >> 2][(i_) & 3]
    if (rbase + wv < rend) NORM_LOAD(rbase + wv, xpre);
    for (int row = rbase + wv; row < rend; row += 8) {
        const bool isc = row < RC;
        const float* m = modb + (isc ? 6144 : 0);
        const float* shift = m + (which ? 3 : 0) * 1024; const float* scale = m + (which ? 4 : 1) * 1024;
        f32x4 x[4]; float ss = 0.f;
#pragma unroll
        for (int j = 0; j < 4; ++j) {
            if (init) x[j] = xpre[j];
            else { x[j][0] = bf2f(xraw[j][0]); x[j][1] = __uint_as_float(xraw[j][0] & 0xffff0000u); x[j][2] = bf2f(xraw[j][1]); x[j][3] = __uint_as_float(xraw[j][1] & 0xffff0000u); }
        }
        if (row + 8 < rend) NORM_LOAD(row + 8, xpre);
        int s0 = 0, s1 = 0; float cg0 = 0.f, cg1 = 0.f; const float* cm = nullptr;
        if (comb_layer >= 0) {
            const int* sl = (const int*)(p.ws + WS_SLOT) + (size_t)row * 2; const float* gg = (const float*)(p.ws + WS_RTG) + (size_t)row * 2;
            s0 = sl[0]; s1 = sl[1]; cg0 = gg[0]; cg1 = gg[1];
            cm = (const float*)(p.ws + WS_MOD) + comb_layer * 2 * 6144 + (isc ? 6144 : 0) + 5 * 1024;
        }
#pragma unroll
        for (int j = 0; j < 4; ++j) {
            const int col = j * 256 + lane * 4;
            if (comb_layer >= 0) {
                const bf16_t* Y = (const bf16_t*)(p.ws + WS_YM);
                const u32x2 a = *(const u32x2*)(Y + (size_t)s0 * 1024 + col), b = *(const u32x2*)(Y + (size_t)s1 * 1024 + col);
                const f32x4 mm = *(const f32x4*)(cm + col);
                x[j][0] += mm[0] * (cg0 * bf2f(a[0] & 0xffffu) + cg1 * bf2f(b[0] & 0xffffu)); x[j][1] += mm[1] * (cg0 * bf2f(a[0] >> 16) + cg1 * bf2f(b[0] >> 16));
                x[j][2] += mm[2] * (cg0 * bf2f(a[1] & 0xffffu) + cg1 * bf2f(b[1] & 0xffffu)); x[j][3] += mm[3] * (cg0 * bf2f(a[1] >> 16) + cg1 * bf2f(b[1] >> 16));
                if (!final_out) { const u32x2 xw = {pk2(x[j][0], x[j][1]), pk2(x[j][2], x[j][3])}; *(u32x2*)(XL + (size_t)row * 1024 + col) = xw; }
            }
            ss += x[j][0] * x[j][0] + x[j][1] * x[j][1] + x[j][2] * x[j][2] + x[j][3] * x[j][3];
        }
        ss = wave_sum(ss);
        const float rs = rsqrtf(ss * (1.f / 1024.f) + 1e-6f);
        float lg[8];
#pragma unroll
        for (int e = 0; e < 8; ++e) lg[e] = 0.f;
#pragma unroll
        for (int j = 0; j < 4; ++j) {
            const int col = j * 256 + lane * 4;
            const f32x4 gg = *(const f32x4*)(g + col);
            f32x4 h;
            if (final_out) { h = x[j] * rs * gg; *(f32x4*)(p.out + (size_t)(row - RC) * 1024 + col) = h; }
            else {
                const f32x4 sc = *(const f32x4*)(scale + col), sh = *(const f32x4*)(shift + col);
                h = x[j] * rs * gg * (1.f + sc) + sh;
                u32x2 w = {pk2(h[0], h[1]), pk2(h[2], h[3])};
                *(u32x2*)(H + (size_t)row * 1024 + col) = w;
                if (route_j >= 0) {
#pragma unroll
                    for (int q = 0; q < 4; ++q)
#pragma unroll
                        for (int e = 0; e < 8; ++e) lg[e] += h[q] * rtw(j, q * 8 + e);
                }
            }
        }
        if (route_j >= 0 && !final_out) {
#pragma unroll
            for (int e = 0; e < 8; ++e) lg[e] = wave_sum(lg[e]);
            if (lane == 0) {
                int i0 = 0; float v0 = lg[0];
#pragma unroll
                for (int e = 1; e < 8; ++e) if (lg[e] > v0) { v0 = lg[e]; i0 = e; }
                int i1 = -1; float v1 = -3.0e38f;
#pragma unroll
                for (int e = 0; e < 8; ++e) if (e != i0 && lg[e] > v1) { v1 = lg[e]; i1 = e; }
                const float e1 = expf(v1 - v0), g0 = 1.f / (1.f + e1), g1 = e1 / (1.f + e1);
                const int i = row - rbase;
                li[16 + 4 * i] = i0; li[17 + 4 * i] = i1; li[18 + 4 * i] = atomicAdd(&li[i0], 1); li[19 + 4 * i] = atomicAdd(&li[i1], 1);
                lf[2 * i] = g0; lf[2 * i + 1] = g1;
            }
        }
    }
    if (route_j >= 0) {
        unsigned* gcnt = (unsigned*)(p.ws + WS_CTL) + CW_MOE + route_j * 256;
        __syncthreads();
        if (tid < 8) li[8 + tid] = (int)atomicAdd(gcnt + tid * 16, (unsigned)li[tid]);
        __syncthreads();
        for (int i = tid; i < rend - rbase; i += NTHR) {
            const int e0 = li[16 + 4 * i], e1 = li[17 + 4 * i];
            int* ro = (int*)(p.ws + WS_ROUTE) + (size_t)(rbase + i) * 4;
            ro[0] = e0; ro[1] = e1; ro[2] = li[8 + e0] + li[18 + 4 * i]; ro[3] = li[8 + e1] + li[19 + 4 * i];
            float* go = (float*)(p.ws + WS_RTG) + (size_t)(rbase + i) * 2; go[0] = lf[2 * i]; go[1] = lf[2 * i + 1];
        }
    }
}

#undef NORM_LOAD
__device__ __forceinline__ void moe_bases(const Params& p, int j, int (&base)[9]) {
    const unsigned* gcnt = (const unsigned*)(p.ws + WS_CTL) + CW_MOE + j * 256;
    base[0] = 0;
#pragma unroll
    for (int e = 0; e < 8; ++e) base[e + 1] = base[e] + (int)((__hip_atomic_load(gcnt + e * 16, __ATOMIC_RELAXED, __HIP_MEMORY_SCOPE_AGENT) + 255u) & ~255u);
}
__device__ __forceinline__ void phase_perm(const Params& p, int j, int row_lo, char* smem) {
    const int tid = ptid(), lane = tid & 63, wv = tid >> 6;
    int* lb = (int*)smem;
    { int base[9]; moe_bases(p, j, base); if (tid == 0) {
#pragma unroll
        for (int e = 0; e < 9; ++e) lb[e] = base[e]; } }
    __syncthreads();
    const bf16_t* H = (const bf16_t*)(p.ws + WS_H); bf16_t* HP = (bf16_t*)(p.ws + WS_HP);
    for (int row = row_lo + blockIdx.x * 8 + wv; row < R; row += gridDim.x * 8) {
        const int* ro = (const int*)(p.ws + WS_ROUTE) + (size_t)row * 4;
        const int s0 = lb[ro[0]] + ro[2], s1 = lb[ro[1]] + ro[3];
        const u32x4 a = *(const u32x4*)(H + (size_t)row * 1024 + lane * 8), b = *(const u32x4*)(H + (size_t)row * 1024 + 512 + lane * 8);
        *(u32x4*)(HP + (size_t)s0 * 1024 + lane * 8) = a; *(u32x4*)(HP + (size_t)s0 * 1024 + 512 + lane * 8) = b;
        *(u32x4*)(HP + (size_t)s1 * 1024 + lane * 8) = a; *(u32x4*)(HP + (size_t)s1 * 1024 + 512 + lane * 8) = b;
        if (lane == 0) { int* sl = (int*)(p.ws + WS_SLOT) + (size_t)row * 2; sl[0] = s0; sl[1] = s1; }
    }
}
struct MoeOrder {
    const int* lb; int nN, G, c, ntiles;
    __device__ __forceinline__ bool next(int i, pg8::Unit& u) const {
        const long L = (long)i * G + c; if (L >= (long)ntiles * nN) return false;
        const int t = (int)(L / nN), pn = (int)(L % nN); int e = 0;
#pragma unroll
        for (int q = 1; q < 8; ++q) e += (t * 256 >= lb[q]) ? 1 : 0;
        u.pm = t; u.pn = __builtin_amdgcn_readfirstlane(e) * nN + pn; return true;
    }
    __device__ __forceinline__ void a_ready(const pg8::Unit&) const {}
    __device__ __forceinline__ void done(const pg8::Unit&) const {}
};
struct EpiGateUpM { bf16_t* ACT;
    __device__ __forceinline__ void operator()(int row, int col0, float (&v)[8]) const {
        float a[4];
#pragma unroll
        for (int j = 0; j < 4; ++j) a[j] = siluf_(v[2 * j]) * v[2 * j + 1];
        u32x2 w = {pk2(a[0], a[1]), pk2(a[2], a[3])};
        const int eb = (__builtin_amdgcn_readfirstlane(col0) / (2 * FF)) * (2 * FF);
        *(u32x2*)(ACT + (size_t)row * FF + ((col0 - eb) >> 1)) = w;
    }
};
struct EpiStoreM { bf16_t* Y;
    __device__ __forceinline__ void operator()(int row, int col0, float (&v)[8]) const {
        u32x4 w = {pk2(v[0], v[1]), pk2(v[2], v[3]), pk2(v[4], v[5]), pk2(v[6], v[7])};
        *(u32x4*)(Y + (size_t)row * 1024 + (col0 & 1023)) = w;
    }
};
template <class E>
__device__ __forceinline__ void gemm_moe(char* lds, const Params& p, int j, const bf16_t* A, int K, const bf16_t* Bt, int nN, const E& e) {
    int* lb = (int*)(lds + 132 * 1024);
    { int base[9]; moe_bases(p, j, base); if (ptid() == 0) {
#pragma unroll
        for (int q = 0; q < 9; ++q) lb[q] = base[q]; } }
    __syncthreads();
    MoeOrder S; S.lb = lb; S.nN = nN; S.G = (int)gridDim.x; S.c = (int)blockIdx.x; S.ntiles = __builtin_amdgcn_readfirstlane(lb[8]) >> 8;
    pg8::Gemm g{A, Bt, 0, 0, K};
    EpiA<E> ea{e, 0};
    pg8::gemm_phase<EpiA<E>, MoeOrder, true, true>((PG8_LAS unsigned char*)lds, g, S, ea);
}

struct RwkvOrder {
    int G, c;
    __device__ __forceinline__ bool next(int i, pg8::Unit& u) const {
        const int L = i * G + c; if (L >= 975) return false;
        if (L < 780) { const int q = L / 260, rem = L - q * 260; u.pm = (q == 0 ? 0 : q + 1) * 65 + (rem >> 2); u.pn = q * 4 + (rem & 3); }
        else { const int q2 = (L - 780) / 65, pm = (L - 780) - q2 * 65; u.pm = (q2 == 0 ? 1 : q2 + 3) * 65 + pm; u.pn = 12 + q2; }
        return true;
    }
    __device__ __forceinline__ void a_ready(const pg8::Unit&) const {}
    __device__ __forceinline__ void done(const pg8::Unit&) const {}
};
struct EpiRwkv1 {
    unsigned char* ws;
    __device__ __forceinline__ void operator()(int row, int col0, float (&v)[8]) const {
        const int mi = row / R, lrow = row - mi * R;
        if (col0 < 3072) {
            const int q = col0 >> 10;
            u32x4 w = {pk2(v[0], v[1]), pk2(v[2], v[3]), pk2(v[4], v[5]), pk2(v[6], v[7])};
            *(u32x4*)((bf16_t*)(ws + WS_RR + (size_t)q * 33 * MiB) + (size_t)lrow * 1024 + (col0 & 1023)) = w;
        } else {
            const int q2 = (col0 - 3072) >> 8, c = (col0 - 3072) & 255;
            if (q2 < 2 && c >= 128) return;
#pragma unroll
            for (int j = 0; j < 8; ++j) { if (q2 == 0) v[j] = tanhf_(v[j]); else if (q2 == 2) v[j] = sigmoidf_(v[j]); }
            u32x4 w = {pk2(v[0], v[1]), pk2(v[2], v[3]), pk2(v[4], v[5]), pk2(v[6], v[7])};
            bf16_t* dst = q2 == 0 ? (bf16_t*)(ws + WS_L1W) + (size_t)lrow * 128 : (q2 == 1 ? (bf16_t*)(ws + WS_L1A) + (size_t)lrow * 128 : (bf16_t*)(ws + WS_L1G) + (size_t)lrow * 256);
            *(u32x4*)(dst + c) = w;
        }
    }
};
__device__ __forceinline__ void gemm_rwkv1(char* lds, const Params& p) {
    int K = 1024; asm volatile("" : "+s"(K));
    RwkvOrder S; S.G = (int)gridDim.x; S.c = (int)blockIdx.x;
    pg8::Gemm g{WSB(WS_MIX), WSB(WS_WIN), 0, 0, K};
    EpiA<EpiRwkv1> ea{EpiRwkv1{p.ws}, 0};
    pg8::gemm_phase<EpiA<EpiRwkv1>, RwkvOrder, true, true>((PG8_LAS unsigned char*)lds, g, S, ea);
}


namespace att {
using bf16x8 = __attribute__((ext_vector_type(8))) short;
using s16x4  = __attribute__((ext_vector_type(4))) short;
using f32x16 = __attribute__((ext_vector_type(16))) float;
constexpr int NW = 8, QBLK = 32, KVBLK = 64, LDQ = 3072, LDO = 2048;
constexpr float THR2 = 8.f;
constexpr int KPITCH = 144, VPITCH = 144, SHM_V = 128 * VPITCH  , SHM_K = KVBLK * KPITCH, SHM_ATTN = 3 * SHM_V + 3 * SHM_K + NW * 64 * 4;
#define KSWZ64(row, colB) ((row) * KPITCH + (colB))
#define SBAR() __builtin_amdgcn_sched_barrier(0)
__device__ __forceinline__ int crow(int r, int hi) { return (r & 3) + 8 * (r >> 2) + 4 * hi; }
__device__ __forceinline__ unsigned cvtpk(float lo, float hi) { unsigned r; asm volatile("v_cvt_pk_bf16_f32 %0, %1, %2" : "=v"(r) : "v"(lo), "v"(hi)); return r; }
__device__ __forceinline__ void partialSM(f32x16& p0, f32x16& p1, float& m_reg, float& alpha) {
    float pmax = fmaxf(fmaxf(p0[0], p0[1]), p0[2]);
#pragma unroll
    for (int r = 3; r < 15; r += 2) pmax = fmaxf(fmaxf(pmax, p0[r]), p0[r + 1]);
    pmax = fmaxf(fmaxf(pmax, p0[15]), p1[0]);
#pragma unroll
    for (int r = 1; r < 15; r += 2) pmax = fmaxf(fmaxf(pmax, p1[r]), p1[r + 1]);
    pmax = fmaxf(pmax, p1[15]);
    { auto rr = __builtin_amdgcn_permlane32_swap(__float_as_uint(pmax), __float_as_uint(pmax), false, false); pmax = fmaxf(__uint_as_float(rr[0]), __uint_as_float(rr[1])); }
    if (__builtin_expect(__all(pmax <= THR2), 1)) { alpha = 1.f; }
    else {
        const float d = fmaxf(pmax, 0.f); alpha = __builtin_amdgcn_exp2f(-d); m_reg += d;
#pragma unroll
        for (int r = 0; r < 16; ++r) { p0[r] -= d; p1[r] -= d; }
    }
#pragma unroll
    for (int r = 0; r < 16; ++r) p0[r] = __builtin_amdgcn_exp2f(p0[r]);
}
__device__ __forceinline__ void finishSM(f32x16& p0, f32x16& p1, float alpha, float& l_reg, bf16x8& pa0, bf16x8& pa1, bf16x8& pa2, bf16x8& pa3) {
#pragma unroll
    for (int r = 0; r < 16; ++r) p1[r] = __builtin_amdgcn_exp2f(p1[r]);
    float ps = 0;
#pragma unroll
    for (int r = 0; r < 16; ++r) ps += p0[r];
#pragma unroll
    for (int r = 0; r < 16; ++r) ps += p1[r];
    { auto rr = __builtin_amdgcn_permlane32_swap(__float_as_uint(ps), __float_as_uint(ps), false, false); ps = __uint_as_float(rr[0]) + __uint_as_float(rr[1]); }
    l_reg = l_reg * alpha + ps;
#define PK4(P, BASE, OUT) do { unsigned a0 = cvtpk(P[BASE + 0], P[BASE + 1]), a1 = cvtpk(P[BASE + 2], P[BASE + 3]);   \
    unsigned b0 = cvtpk(P[BASE + 4], P[BASE + 5]), b1 = cvtpk(P[BASE + 6], P[BASE + 7]);                              \
    u32x4 w = {a0, a1, b0, b1}; OUT = *reinterpret_cast<bf16x8*>(&w); } while (0)
    PK4(p0, 0, pa0); PK4(p0, 8, pa1); PK4(p1, 0, pa2); PK4(p1, 8, pa3);
#undef PK4
}
__device__ __forceinline__ void qkt(f32x16& p0, f32x16& p1, const char* Ks, const bf16x8* qr, int r32, int hi, float negm) {
#pragma unroll
    for (int r = 0; r < 16; ++r) { p0[r] = negm; p1[r] = negm; }
#pragma unroll
    for (int d0 = 0; d0 < 4; ++d0) { const int cb = (d0 * 16 + hi * 8) * 2;
        bf16x8 b0 = *reinterpret_cast<const bf16x8*>(Ks + KSWZ64(r32, cb));
        bf16x8 b1 = *reinterpret_cast<const bf16x8*>(Ks + KSWZ64(32 + r32, cb));
        p0 = __builtin_amdgcn_mfma_f32_32x32x16_bf16(b0, qr[d0], p0, 0, 0, 0);
        p1 = __builtin_amdgcn_mfma_f32_32x32x16_bf16(b1, qr[d0], p1, 0, 0, 0); }
}
__device__ __forceinline__ int v_st(int k, int c) { const int kk = k; return ((kk >> 3) * 4 + (c >> 5)) * 512 + ((kk & 7) * 32 + (c & 31)) * 2; }
__device__ __forceinline__ int v_rd_base(int lane) { return ((lane & 3) << 3) | (((lane >> 2) & 3) << 6) | (((lane >> 4) & 1) << 5) | (((lane >> 5) & 1) << 8); }
constexpr int v_rd_off(int d0, int ks, int half) { return d0 * 512 + ks * 4096 + half * 2048; }
template <int OFF> __device__ __forceinline__ s16x4 tr_read(int vb) { s16x4 r; asm volatile("ds_read_b64_tr_b16 %0, %1 offset:%2" : "=&v"(r) : "v"(vb), "i"(OFF) : "memory"); return r; }
struct VFrag { s16x4 l0, h0, l1, h1, l2, h2, l3, h3; };
template <int D0> __device__ __forceinline__ void pv_read(VFrag& f, int vb) {
    f.l0 = tr_read<v_rd_off(D0, 0, 0)>(vb); f.h0 = tr_read<v_rd_off(D0, 0, 1)>(vb); f.l1 = tr_read<v_rd_off(D0, 1, 0)>(vb); f.h1 = tr_read<v_rd_off(D0, 1, 1)>(vb);
    f.l2 = tr_read<v_rd_off(D0, 2, 0)>(vb); f.h2 = tr_read<v_rd_off(D0, 2, 1)>(vb); f.l3 = tr_read<v_rd_off(D0, 3, 0)>(vb); f.h3 = tr_read<v_rd_off(D0, 3, 1)>(vb);
}
__device__ __forceinline__ void pv_mma(f32x16& od, const VFrag& f, bf16x8 pa0, bf16x8 pa1, bf16x8 pa2, bf16x8 pa3) {
#define PK(L, H) (bf16x8){L[0], L[1], L[2], L[3], H[0], H[1], H[2], H[3]}
    od = __builtin_amdgcn_mfma_f32_32x32x16_bf16(pa0, PK(f.l0, f.h0), od, 0, 0, 0);
    od = __builtin_amdgcn_mfma_f32_32x32x16_bf16(pa1, PK(f.l1, f.h1), od, 0, 0, 0);
    od = __builtin_amdgcn_mfma_f32_32x32x16_bf16(pa2, PK(f.l2, f.h2), od, 0, 0, 0);
    od = __builtin_amdgcn_mfma_f32_32x32x16_bf16(pa3, PK(f.l3, f.h3), od, 0, 0, 0);
#undef PK
}
#define SGB_MFMA_VALU(nv) do { __builtin_amdgcn_sched_group_barrier(0x008, 1, 0); __builtin_amdgcn_sched_group_barrier(0x002, nv, 0); } while (0)
__device__ __forceinline__ void pv_sm(f32x16* o, int vb, bf16x8 pa0, bf16x8 pa1, bf16x8 pa2, bf16x8 pa3, f32x16& p0, f32x16& p1, float& m_reg, float& alpha, float& ps) {
    VFrag fa, fb;
#define PV_WAIT() do { asm volatile("s_waitcnt lgkmcnt(0)" ::: "memory"); SBAR(); } while (0)
    pv_read<0>(fa, vb); PV_WAIT();
    pv_read<1>(fb, vb); pv_mma(o[0], fa, pa0, pa1, pa2, pa3);
    float mx = fmaxf(fmaxf(p0[0], p0[1]), p0[2]);
#pragma unroll
    for (int r = 3; r < 15; r += 2) mx = fmaxf(fmaxf(mx, p0[r]), p0[r + 1]);
    mx = fmaxf(mx, p0[15]);
#pragma unroll
    for (int r = 0; r < 8; ++r) p0[r] = __builtin_amdgcn_exp2f(p0[r]);
    SGB_MFMA_VALU(4); SGB_MFMA_VALU(4); SGB_MFMA_VALU(4); SGB_MFMA_VALU(4);
    PV_WAIT();
    pv_read<2>(fa, vb); pv_mma(o[1], fb, pa0, pa1, pa2, pa3);
#pragma unroll
    for (int r = 0; r < 16; r += 2) mx = fmaxf(fmaxf(mx, p1[r]), p1[r + 1]);
    { auto rr = __builtin_amdgcn_permlane32_swap(__float_as_uint(mx), __float_as_uint(mx), false, false); mx = fmaxf(__uint_as_float(rr[0]), __uint_as_float(rr[1])); }
    const float d = mx > THR2 ? mx : 0.f;
    alpha = __builtin_amdgcn_exp2f(-d); m_reg += d;
#pragma unroll
    for (int r = 8; r < 16; ++r) p0[r] = __builtin_amdgcn_exp2f(p0[r]);
    SGB_MFMA_VALU(5); SGB_MFMA_VALU(5); SGB_MFMA_VALU(5); SGB_MFMA_VALU(5);
    PV_WAIT();
    pv_read<3>(fb, vb); pv_mma(o[2], fa, pa0, pa1, pa2, pa3);
#pragma unroll
    for (int r = 0; r < 8; ++r) p1[r] = __builtin_amdgcn_exp2f(p1[r]);
    float s0 = (p0[0] + p0[1]) + (p0[2] + p0[3]), s1 = (p0[4] + p0[5]) + (p0[6] + p0[7]), s2 = (p0[8] + p0[9]) + (p0[10] + p0[11]), s3 = (p0[12] + p0[13]) + (p0[14] + p0[15]);
    SGB_MFMA_VALU(5); SGB_MFMA_VALU(5); SGB_MFMA_VALU(5); SGB_MFMA_VALU(5);
    PV_WAIT();
    pv_mma(o[3], fb, pa0, pa1, pa2, pa3);
#pragma unroll
    for (int r = 8; r < 16; ++r) p1[r] = __builtin_amdgcn_exp2f(p1[r]);
    s0 += (p1[0] + p1[1]) + (p1[2] + p1[3]); s1 += (p1[4] + p1[5]) + (p1[6] + p1[7]); s2 += (p1[8] + p1[9]) + (p1[10] + p1[11]); s3 += (p1[12] + p1[13]) + (p1[14] + p1[15]);
    ps = (s0 + s1) + (s2 + s3);
    SGB_MFMA_VALU(6); SGB_MFMA_VALU(6); SGB_MFMA_VALU(6); SGB_MFMA_VALU(6);
    SBAR();
    if (__builtin_expect(__any(d > 0.f), 0)) {
#pragma unroll
        for (int r = 0; r < 16; ++r) { p0[r] *= alpha; p1[r] *= alpha; }
        ps *= alpha;
    }
#undef PV_WAIT
}
__device__ __forceinline__ void finishSM2(const f32x16& p0, const f32x16& p1, float alpha, float ps, float& l_reg, bf16x8& pa0, bf16x8& pa1, bf16x8& pa2, bf16x8& pa3) {
    { auto rr = __builtin_amdgcn_permlane32_swap(__float_as_uint(ps), __float_as_uint(ps), false, false); ps = __uint_as_float(rr[0]) + __uint_as_float(rr[1]); }
    l_reg = l_reg * alpha + ps;
#define PK4(P, BASE, OUT) do { unsigned a0 = cvtpk(P[BASE + 0], P[BASE + 1]), a1 = cvtpk(P[BASE + 2], P[BASE + 3]);   \
    unsigned b0 = cvtpk(P[BASE + 4], P[BASE + 5]), b1 = cvtpk(P[BASE + 6], P[BASE + 7]);                              \
    u32x4 w = {a0, a1, b0, b1}; OUT = *reinterpret_cast<bf16x8*>(&w); } while (0)
    PK4(p0, 0, pa0); PK4(p0, 8, pa1); PK4(p1, 0, pa2); PK4(p1, 8, pa3);
#undef PK4
}
__device__ __forceinline__ void attn_body(const bf16_t* __restrict__ Qb, const bf16_t* __restrict__ Kh, const bf16_t* __restrict__ Vh, float* __restrict__ Ob, int seq, char* lds) {
    const int tid = ptid(), wid = tid >> 6, lane = tid & 63, r32 = lane & 31, hi = lane >> 5;
    char* V_lds = lds; char* K_lds = lds + 3 * SHM_V;
    float* ws = (float*)(lds + 3 * SHM_V + 3 * SHM_K) + wid * 64; float* li_l = ws; float* al_l = ws + 32;
    float m_reg = 0.f, l_reg = 0; f32x16 o[4] = {}; bf16x8 qr[4];
    const bf16_t* Qw = Qb + (long)(wid * QBLK + r32) * LDQ + hi * 8;
#pragma unroll
    for (int d0 = 0; d0 < 4; ++d0) qr[d0] = *reinterpret_cast<const bf16x8*>(Qw + d0 * 16);
    const int sr = tid >> 4, sc = (tid & 15) * 8, vst0 = v_st(sr, sc), vst1 = v_st(32 + sr, sc);
    const int kr = tid >> 3, kc = (tid & 7) * 8, kst = KSWZ64(kr, kc * 2);
    const unsigned gvo0 = (unsigned)(sr * LDQ + sc) * 2u, gvo1 = (unsigned)((32 + sr) * LDQ + sc) * 2u, gko = (unsigned)(kr * LDQ + kc) * 2u;
    const int vb0 = (int)(uintptr_t)V_lds + v_rd_base(lane);
    struct { bf16x8 vs0, vs1, ks0; } sr_[2];
#define SLOAD(i, k0) do { const char* vb_ = (const char*)Vh + (size_t)(k0) * (LDQ * 2); const char* kb_ = (const char*)Kh + (size_t)(k0) * (LDQ * 2);     \
    sr_[i].vs0 = *reinterpret_cast<const bf16x8*>(vb_ + gvo0); sr_[i].vs1 = *reinterpret_cast<const bf16x8*>(vb_ + gvo1); sr_[i].ks0 = *reinterpret_cast<const bf16x8*>(kb_ + gko); } while (0)
#define SWRITE(b, i) do { *(bf16x8*)(V_lds + (b) * SHM_V + vst0) = sr_[i].vs0; *(bf16x8*)(V_lds + (b) * SHM_V + vst1) = sr_[i].vs1; *(bf16x8*)(K_lds + (b) * SHM_K + kst) = sr_[i].ks0; } while (0)
#define SWAIT() asm volatile("s_waitcnt vmcnt(3)" ::: "memory")
#define RESC(a) do { if (__any((a) < 1.f)) { if (hi == 0) al_l[r32] = (a); asm volatile("s_waitcnt lgkmcnt(0)" ::: "memory"); \
    _Pragma("unroll") for (int d = 0; d < 4; ++d) _Pragma("unroll") for (int r = 0; r < 16; ++r) o[d][r] *= al_l[crow(r, hi)]; } } while (0)
    f32x16 pA0, pA1, pB0, pB1; float alA, alB, psA = 0.f, psB = 0.f; bf16x8 pa0, pa1, pa2, pa3; const int NT = seq / KVBLK;
    constexpr int SE = 0, SO = 1;
    SLOAD(SE, 0); asm volatile("s_waitcnt vmcnt(0)" ::: "memory"); SWRITE(0, SE); __syncthreads();
    qkt(pA0, pA1, K_lds, qr, r32, hi, -m_reg); partialSM(pA0, pA1, m_reg, alA);
    SLOAD(SO, KVBLK); if (2 < NT) SLOAD(SE, 2 * KVBLK);
    SWAIT(); SWRITE(1, SO); RESC(alA); __syncthreads();
    int bc = 1, bn = 2, bp = 0;
#define ASTEP(j_, PX0, PX1, ALX, PSX, PY0, PY1, ALY, PSY, SLD, SWR, FIRST) do { \
        SBAR(); qkt(PX0, PX1, K_lds + bc * SHM_K, qr, r32, hi, -m_reg); \
        if (FIRST) finishSM(PY0, PY1, ALY, l_reg, pa0, pa1, pa2, pa3); else finishSM2(PY0, PY1, ALY, PSY, l_reg, pa0, pa1, pa2, pa3); SBAR(); \
        if ((j_) + 2 < NT) SLOAD(SLD, ((j_) + 2) * KVBLK); SBAR(); \
        pv_sm(o, vb0 + bp * SHM_V, pa0, pa1, pa2, pa3, PX0, PX1, m_reg, ALX, PSX); \
        SWAIT(); if ((j_) + 1 < NT) SWRITE(bn, SWR); \
        RESC(ALX); __syncthreads(); \
        { const int t_ = bc; bc = bn; bn = bp; bp = t_; } } while (0)
    ASTEP(1, pB0, pB1, alB, psB, pA0, pA1, alA, psA, SO, SE, true);
    for (int j = 2; j + 1 < NT; j += 2) {
        ASTEP(j, pA0, pA1, alA, psA, pB0, pB1, alB, psB, SE, SO, false);
        ASTEP(j + 1, pB0, pB1, alB, psB, pA0, pA1, alA, psA, SO, SE, false);
    }
#undef ASTEP
    finishSM2(pB0, pB1, alB, psB, l_reg, pa0, pa1, pa2, pa3); SBAR();
    { VFrag f0; pv_read<0>(f0, vb0 + bp * SHM_V); asm volatile("s_waitcnt lgkmcnt(0)" ::: "memory"); SBAR(); pv_mma(o[0], f0, pa0, pa1, pa2, pa3);
      pv_read<1>(f0, vb0 + bp * SHM_V); asm volatile("s_waitcnt lgkmcnt(0)" ::: "memory"); SBAR(); pv_mma(o[1], f0, pa0, pa1, pa2, pa3);
      pv_read<2>(f0, vb0 + bp * SHM_V); asm volatile("s_waitcnt lgkmcnt(0)" ::: "memory"); SBAR(); pv_mma(o[2], f0, pa0, pa1, pa2, pa3);
      pv_read<3>(f0, vb0 + bp * SHM_V); asm volatile("s_waitcnt lgkmcnt(0)" ::: "memory"); SBAR(); pv_mma(o[3], f0, pa0, pa1, pa2, pa3); }
    if (hi == 0) li_l[r32] = l_reg; asm volatile("s_waitcnt lgkmcnt(0)" ::: "memory");
    float rli[16];
#pragma unroll
    for (int r = 0; r < 16; ++r) rli[r] = __builtin_amdgcn_rcpf(li_l[crow(r, hi)]);
    float* Ow = Ob + (long)(wid * QBLK) * LDO;
#pragma unroll
    for (int r = 0; r < 16; ++r) { const int orow = crow(r, hi);
#pragma unroll
        for (int d0 = 0; d0 < 4; ++d0) Ow[(long)orow * LDO + d0 * 32 + r32] = o[d0][r] * rli[r]; }
    __syncthreads();
#undef SLOAD
#undef SWRITE
#undef SWAIT
#undef RESC
}


__device__ __forceinline__ void qkt0(f32x16& p0, f32x16& p1, const char* Ks, const bf16x8* qr, int r32, int hi) {
    p0 = f32x16{}; p1 = f32x16{};
#pragma unroll
    for (int d0 = 0; d0 < 4; ++d0) { const int cb = (d0 * 16 + hi * 8) * 2;
        bf16x8 b0 = *reinterpret_cast<const bf16x8*>(Ks + KSWZ64(r32, cb));
        bf16x8 b1 = *reinterpret_cast<const bf16x8*>(Ks + KSWZ64(32 + r32, cb));
        p0 = __builtin_amdgcn_mfma_f32_32x32x16_bf16(b0, qr[d0], p0, 0, 0, 0);
        p1 = __builtin_amdgcn_mfma_f32_32x32x16_bf16(b1, qr[d0], p1, 0, 0, 0); }
}
struct VFragT { bf16x8 f[4]; };
template <int D0> __device__ __forceinline__ void pv_readT(VFragT& f, const char* vbp) {
#pragma unroll
    for (int ks = 0; ks < 4; ++ks) f.f[ks] = *reinterpret_cast<const bf16x8*>(vbp + D0 * 32 * VPITCH + ks * 32);
}
__device__ __forceinline__ void pv_mmaT(f32x16& od, const VFragT& f, bf16x8 pa0, bf16x8 pa1, bf16x8 pa2, bf16x8 pa3) {
    od = __builtin_amdgcn_mfma_f32_32x32x16_bf16(pa0, f.f[0], od, 0, 0, 0);
    od = __builtin_amdgcn_mfma_f32_32x32x16_bf16(pa1, f.f[1], od, 0, 0, 0);
    od = __builtin_amdgcn_mfma_f32_32x32x16_bf16(pa2, f.f[2], od, 0, 0, 0);
    od = __builtin_amdgcn_mfma_f32_32x32x16_bf16(pa3, f.f[3], od, 0, 0, 0);
}
__device__ __forceinline__ void pack_p(const f32x16& p0, const f32x16& p1, bf16x8& pa0, bf16x8& pa1, bf16x8& pa2, bf16x8& pa3) {
#define PK4(P, BASE, OUT) do { unsigned a0 = cvtpk(P[BASE + 0], P[BASE + 1]), a1 = cvtpk(P[BASE + 2], P[BASE + 3]);   \
    unsigned b0 = cvtpk(P[BASE + 4], P[BASE + 5]), b1 = cvtpk(P[BASE + 6], P[BASE + 7]);                              \
    u32x4 w = {a0, a1, b0, b1}; OUT = *reinterpret_cast<bf16x8*>(&w); } while (0)
    PK4(p0, 0, pa0); PK4(p0, 8, pa1); PK4(p1, 0, pa2); PK4(p1, 8, pa3);
#undef PK4
}
__device__ __forceinline__ void pv_exp(f32x16* o, const char* vb, VFragT& fa, bf16x8 pa0, bf16x8 pa1, bf16x8 pa2, bf16x8 pa3, f32x16& p0, f32x16& p1, float& lpart, const char* kpre, bf16x8 (&kf)[8], int r32, int hi) {
    VFragT fb;
#define PV_WAIT() do { asm volatile("s_waitcnt lgkmcnt(0)" ::: "memory"); SBAR(); } while (0)
    PV_WAIT();
    pv_readT<1>(fb, vb); pv_mmaT(o[0], fa, pa0, pa1, pa2, pa3);
#pragma unroll
    for (int r = 0; r < 8; ++r) p0[r] = __builtin_amdgcn_exp2f(p0[r]);
    SGB_MFMA_VALU(2); SGB_MFMA_VALU(2); SGB_MFMA_VALU(2); SGB_MFMA_VALU(2);
    PV_WAIT();
    pv_readT<2>(fa, vb); pv_mmaT(o[1], fb, pa0, pa1, pa2, pa3);
#pragma unroll
    for (int r = 8; r < 16; ++r) p0[r] = __builtin_amdgcn_exp2f(p0[r]);
    float s0 = (p0[0] + p0[1]) + (p0[2] + p0[3]), s1 = (p0[4] + p0[5]) + (p0[6] + p0[7]);
    SGB_MFMA_VALU(4); SGB_MFMA_VALU(4); SGB_MFMA_VALU(4); SGB_MFMA_VALU(4);
    PV_WAIT();
    pv_readT<3>(fb, vb); pv_mmaT(o[2], fa, pa0, pa1, pa2, pa3);
#pragma unroll
    for (int r = 0; r < 8; ++r) p1[r] = __builtin_amdgcn_exp2f(p1[r]);
    float s2 = (p0[8] + p0[9]) + (p0[10] + p0[11]), s3 = (p0[12] + p0[13]) + (p0[14] + p0[15]);
    SGB_MFMA_VALU(4); SGB_MFMA_VALU(4); SGB_MFMA_VALU(4); SGB_MFMA_VALU(4);
    PV_WAIT();
#pragma unroll
    for (int d0 = 0; d0 < 4; ++d0) { const int cb = (d0 * 16 + hi * 8) * 2; kf[2 * d0] = *reinterpret_cast<const bf16x8*>(kpre + KSWZ64(r32, cb)); kf[2 * d0 + 1] = *reinterpret_cast<const bf16x8*>(kpre + KSWZ64(32 + r32, cb)); }
    pv_mmaT(o[3], fb, pa0, pa1, pa2, pa3);
#pragma unroll
    for (int r = 8; r < 16; ++r) p1[r] = __builtin_amdgcn_exp2f(p1[r]);
    s0 += (p1[0] + p1[1]) + (p1[2] + p1[3]); s1 += (p1[4] + p1[5]) + (p1[6] + p1[7]); s2 += (p1[8] + p1[9]) + (p1[10] + p1[11]); s3 += (p1[12] + p1[13]) + (p1[14] + p1[15]);
    lpart += (s0 + s1) + (s2 + s3);
    SGB_MFMA_VALU(6); SGB_MFMA_VALU(6); SGB_MFMA_VALU(6); SGB_MFMA_VALU(6);
    SBAR();
#undef PV_WAIT
}
struct FuseArgs { float lam, gs; const float* sub; bf16_t* A2b; unsigned* o0g; };
template <int MODE>
__device__ __forceinline__ void attn_body_fast(const bf16_t* __restrict__ Qb, const bf16_t* __restrict__ Kh, const bf16_t* __restrict__ Vh, float* __restrict__ Ob, int seq, char* lds, const FuseArgs fa_) {
    const int tid = ptid(), wid = __builtin_amdgcn_readfirstlane(tid >> 6), lane = tid & 63, r32 = lane & 31, hi = lane >> 5;
    char* V_lds = lds; char* K_lds = lds + 3 * SHM_V;
    float* ws = (float*)(lds + 3 * SHM_V + 3 * SHM_K) + wid * 64; float* li_l = ws;
    volatile int* badflag = (volatile int*)(lds + 3 * SHM_V + 3 * SHM_K + NW * 64 * 4);
    float lpart = 0.f; f32x16 o[4] = {}; bf16x8 qr[4];
    const bf16_t* Qw = Qb + (long)(wid * QBLK + r32) * LDQ + hi * 8;
#pragma unroll
    for (int d0 = 0; d0 < 4; ++d0) qr[d0] = *reinterpret_cast<const bf16x8*>(Qw + d0 * 16);
    const int vd = tid >> 2, vc = (tid & 3) * 2, vstT = vd * VPITCH + vc * 16;
    const int kr = tid >> 3, kc = (tid & 7) * 8, krs = (kr & ~0xC) | ((kr & 4) << 1) | ((kr & 8) >> 1), kst = KSWZ64(krs, kc * 2);
    const unsigned gvo = (unsigned)(vd * R + vc * 8) * 2u, gko = (unsigned)(kr * LDQ + kc) * 2u;
    const char* vb0 = V_lds + r32 * VPITCH + hi * 16;
    struct { bf16x8 vs0, vs1, ks0; } sr_[2];
#define TCL(t_) ((t_) < NT ? (t_) : NT - 1)
#define SLOAD(i, t_) do { const char* vb_ = (const char*)Vh + (size_t)(TCL(t_) * KVBLK) * 2; const char* kb_ = (const char*)Kh + (size_t)(TCL((t_) + 1) * KVBLK) * (LDQ * 2);     \
    sr_[i].vs0 = *reinterpret_cast<const bf16x8*>(vb_ + gvo); sr_[i].vs1 = *reinterpret_cast<const bf16x8*>(vb_ + gvo + 16); sr_[i].ks0 = *reinterpret_cast<const bf16x8*>(kb_ + gko); } while (0)
#define SWRITE(bv, bk, i) do { *(bf16x8*)(V_lds + (bv) * SHM_V + vstT) = sr_[i].vs0; *(bf16x8*)(V_lds + (bv) * SHM_V + vstT + 16) = sr_[i].vs1; *(bf16x8*)(K_lds + (bk) * SHM_K + kst) = sr_[i].ks0; } while (0)
#define SWAIT() asm volatile("s_waitcnt vmcnt(3)" ::: "memory")
    f32x16 pA0, pA1, pB0, pB1; bf16x8 pa0, pa1, pa2, pa3; const int NT = seq / KVBLK;
    constexpr int SE = 0, SO = 1;
    if (MODE == 0 && tid == 0) *badflag = 0;
    bf16x8 kf[8];
    {
        const bf16x8 k0r = *reinterpret_cast<const bf16x8*>((const char*)Kh + gko);
        SLOAD(SE, 0); asm volatile("s_waitcnt vmcnt(0)" ::: "memory");
        *(bf16x8*)(K_lds + kst) = k0r; SWRITE(0, 1, SE); __syncthreads();
    }
    qkt0(pA0, pA1, K_lds, qr, r32, hi);
#pragma unroll
    for (int r = 0; r < 16; ++r) { pA0[r] = __builtin_amdgcn_exp2f(pA0[r]); pA1[r] = __builtin_amdgcn_exp2f(pA1[r]); lpart += pA0[r] + pA1[r]; }
    SLOAD(SO, 1); SLOAD(SE, 2);
#pragma unroll
    for (int d0 = 0; d0 < 4; ++d0) { const int cb = (d0 * 16 + hi * 8) * 2; kf[2 * d0] = *reinterpret_cast<const bf16x8*>(K_lds + SHM_K + KSWZ64(r32, cb)); kf[2 * d0 + 1] = *reinterpret_cast<const bf16x8*>(K_lds + SHM_K + KSWZ64(32 + r32, cb)); }
    SWAIT(); SWRITE(1, 2, SO); __syncthreads();
    int bc = 1, bn = 2, bp = 0;
#define FSTEP(j_, PX0, PX1, PY0, PY1, SLD, SWR) do { \
        SBAR(); VFragT fa0_; pv_readT<0>(fa0_, vb0 + bp * SHM_V); \
        PX0 = f32x16{}; PX1 = f32x16{}; \
        _Pragma("unroll") for (int d0 = 0; d0 < 4; ++d0) { PX0 = __builtin_amdgcn_mfma_f32_32x32x16_bf16(kf[2 * d0], qr[d0], PX0, 0, 0, 0); PX1 = __builtin_amdgcn_mfma_f32_32x32x16_bf16(kf[2 * d0 + 1], qr[d0], PX1, 0, 0, 0); } \
        pack_p(PY0, PY1, pa0, pa1, pa2, pa3); SBAR(); \
        SLOAD(SLD, (j_) + 2); SBAR(); \
        pv_exp(o, vb0 + bp * SHM_V, fa0_, pa0, pa1, pa2, pa3, PX0, PX1, lpart, K_lds + bn * SHM_K, kf, r32, hi); \
        SWAIT(); SWRITE(bn, bp, SWR); \
        __syncthreads(); \
        { const int t_ = bc; bc = bn; bn = bp; bp = t_; } } while (0)
    for (int j = 1; j + 1 < NT; j += 2) {
        FSTEP(j, pB0, pB1, pA0, pA1, SO, SE);
        FSTEP(j + 1, pA0, pA1, pB0, pB1, SE, SO);
    }
    FSTEP(NT - 1, pB0, pB1, pA0, pA1, SO, SE);
#undef TCL
#undef FSTEP
    pack_p(pB0, pB1, pa0, pa1, pa2, pa3); SBAR();
    { VFragT f0; pv_readT<0>(f0, vb0 + bp * SHM_V); asm volatile("s_waitcnt lgkmcnt(0)" ::: "memory"); SBAR(); pv_mmaT(o[0], f0, pa0, pa1, pa2, pa3);
      pv_readT<1>(f0, vb0 + bp * SHM_V); asm volatile("s_waitcnt lgkmcnt(0)" ::: "memory"); SBAR(); pv_mmaT(o[1], f0, pa0, pa1, pa2, pa3);
      pv_readT<2>(f0, vb0 + bp * SHM_V); asm volatile("s_waitcnt lgkmcnt(0)" ::: "memory"); SBAR(); pv_mmaT(o[2], f0, pa0, pa1, pa2, pa3);
      pv_readT<3>(f0, vb0 + bp * SHM_V); asm volatile("s_waitcnt lgkmcnt(0)" ::: "memory"); SBAR(); pv_mmaT(o[3], f0, pa0, pa1, pa2, pa3); }
    float l_reg;
    { auto rr = __builtin_amdgcn_permlane32_swap(__float_as_uint(lpart), __float_as_uint(lpart), false, false); l_reg = __uint_as_float(rr[0]) + __uint_as_float(rr[1]); }
    const bool bad = !(l_reg > 1e-30f && l_reg < 1e30f);
    if (__any(bad) && lane == 0) *badflag = 1;
    if (hi == 0) li_l[r32] = l_reg; asm volatile("s_waitcnt lgkmcnt(0)" ::: "memory");
    float rli[16];
#pragma unroll
    for (int r = 0; r < 16; ++r) rli[r] = __builtin_amdgcn_rcpf(li_l[crow(r, hi)]);
    unsigned* O0 = fa_.o0g + (size_t)wid * 32 * 64 + lane;
    if (MODE == 0) {
        float* Ow = Ob + (long)(wid * QBLK) * LDO;
#pragma unroll
        for (int r = 0; r < 16; ++r) { const int orow = crow(r, hi);
#pragma unroll
            for (int d0 = 0; d0 < 4; ++d0) Ow[(long)orow * LDO + d0 * 32 + r32] = o[d0][r] * rli[r]; }
        __syncthreads();
        const int redo = *badflag;
        __syncthreads();
        if (redo) attn_body(Qb, Kh, Vh, Ob, seq, lds);
    } else if (MODE == 1) {
#pragma unroll
        for (int d0 = 0; d0 < 4; ++d0)
#pragma unroll
            for (int r = 0; r < 16; r += 2) O0[(d0 * 8 + (r >> 1)) * 64] = pk2(o[d0][r] * rli[r], o[d0][r + 1] * rli[r + 1]);
        __syncthreads();
    } else {
        float qq[16];
#pragma unroll
        for (int r = 0; r < 16; ++r) qq[r] = 0.f;
#pragma unroll
        for (int d0 = 0; d0 < 4; ++d0)
#pragma unroll
            for (int r = 0; r < 16; r += 2) {
                const unsigned w = O0[(d0 * 8 + (r >> 1)) * 64];
                o[d0][r] = bf2f(w & 0xffffu) - fa_.lam * (o[d0][r] * rli[r]); o[d0][r + 1] = bf2f(w >> 16) - fa_.lam * (o[d0][r + 1] * rli[r + 1]);
                qq[r] += o[d0][r] * o[d0][r]; qq[r + 1] += o[d0][r + 1] * o[d0][r + 1];
            }
#pragma unroll
        for (int r = 0; r < 16; ++r) {
            float v = qq[r];
            v += dppmov<0xB1>(v); v += dppmov<0x4E>(v); v += dppmov<0x141>(v); v += dppmov<0x140>(v); v += __shfl_xor(v, 16);
            qq[r] = rsqrtf(v * (1.f / 128.f) + 1e-5f);
        }
        float gg[4];
#pragma unroll
        for (int d0 = 0; d0 < 4; ++d0) gg[d0] = fa_.sub[d0 * 32 + r32] * fa_.gs;
        bf16_t* Aw = fa_.A2b + (size_t)(wid * QBLK) * 1024;
        __syncthreads();
        char* stg = lds + wid * (32 * 272);
#pragma unroll
        for (int r = 0; r < 16; ++r) { const int orow = crow(r, hi);
#pragma unroll
            for (int d0 = 0; d0 < 4; ++d0) *(bf16_t*)(stg + orow * 272 + (d0 * 32 + r32) * 2) = (bf16_t)f2bf(o[d0][r] * qq[r] * gg[d0]); }
#pragma unroll
        for (int i = 0; i < 8; ++i) { const int row = (lane >> 4) + 4 * i, ch = lane & 15;
            const u32x4 w = *(const u32x4*)(stg + row * 272 + ch * 16);
            *(u32x4*)(Aw + (size_t)row * 1024 + ch * 8) = w; }
        __syncthreads();
    }
#undef SLOAD
#undef SWRITE
#undef SWAIT
}
}

__device__ __forceinline__ void comb_rows(const Params& p, int j, float lam, float lam_init, int row_lo, int row_hi, int h) {
    const int lane = ptid() & 63, wv = ptid() >> 6;
    const float* O = (const float*)(p.ws + WS_O); bf16_t* A2 = (bf16_t*)(p.ws + WS_A2); const float* sub = p.in[10] + j * 128;
    for (int row = row_lo + wv; row < row_hi; row += 8) {
        const float* o0 = O + (size_t)row * 2048 + h * 256 + lane * 2;
        const float d0 = o0[0] - lam * o0[128], d1 = o0[1] - lam * o0[129];
        const float rs = rsqrtf(wave_sum(d0 * d0 + d1 * d1) * (1.f / 128.f) + 1e-5f);
        *(unsigned*)(A2 + (size_t)row * 1024 + h * 128 + lane * 2) = pk2(d0 * rs * sub[lane * 2] * (1.f - lam_init), d1 * rs * sub[lane * 2 + 1] * (1.f - lam_init));
    }
}
__device__ __forceinline__ void phase_attn_fused(const Params& p, int j, float lam_init, int with_ctx, char* lds) {
    const bf16_t* QKV = (const bf16_t*)(p.ws + WS_QKV); float* O = (float*)(p.ws + WS_O); bf16_t* A2 = (bf16_t*)(p.ws + WS_A2);
    const int lane = ptid() & 63;
    const float* lp = p.in[9] + j * 256;
    const float lam = expf(wave_sum(lp[lane] * lp[64 + lane])) - expf(wave_sum(lp[128 + lane] * lp[192 + lane])) + lam_init;
    volatile int* badflag = (volatile int*)(lds + 3 * att::SHM_V + 3 * att::SHM_K + att::NW * 64 * 4);
    const int nlat = 64 * 8, nU = nlat + (with_ctx ? 8 : 0);
    for (int u = blockIdx.x; u < nU; u += gridDim.x) {
        int head, row0, nkeys;
        if (u < nlat) { const int k = u >> 8, b = u & 255, xcd = b & 7, idx = b >> 3; head = 4 * k + (xcd >> 1); row0 = RC + ((xcd & 1) * 32 + idx) * 256; nkeys = R; }
        else { head = u - nlat; row0 = 0; nkeys = RC; }
        if (ptid() == 0) *badflag = 0;
        const att::FuseArgs fa{lam, 1.f - lam_init, p.in[10] + j * 128, A2 + (size_t)row0 * 1024 + head * 128, (unsigned*)(p.ws + WS_O0) + (size_t)blockIdx.x * 16384};
        const bf16_t* VTh = (const bf16_t*)(p.ws + WS_VT) + (size_t)head * 128 * R;
        const bf16_t* Qb = QKV + (size_t)row0 * 3072 + head * 128; const bf16_t* Kb = QKV + 1024 + head * 128; const bf16_t* Vb = QKV + 2048 + head * 128;
        att::attn_body_fast<1>(Qb, Kb, VTh, nullptr, nkeys, lds, fa);
        att::attn_body_fast<2>(Qb + 64, Kb + 64, VTh, nullptr, nkeys, lds, fa);
        const int redo = *badflag;
        __syncthreads();
        if (redo) {
            att::attn_body(Qb, Kb, Vb, O + (size_t)row0 * 2048 + head * 256, nkeys, lds);
            att::attn_body(Qb + 64, Kb + 64, Vb, O + (size_t)row0 * 2048 + head * 256 + 128, nkeys, lds);
            asm volatile("s_waitcnt vmcnt(0)" ::: "memory"); __syncthreads();
            comb_rows(p, j, lam, lam_init, row0, row0 + 256, head);
            __syncthreads();
        }
    }
}

__device__ __forceinline__ void phase_lnv(const Params& p) {
    const int lane = ptid() & 63, wv = ptid() >> 6;
    const bf16_t* VP = (const bf16_t*)(p.ws + WS_VP); bf16_t* VN = (bf16_t*)(p.ws + WS_VN);
    const float* lg = p.in[13]; const float* lb = p.in[14];
    const int rstep = gridDim.x * 8;
    f32x4 lgv[4], lbv[4];
#pragma unroll
    for (int j = 0; j < 4; ++j) { lgv[j] = *(const f32x4*)(lg + j * 256 + lane * 4); lbv[j] = *(const f32x4*)(lb + j * 256 + lane * 4); }
    u32x2 xr[4];
    { const int r0 = blockIdx.x * 8 + wv;
#pragma unroll
      for (int j = 0; j < 4; ++j) xr[j] = *(const u32x2*)(VP + (size_t)(r0 < R ? r0 : R - 1) * 1024 + j * 256 + lane * 4); }
    for (int row = blockIdx.x * 8 + wv; row < R; row += rstep) {
        f32x4 x[4]; float s = 0.f;
#pragma unroll
        for (int j = 0; j < 4; ++j) { x[j][0] = bf2f(xr[j][0]); x[j][1] = __uint_as_float(xr[j][0] & 0xffff0000u); x[j][2] = bf2f(xr[j][1]); x[j][3] = __uint_as_float(xr[j][1] & 0xffff0000u); s += x[j][0] + x[j][1] + x[j][2] + x[j][3]; }
        { const int rn = row + rstep < R ? row + rstep : R - 1;
#pragma unroll
          for (int j = 0; j < 4; ++j) xr[j] = *(const u32x2*)(VP + (size_t)rn * 1024 + j * 256 + lane * 4); }
        const float mean = wave_sum(s) * (1.f / 1024.f);
        float q = 0.f;
#pragma unroll
        for (int j = 0; j < 4; ++j) { x[j] = x[j] - mean; q += x[j][0] * x[j][0] + x[j][1] * x[j][1] + x[j][2] * x[j][2] + x[j][3] * x[j][3]; }
        const float rs = rsqrtf(wave_sum(q) * (1.f / 1024.f) + 1e-5f);
#pragma unroll
        for (int j = 0; j < 4; ++j) {
            const int col = j * 256 + lane * 4;
            const f32x4 h = x[j] * rs * lgv[j] + lbv[j];
            u32x2 w = {pk2(h[0], h[1]), pk2(h[2], h[3])};
            *(u32x2*)(VN + (size_t)row * 1024 + col) = w;
        }
    }
}


__device__ __forceinline__ void phase_spat(const Params& p, char* smem) {
    typedef short bf16x8_ __attribute__((ext_vector_type(8)));
    constexpr int LDS_ = 136;
    const int tid = ptid(), lane = tid & 63, wv = __builtin_amdgcn_readfirstlane(tid >> 6), fr = lane & 15, fq = lane >> 4;
    const bf16_t* VN = (const bf16_t*)(p.ws + WS_VN); const bf16_t* U = (const bf16_t*)(p.ws + WS_U); bf16_t* A2 = (bf16_t*)(p.ws + WS_A2);
    const bf16_t* WSb = (const bf16_t*)(p.ws + WS_WSPAT); const float* bs = p.in[16];
    bf16_t* Wl = (bf16_t*)smem; bf16_t* VT = (bf16_t*)(smem + 128 * LDS_ * 2);
    const int m0 = 32 * (wv >> 1), n0 = 64 * (wv & 1);
    for (int u = blockIdx.x; u < 130 * 8; u += gridDim.x) {
        const int c = u >> 3, g = u & 7;
        __syncthreads();
#pragma unroll
        for (int i = 0; i < 4; ++i) {
            const int idx = tid + 512 * i, rr = idx >> 4, c8 = (idx & 15) * 8;
            *(u32x4*)(Wl + rr * LDS_ + c8) = *(const u32x4*)(WSb + (size_t)g * 16384 + rr * 128 + c8);
            const u32x4 raw = *(const u32x4*)(VN + (size_t)(c * 128 + rr) * 1024 + g * 128 + c8);
#pragma unroll
            for (int e = 0; e < 4; ++e) { VT[(c8 + 2 * e) * LDS_ + rr] = (bf16_t)(raw[e] & 0xffffu); VT[(c8 + 2 * e + 1) * LDS_ + rr] = (bf16_t)(raw[e] >> 16); }
        }
        __syncthreads();
        f32x4 acc[2][4];
#pragma unroll
        for (int a = 0; a < 2; ++a)
#pragma unroll
            for (int t = 0; t < 4; ++t) acc[a][t] = (f32x4){0.f, 0.f, 0.f, 0.f};
#pragma unroll
        for (int ks = 0; ks < 4; ++ks) {
            bf16x8_ af[2];
#pragma unroll
            for (int a = 0; a < 2; ++a) af[a] = *(const bf16x8_*)(Wl + (m0 + 16 * a + fr) * LDS_ + ks * 32 + fq * 8);
#pragma unroll
            for (int t = 0; t < 4; ++t) { const bf16x8_ bq = *(const bf16x8_*)(VT + (n0 + 16 * t + fr) * LDS_ + ks * 32 + fq * 8);
#pragma unroll
                for (int a = 0; a < 2; ++a) acc[a][t] = __builtin_amdgcn_mfma_f32_16x16x32_bf16(bq, af[a], acc[a][t], 0, 0, 0); }
        }
#pragma unroll
        for (int a = 0; a < 2; ++a) {
            const int pp = m0 + 16 * a + fr; const float bias = bs[g * 128 + pp];
#pragma unroll
            for (int t = 0; t < 4; ++t) {
                const size_t off = (size_t)(c * 128 + pp) * 1024 + g * 128 + n0 + 16 * t + 4 * fq;
                const u32x2 uu = *(const u32x2*)(U + off);
                u32x2 w = {pk2(bf2f(uu[0] & 0xffffu) * (acc[a][t][0] + bias), bf2f(uu[0] >> 16) * (acc[a][t][1] + bias)), pk2(bf2f(uu[1] & 0xffffu) * (acc[a][t][2] + bias), bf2f(uu[1] >> 16) * (acc[a][t][3] + bias))};
                *(u32x2*)(A2 + off) = w;
            }
        }
    }
    __syncthreads();
}

__device__ __forceinline__ void phase_mix(const Params& p) {
    const int lane = ptid() & 63, wv = ptid() >> 6;
    const bf16_t* H = (const bf16_t*)(p.ws + WS_H); bf16_t* MX = (bf16_t*)(p.ws + WS_MIX);
    const float* mix = p.in[18];
    f32x4 mqv[4][6];
#pragma unroll
    for (int j = 0; j < 4; ++j)
#pragma unroll
        for (int q = 0; q < 6; ++q) mqv[j][q] = *(const f32x4*)(mix + q * 1024 + j * 256 + lane * 4);
    for (int row = blockIdx.x * 8 + wv; row < R; row += gridDim.x * 8) {
        const bool hp = (row != 0 && row != RC), hn = (row != RC - 1 && row != R - 1);
#pragma unroll
        for (int j = 0; j < 4; ++j) {
            const int col = j * 256 + lane * 4;
            const u32x2 c = *(const u32x2*)(H + (size_t)row * 1024 + col);
            u32x2 a = {0u, 0u}, b = {0u, 0u};
            if (hp) a = *(const u32x2*)(H + (size_t)(row - 1) * 1024 + col);
            if (hn) b = *(const u32x2*)(H + (size_t)(row + 1) * 1024 + col);
            float hc[4] = {bf2f(c[0] & 0xffffu), bf2f(c[0] >> 16), bf2f(c[1] & 0xffffu), bf2f(c[1] >> 16)};
            float ha[4] = {bf2f(a[0] & 0xffffu), bf2f(a[0] >> 16), bf2f(a[1] & 0xffffu), bf2f(a[1] >> 16)};
            float hb[4] = {bf2f(b[0] & 0xffffu), bf2f(b[0] >> 16), bf2f(b[1] & 0xffffu), bf2f(b[1] >> 16)};
            float ts[4];
#pragma unroll
            for (int e = 0; e < 4; ++e) ts[e] = 0.5f * (ha[e] + hb[e]) - hc[e];
#pragma unroll
            for (int q = 0; q < 6; ++q) {
                const f32x4 mq = mqv[j][q];
                u32x2 w = {pk2(hc[0] + ts[0] * mq[0], hc[1] + ts[1] * mq[1]), pk2(hc[2] + ts[2] * mq[2], hc[3] + ts[3] * mq[3])};
                *(u32x2*)(MX + ((size_t)q * R + row) * 1024 + col) = w;
            }
        }
    }
}

__device__ __forceinline__ void phase_kkn(const Params& p) {
    const int lane = ptid() & 63, wv = ptid() >> 6;
    const bf16_t* KK = (const bf16_t*)(p.ws + WS_KK); float* KN = (float*)(p.ws + WS_KN);
    const float* kk_ = p.in[28];
    for (int row = blockIdx.x * 8 + wv; row < R; row += gridDim.x * 8) {
        float ss = 0.f;
#pragma unroll
        for (int j = 0; j < 2; ++j) {
            const int col = lane * 16 + j * 8;
            const u32x4 raw = *(const u32x4*)(KK + (size_t)row * 1024 + col);
#pragma unroll
            for (int e = 0; e < 4; ++e) { const float a = bf2f(raw[e] & 0xffffu) * kk_[col + 2 * e], b = bf2f(raw[e] >> 16) * kk_[col + 2 * e + 1]; ss += a * a + b * b; }
        }
        ss += __shfl_xor(ss, 1); ss += __shfl_xor(ss, 2);
        if ((lane & 3) == 0) KN[(size_t)row * 16 + (lane >> 2)] = 1.f / fmaxf(sqrtf(ss), 1e-12f);
    }
}

__device__ __forceinline__ int scan_row(int z, int n) { return z == 0 ? n : (n < RC ? RC - 1 - n : R + RC - 1 - n); }

namespace ck {
using bf16x8 = __attribute__((ext_vector_type(8))) short;
constexpr int LD = 72, MBUF = 64 * LD * 2;
constexpr int NCH = 260;
constexpr int NUH = 2 * 16 * NCH;
constexpr size_t WS_CK1 = 649 * MiB;
constexpr size_t WS_CK2 = WS_S + 412 * MiB;
constexpr size_t WS_CK3 = WS_S + 65 * MiB;
constexpr size_t WS_CKS = 780 * MiB;
typedef __bf16 bf16x2n __attribute__((ext_vector_type(2))); typedef float f32x2n __attribute__((ext_vector_type(2)));
__device__ __forceinline__ unsigned cvt2(float lo, float hi) { const f32x2n v = {lo, hi}; const bf16x2n b = __builtin_convertvector(v, bf16x2n); return __builtin_bit_cast(unsigned, b); }
__device__ __forceinline__ bf16_t* slot(char* smem, int i) { return (bf16_t*)(smem + i * MBUF); }
__device__ __forceinline__ void mm_lds(const bf16_t* A, const bf16_t* B, f32x4 (&acc)[2], int m0, int n0, int fr, int fq) {
#pragma unroll
    for (int ks = 0; ks < 2; ++ks) {
        const bf16x8 af = *(const bf16x8*)(A + (m0 + fr) * LD + ks * 32 + fq * 8);
#pragma unroll
        for (int t = 0; t < 2; ++t) {
            const bf16x8 bfr = *(const bf16x8*)(B + (n0 + 16 * t + fr) * LD + ks * 32 + fq * 8);
            acc[t] = __builtin_amdgcn_mfma_f32_16x16x32_bf16(bfr, af, acc[t], 0, 0, 0);
        }
    }
}
__device__ __forceinline__ void st_row(bf16_t* D, const f32x4 (&acc)[2], int m0, int n0, int fr, int fq) {
#pragma unroll
    for (int t = 0; t < 2; ++t) { u32x2 w = {pk2(acc[t][0], acc[t][1]), pk2(acc[t][2], acc[t][3])}; *(u32x2*)(D + (m0 + fr) * LD + n0 + 16 * t + 4 * fq) = w; }
}
__device__ __forceinline__ void st_tr(bf16_t* D, const f32x4 (&acc)[2], int m0, int n0, int fr, int fq) {
#pragma unroll
    for (int t = 0; t < 2; ++t)
#pragma unroll
        for (int r = 0; r < 4; ++r) D[(n0 + 16 * t + 4 * fq + r) * LD + m0 + fr] = (bf16_t)f2bf(acc[t][r]);
}
template <bool STRICT> __device__ __forceinline__ void mask_tri(f32x4 (&acc)[2], int m0, int n0, int fr, int fq) {
#pragma unroll
    for (int t = 0; t < 2; ++t)
#pragma unroll
        for (int r = 0; r < 4; ++r) { const int s_ = m0 + fr, t_ = n0 + 16 * t + 4 * fq + r; if (STRICT ? !(s_ < t_) : !(s_ <= t_)) acc[t][r] = 0.f; }
}
struct PrepRaw { float kn[8], kkc, kac; _Float16 w[8]; bf16_t k[8], ap[8], r[8], v[8]; };
template <bool FULL>
__device__ __forceinline__ void prep_load(const Params& p, int z, int head, int cg, PrepRaw& q) {
    const int tid = ptid(), j = tid & 63, tq = tid >> 6, col = head * 64 + j;
    const bf16_t* RRb = (const bf16_t*)(p.ws + WS_RR); const bf16_t* KKb = (const bf16_t*)(p.ws + WS_KK); const bf16_t* VVb = (const bf16_t*)(p.ws + WS_VV);
    const _Float16* DEC = (const _Float16*)(p.ws + WS_DEC); const bf16_t* AP = (const bf16_t*)(p.ws + WS_AP); const float* KN = (const float*)(p.ws + WS_KN);
    q.kkc = p.in[28][col]; q.kac = p.in[29][col];
    const _Float16* DECz = DEC + (size_t)z * R * 1024; const bf16_t* APz = AP + (size_t)z * R * 1024;
#pragma unroll
    for (int e = 0; e < 8; ++e) {
        const unsigned row = (unsigned)scan_row(z, cg * 64 + tq * 8 + e), off = row * 1024u + (unsigned)col, o2 = off * 2u, o4 = off * 4u;
#define LDB(T, base, boff) (*(const T*)((const char*)(base) + (boff)))
        q.k[e] = LDB(bf16_t, KKb, o2); q.ap[e] = LDB(bf16_t, APz, o2); q.kn[e] = LDB(float, KN, (row * 16u + (unsigned)head) * 4u); q.w[e] = LDB(_Float16, DECz, o2);
        if (FULL) { q.r[e] = LDB(bf16_t, RRb, o2); q.v[e] = LDB(bf16_t, VVb, o2); }
#undef LDB
    }
}
template <bool FULL>
__device__ __forceinline__ void prep_compute(const Params& p, char* smem, int head, const PrepRaw& q) {
    const int tid = ptid(), j = tid & 63, tq = tid >> 6, col = head * 64 + j;
    float* G = (float*)(smem + 14 * MBUF); float* WE = G + 512;
    const float kkc = q.kkc, kac = q.kac;
    float w[8], a[8], b[8], kd[8], r[8], vv[8];
#pragma unroll
    for (int e = 0; e < 8; ++e) {
        const float kraw = bf2f(q.k[e]), ap = bf2f(q.ap[e]);
        const float kkv = kraw * kkc * q.kn[e];
        w[e] = (float)q.w[e]; a[e] = -kkv; b[e] = kkv * ap; kd[e] = kraw * (1.f + (ap - 1.f) * kac);
        if (FULL) { r[e] = bf2f(q.r[e]); vv[e] = bf2f(q.v[e]); }
    }
    float lp[8]; lp[0] = w[0];
#pragma unroll
    for (int e = 1; e < 8; ++e) lp[e] = lp[e - 1] * w[e];
    G[tq * 64 + j] = lp[7];
    __syncthreads();
    float pre = 1.f, wend = 1.f;
#pragma unroll
    for (int q = 0; q < 8; ++q) { const float g = G[q * 64 + j]; pre *= (q < tq) ? g : 1.f; wend *= g; }
    if (FULL && tq == 0) WE[j] = wend;
    bf16_t* At = slot(smem, 0); bf16_t* AtT = slot(smem, 1); bf16_t* Rt = slot(smem, 2); bf16_t* Bt = slot(smem, 3); bf16_t* Kt = slot(smem, 4);
    bf16_t* BhT = slot(smem, 5); bf16_t* Kh = slot(smem, 6); bf16_t* VA = slot(smem, 7);
    unsigned atp[4], bhp[4], vap[4]; float atv[8], btv[8], bhv[8], rtv[8], ktv[8], khv[8];
#pragma unroll
    for (int e = 0; e < 8; ++e) {
        const int t = tq * 8 + e;
        const float Wt = pre * lp[e], Wm1 = e == 0 ? pre : pre * lp[e - 1], iw = __builtin_amdgcn_rcpf(Wt);
        const float at = a[e] * Wm1, bt = b[e] * iw;
        atv[e] = at; btv[e] = bt; bhv[e] = bt * wend;
        if (FULL) { const float kt = kd[e] * iw; rtv[e] = r[e] * Wt; ktv[e] = kt; khv[e] = kt * wend; }
    }
#pragma unroll
    for (int e = 0; e < 8; e += 2) {
        const int t = tq * 8 + e;
        const unsigned pa = cvt2(atv[e], atv[e + 1]), pb = cvt2(btv[e], btv[e + 1]);
        At[t * LD + j] = (bf16_t)(pa & 0xffffu); At[(t + 1) * LD + j] = (bf16_t)(pa >> 16); Bt[t * LD + j] = (bf16_t)(pb & 0xffffu); Bt[(t + 1) * LD + j] = (bf16_t)(pb >> 16);
        if (FULL) { const unsigned pr = cvt2(rtv[e], rtv[e + 1]), pk = cvt2(ktv[e], ktv[e + 1]), ph = cvt2(khv[e], khv[e + 1]);
            Rt[t * LD + j] = (bf16_t)(pr & 0xffffu); Rt[(t + 1) * LD + j] = (bf16_t)(pr >> 16); Kt[t * LD + j] = (bf16_t)(pk & 0xffffu); Kt[(t + 1) * LD + j] = (bf16_t)(pk >> 16);
            Kh[t * LD + j] = (bf16_t)(ph & 0xffffu); Kh[(t + 1) * LD + j] = (bf16_t)(ph >> 16); }
    }
    if (FULL) {
#pragma unroll
        for (int e = 0; e < 4; ++e) { atp[e] = cvt2(atv[2 * e], atv[2 * e + 1]); bhp[e] = cvt2(bhv[2 * e], bhv[2 * e + 1]); vap[e] = (unsigned)q.v[2 * e] | ((unsigned)q.v[2 * e + 1] << 16); }
        *(u32x4*)(AtT + j * LD + tq * 8) = (u32x4){atp[0], atp[1], atp[2], atp[3]};
        *(u32x4*)(BhT + j * LD + tq * 8) = (u32x4){bhp[0], bhp[1], bhp[2], bhp[3]};
        *(u32x4*)(VA + j * LD + tq * 8) = (u32x4){vap[0], vap[1], vap[2], vap[3]};
    }
    __syncthreads();
}
__device__ __forceinline__ void unit_ids(int half, int ul, int& z, int& head, int& cg) { const int zh = ul & 31; z = zh >> 4; head = zh & 15; cg = half * NCH + (ul >> 5); }

__device__ __forceinline__ void phase_c1(const Params& p, int half, char* smem) {
    const int tid = ptid(), lane = tid & 63, wv = __builtin_amdgcn_readfirstlane(tid >> 6), fr = lane & 15, fq = lane >> 4, m0 = 16 * (wv >> 1), n0 = 32 * (wv & 1);
    const int G = (int)gridDim.x, u0 = (int)blockIdx.x;
    if (u0 >= NUH) return;
#define C1_LOAD(Q, ul_) do { int ux_ = (ul_); ux_ = ux_ < NUH ? ux_ : u0; int z_, head_, cg_; unit_ids(half, ux_, z_, head_, cg_); prep_load<false>(p, z_, head_, cg_, Q); } while (0)
#define C1_BODY(Q, ul_) do { int z_, head_, cg_; unit_ids(half, (ul_), z_, head_, cg_); prep_compute<false>(p, smem, head_, Q); \
        f32x4 acc[2] = {{0.f, 0.f, 0.f, 0.f}, {0.f, 0.f, 0.f, 0.f}}; \
        mm_lds(slot(smem, 3), slot(smem, 0), acc, m0, n0, fr, fq); mask_tri<true>(acc, m0, n0, fr, fq); \
        float* M = (float*)(p.ws + WS_CK1) + (size_t)(ul_) * 4096; \
        _Pragma("unroll") for (int t = 0; t < 2; ++t) *(f32x4*)(M + (m0 + fr) * 64 + n0 + 16 * t + 4 * fq) = acc[t]; \
        __syncthreads(); } while (0)
    PrepRaw q0, q1, q2;
    C1_LOAD(q0, u0); C1_LOAD(q1, u0 + G);
#pragma unroll 1
    for (int ul = u0; ul < NUH; ul += 3 * G) {
        C1_LOAD(q2, ul + 2 * G); C1_BODY(q0, ul);
        C1_LOAD(q0, ul + 3 * G); if (ul + G < NUH) { C1_BODY(q1, ul + G); }
        C1_LOAD(q1, ul + 4 * G); if (ul + 2 * G < NUH) { C1_BODY(q2, ul + 2 * G); }
    }
#undef C1_LOAD
#undef C1_BODY
}
__device__ __forceinline__ void phase_c2(const Params& p, char* smem) {
    const int tid = ptid(), lane = tid & 63, wv = __builtin_amdgcn_readfirstlane(tid >> 6);
    float* Ms = (float*)(smem + wv * 16384);
    const int G8 = (int)gridDim.x * 8, u0 = wv * (int)gridDim.x + (int)blockIdx.x;
    f32x4 mreg[16];
    if (u0 < NUH) {
        const float* M = (const float*)(p.ws + WS_CK1) + (size_t)u0 * 4096;
#pragma unroll
        for (int i = 0; i < 16; ++i) mreg[i] = *(const f32x4*)(M + i * 256 + lane * 4);
    }
    for (int ul = u0; ul < NUH; ul += G8) {
#pragma unroll
        for (int i = 0; i < 16; ++i) *(f32x4*)(Ms + i * 256 + lane * 4) = mreg[i];
        if (ul + G8 < NUH) {
            const float* M = (const float*)(p.ws + WS_CK1) + (size_t)(ul + G8) * 4096;
#pragma unroll
            for (int i = 0; i < 16; ++i) mreg[i] = *(const f32x4*)(M + i * 256 + lane * 4);
        }
        typedef float f32x2p __attribute__((ext_vector_type(2)));
        f32x2p xx[32];
#pragma unroll
        for (int q = 0; q < 32; ++q) xx[q] = (f32x2p){0.f, 0.f};
        xx[31][1] = lane == 63 ? 1.f : 0.f;
#pragma unroll
        for (int s_ = 62; s_ >= 0; --s_) {
            f32x2p acc2 = {0.f, 0.f}; float acc1 = 0.f;
#pragma unroll
            for (int q4 = ((s_ + 1) & ~3); q4 < 64; q4 += 4) {
                const f32x4 mrow = *(const f32x4*)(Ms + s_ * 64 + q4);
#pragma unroll
                for (int pr = 0; pr < 2; ++pr) { const int q = q4 + 2 * pr;
                    if (q > s_) acc2 = acc2 + (f32x2p){mrow[2 * pr], mrow[2 * pr + 1]} * xx[q >> 1];
                    else if (q + 1 > s_) acc1 += mrow[2 * pr + 1] * xx[q >> 1][1]; }
            }
            xx[s_ >> 1][s_ & 1] = lane == s_ ? 1.f : (acc2[0] + acc2[1]) + acc1;
        }
        float x[64];
#pragma unroll
        for (int q = 0; q < 64; ++q) x[q] = xx[q >> 1][q & 1];
        bf16_t* To = (bf16_t*)(p.ws + WS_CK2) + (size_t)ul * 4096;
#pragma unroll
        for (int q = 0; q < 64; ++q) To[q * 64 + lane] = (bf16_t)f2bf(x[q]);
    }
}
__device__ __forceinline__ void phase_c3(const Params& p, int half, char* smem) {
    const int tid = ptid(), lane = tid & 63, wv = __builtin_amdgcn_readfirstlane(tid >> 6), fr = lane & 15, fq = lane >> 4, m0 = 16 * (wv >> 1), n0 = 32 * (wv & 1);
    bf16_t* Y = (bf16_t*)(p.ws + WS_Y);
    const float* WE = (const float*)(smem + 14 * MBUF) + 512;
    PrepRaw pq; u32x4 traw = {0u, 0u, 0u, 0u};
    const int trr = tid >> 3, tc8 = (tid & 7) * 8;
    if ((int)blockIdx.x < NUH) { int z, head, cg; unit_ids(half, (int)blockIdx.x, z, head, cg); prep_load<true>(p, z, head, cg, pq); traw = *(const u32x4*)((const bf16_t*)(p.ws + WS_CK2) + (size_t)blockIdx.x * 4096 + trr * 64 + tc8); }
    for (int ul = blockIdx.x; ul < NUH; ul += gridDim.x) {
        int z, head, cg; unit_ids(half, ul, z, head, cg);
        prep_compute<true>(p, smem, head, pq);
        const int uln = ul + (int)gridDim.x;
        if (uln < NUH) { int z2, head2, cg2; unit_ids(half, uln, z2, head2, cg2); prep_load<true>(p, z2, head2, cg2, pq); }
        bf16_t* At = slot(smem, 0); bf16_t* AtT = slot(smem, 1); bf16_t* Rt = slot(smem, 2); bf16_t* Bt = slot(smem, 3); bf16_t* Kt = slot(smem, 4);
        bf16_t* BhT = slot(smem, 5); bf16_t* Kh = slot(smem, 6); bf16_t* VA = slot(smem, 7); bf16_t* Mak = slot(smem, 8); bf16_t* MrbT = slot(smem, 9);
        bf16_t* Tm = slot(smem, 12); bf16_t* TT = slot(smem, 13); bf16_t* G1T = slot(smem, 10); bf16_t* G2T = slot(smem, 11); bf16_t* Hm = slot(smem, 3); bf16_t* FT = slot(smem, 0); bf16_t* QT = slot(smem, 4);
        const f32x4 Z4 = {0.f, 0.f, 0.f, 0.f};
        f32x4 mrk[2] = {Z4, Z4};
        {
            const int rr = trr, c8 = tc8;
            const u32x4 raw = traw;
            if (uln < NUH) traw = *(const u32x4*)((const bf16_t*)(p.ws + WS_CK2) + (size_t)uln * 4096 + trr * 64 + tc8);
            *(u32x4*)(Tm + rr * LD + c8) = raw;
#pragma unroll
            for (int e = 0; e < 4; ++e) { TT[(c8 + 2 * e) * LD + rr] = (bf16_t)(raw[e] & 0xffffu); TT[(c8 + 2 * e + 1) * LD + rr] = (bf16_t)(raw[e] >> 16); }
        }
        { f32x4 acc[2] = {Z4, Z4}; mm_lds(Kt, At, acc, m0, n0, fr, fq); mask_tri<true>(acc, m0, n0, fr, fq); st_row(Mak, acc, m0, n0, fr, fq); }
        { f32x4 acc[2] = {Z4, Z4}; mm_lds(Bt, Rt, acc, m0, n0, fr, fq); mask_tri<false>(acc, m0, n0, fr, fq); st_tr(MrbT, acc, m0, n0, fr, fq); }
        { mm_lds(Kt, Rt, mrk, m0, n0, fr, fq); mask_tri<false>(mrk, m0, n0, fr, fq); }
        __syncthreads();
        { f32x4 acc[2] = {Z4, Z4}; mm_lds(Tm, MrbT, acc, m0, n0, fr, fq); st_tr(G1T, acc, m0, n0, fr, fq); }
        { f32x4 acc[2] = {Z4, Z4}; mm_lds(Tm, BhT, acc, m0, n0, fr, fq); st_tr(G2T, acc, m0, n0, fr, fq); }
        { f32x4 acc[2] = {Z4, Z4}; mm_lds(Mak, TT, acc, m0, n0, fr, fq); st_row(Hm, acc, m0, n0, fr, fq); }
        __syncthreads();
        bf16_t* EP = (bf16_t*)(p.ws + WS_CK1) + (size_t)ul * 8192;
        {
            f32x4 acc[2];
#pragma unroll
            for (int t = 0; t < 2; ++t) { const u32x2 rw = *(const u32x2*)(Rt + (m0 + fr) * LD + n0 + 16 * t + 4 * fq); acc[t] = (f32x4){bf2f(rw[0] & 0xffffu), bf2f(rw[0] >> 16), bf2f(rw[1] & 0xffffu), bf2f(rw[1] >> 16)}; }
            mm_lds(G1T, AtT, acc, m0, n0, fr, fq);
#pragma unroll
            for (int t = 0; t < 2; ++t) { u32x2 w = {pk2(acc[t][0], acc[t][1]), pk2(acc[t][2], acc[t][3])}; *(u32x2*)(EP + (m0 + fr) * 64 + n0 + 16 * t + 4 * fq) = w; }
        }
        {
            f32x4 acc[2];
#pragma unroll
            for (int t = 0; t < 2; ++t)
#pragma unroll
                for (int r = 0; r < 4; ++r) acc[t][r] = (m0 + fr == n0 + 16 * t + 4 * fq + r) ? WE[m0 + fr] : 0.f;
            mm_lds(G2T, AtT, acc, m0, n0, fr, fq);
#pragma unroll
            for (int t = 0; t < 2; ++t) { u32x2 w = {pk2(acc[t][0], acc[t][1]), pk2(acc[t][2], acc[t][3])}; *(u32x2*)(EP + 4096 + (m0 + fr) * 64 + n0 + 8 * fq + 4 * t) = w; }
        }
        { mm_lds(Hm, MrbT, mrk, m0, n0, fr, fq); st_tr(FT, mrk, m0, n0, fr, fq); }
        {
            f32x4 acc[2];
#pragma unroll
            for (int t = 0; t < 2; ++t) { const u32x2 rw = *(const u32x2*)(Kh + (m0 + fr) * LD + n0 + 16 * t + 4 * fq); acc[t] = (f32x4){bf2f(rw[0] & 0xffffu), bf2f(rw[0] >> 16), bf2f(rw[1] & 0xffffu), bf2f(rw[1] >> 16)}; }
            mm_lds(Hm, BhT, acc, m0, n0, fr, fq); st_tr(QT, acc, m0, n0, fr, fq);
        }
        __syncthreads();
        {
            f32x4 acc[2] = {Z4, Z4}; mm_lds(FT, VA, acc, m0, n0, fr, fq);
            const int row = scan_row(z, cg * 64 + m0 + fr);
#pragma unroll
            for (int t = 0; t < 2; ++t) { u32x2 w = {pk2(acc[t][0], acc[t][1]), pk2(acc[t][2], acc[t][3])}; *(u32x2*)(Y + ((size_t)z * R + row) * 1024 + head * 64 + n0 + 16 * t + 4 * fq) = w; }
        }
        {
            f32x4 acc[2] = {Z4, Z4}; mm_lds(VA, QT, acc, m0, n0, fr, fq);
            bf16_t* SV = (bf16_t*)(p.ws + WS_CK3) + (size_t)ul * 4096;
#pragma unroll
            for (int t = 0; t < 2; ++t) { u32x2 w = {pk2(acc[t][0], acc[t][1]), pk2(acc[t][2], acc[t][3])}; *(u32x2*)(SV + (m0 + fr) * 64 + n0 + 16 * t + 4 * fq) = w; }
        }
        __syncthreads();
    }
}
__device__ __forceinline__ void phase_c4(const Params& p, int half, char* smem) {
    const int tid = ptid(), lane = tid & 63, wv = __builtin_amdgcn_readfirstlane(tid >> 6), fr = lane & 15, fq = lane >> 4;
    const int b = (int)blockIdx.x;
    if (b >= 64) return;
    constexpr int G = 5, NG = NCH / G, NGP = (NG + 1 + 3) / 4 * 4  , PTB = 64 * 144, STEPB = PTB + 32 * 144, BUFB = G * STEPB;
    const int zh = (b & 7) + 8 * (b >> 4), rb = 32 * ((b >> 3) & 1);
    const bf16_t* PTb = (const bf16_t*)(p.ws + WS_CK1) + (size_t)zh * 8192 + 4096;
    const bf16_t* SVb = (const bf16_t*)(p.ws + WS_CK3) + (size_t)zh * 4096;
    if (wv >= 2) {
        const int L = tid - 128, L2 = L - 128;
        const bool isPT = L < 128;
        const bf16_t* gA = PTb + (L >> 3) * 64 + (L & 7) * 8;
        const bf16_t* gB = isPT ? PTb + (48 + (L >> 3)) * 64 + (L & 7) * 8 : SVb + (rb + (L2 >> 3)) * 64 + (L2 & 7) * 8;
        const int strideB = isPT ? 32 * 8192 : 32 * 4096;
        const int ldsA = (L >> 3) * 144 + (L & 7) * 16, ldsB = isPT ? (48 + (L >> 3)) * 144 + (L & 7) * 16 : PTB + (L2 >> 3) * 144 + (L2 & 7) * 16;
        u32x4 ra[4][G][2];
#define C4_LOADG(set, g) do { _Pragma("unroll") for (int s_ = 0; s_ < G; ++s_) { int c_ = (g) * G + s_; c_ = c_ < NCH - 1 ? c_ : NCH - 1; ra[set][s_][0] = *(const u32x4*)(gA + (size_t)c_ * (32 * 8192)); ra[set][s_][1] = *(const u32x4*)(gB + (size_t)c_ * strideB); } } while (0)
#define C4_WRITEG(set, buf) do { _Pragma("unroll") for (int s_ = 0; s_ < G; ++s_) { *(u32x4*)(smem + (buf) * BUFB + s_ * STEPB + ldsA) = ra[set][s_][0]; *(u32x4*)(smem + (buf) * BUFB + s_ * STEPB + ldsB) = ra[set][s_][1]; } } while (0)
        bf16_t* scg = (bf16_t*)(p.ws + WS_CK2) + (size_t)zh * 4096 + (size_t)(rb + (L2 >> 3)) * 64 + (L2 & 7) * 8;
        bf16_t* cag = (bf16_t*)(p.ws + WS_CKS) + (size_t)zh * 4096 + (size_t)(rb + (L2 >> 3)) * 64 + (L2 & 7) * 8;
#define C4_FLUSH(buf, grp) do { const int grp_ = (grp); if (!isPT && grp_ >= 0 && grp_ < NG) { _Pragma("unroll") for (int s_ = 0; s_ < G; ++s_) { const int c_ = grp_ * G + s_ + 1; \
            const u32x4 v_ = *(const u32x4*)(smem + (buf) * BUFB + s_ * STEPB + ldsB); if (c_ < NCH) *(u32x4*)(scg + (size_t)c_ * (32 * 4096)) = v_; else if (!half) *(u32x4*)cag = v_; } } } while (0)
        C4_LOADG(0, 0); C4_LOADG(1, 1); C4_LOADG(2, 2); C4_LOADG(3, 3); C4_WRITEG(0, 0); C4_LOADG(0, 4);
        __syncthreads();
#pragma unroll 1
        for (int g = 0; g < NGP; g += 4) {
            C4_FLUSH(1, g - 1); C4_WRITEG(1, 1); C4_LOADG(1, g + 5); __syncthreads();
            C4_FLUSH(0, g);     C4_WRITEG(2, 0); C4_LOADG(2, g + 6); __syncthreads();
            C4_FLUSH(1, g + 1); C4_WRITEG(3, 1); C4_LOADG(3, g + 7); __syncthreads();
            C4_FLUSH(0, g + 2); C4_WRITEG(0, 0); C4_LOADG(0, g + 8); __syncthreads();
        }
#undef C4_FLUSH
#undef C4_LOADG
#undef C4_WRITEG
    } else {
        const int i0 = rb + 16 * wv;
        bf16_t* SCb = (bf16_t*)(p.ws + WS_CK2) + (size_t)zh * 4096 + (size_t)(i0 + fr) * 64 + 4 * fq;
        bf16_t* carry = (bf16_t*)(p.ws + WS_CKS) + (size_t)zh * 4096 + (size_t)(i0 + fr) * 64 + 4 * fq;
        u32x2 sa[2][2];
#pragma unroll
        for (int ks = 0; ks < 2; ++ks)
#pragma unroll
            for (int q = 0; q < 2; ++q) { sa[ks][q] = (u32x2){0u, 0u}; if (half) sa[ks][q] = *(const u32x2*)(carry + 32 * ks + 16 * q); *(u32x2*)(SCb + 32 * ks + 16 * q) = sa[ks][q]; }
        const int aoff = fr * 144 + fq * 16, soff = PTB + (16 * wv + fr) * 144 + fq * 8;
        u32x4 fa[2][4][2]; u32x2 fs[2][4];
#define C4_FRAGS(B, sp) do { const char* sp_ = (sp); _Pragma("unroll") for (int t = 0; t < 4; ++t) { _Pragma("unroll") for (int ks = 0; ks < 2; ++ks) \
            fa[B][t][ks] = *(const u32x4*)(sp_ + t * 16 * 144 + aoff + 64 * ks); fs[B][t] = *(const u32x2*)(sp_ + soff + 32 * t); } } while (0)
#define C4_COMP(B, sp) do { f32x4 acc[4]; \
            _Pragma("unroll") for (int t = 0; t < 4; ++t) acc[t] = (f32x4){bf2f(fs[B][t][0] & 0xffffu), bf2f(fs[B][t][0] >> 16), bf2f(fs[B][t][1] & 0xffffu), bf2f(fs[B][t][1] >> 16)}; \
            _Pragma("unroll") for (int ks = 0; ks < 2; ++ks) { const u32x4 bw = {sa[ks][0][0], sa[ks][0][1], sa[ks][1][0], sa[ks][1][1]}; const bf16x8 bop = __builtin_bit_cast(bf16x8, bw); \
                _Pragma("unroll") for (int t = 0; t < 4; ++t) acc[t] = __builtin_amdgcn_mfma_f32_16x16x32_bf16(__builtin_bit_cast(bf16x8, fa[B][t][ks]), bop, acc[t], 0, 0, 0); } \
            _Pragma("unroll") for (int ks = 0; ks < 2; ++ks) _Pragma("unroll") for (int q = 0; q < 2; ++q) { \
                sa[ks][q] = (u32x2){cvt2(acc[2 * ks + q][0], acc[2 * ks + q][1]), cvt2(acc[2 * ks + q][2], acc[2 * ks + q][3])}; \
                *(u32x2*)((sp) + soff + 64 * ks + 32 * q) = sa[ks][q]; } } while (0)
#define C4_GROUP(bufp) do { char* bp_ = (bufp); C4_FRAGS(0, bp_); \
            C4_FRAGS(1, bp_ + 1 * STEPB); C4_COMP(0, bp_); C4_FRAGS(0, bp_ + 2 * STEPB); C4_COMP(1, bp_ + 1 * STEPB); C4_FRAGS(1, bp_ + 3 * STEPB); C4_COMP(0, bp_ + 2 * STEPB); \
            C4_FRAGS(0, bp_ + 4 * STEPB); C4_COMP(1, bp_ + 3 * STEPB); C4_COMP(0, bp_ + 4 * STEPB); } while (0)
        __syncthreads();
#pragma unroll 1
        for (int g = 0; g < NGP; g += 2) {
            if (g < NG) { C4_GROUP(smem); }
            __syncthreads();
            if (g < NG) { C4_GROUP(smem + BUFB); }
            __syncthreads();
        }
#undef C4_FRAGS
#undef C4_COMP
#undef C4_GROUP
    }
}
__device__ __forceinline__ void phase_c5(const Params& p, int half) {
    const int tid = ptid(), lane = tid & 63, wv = __builtin_amdgcn_readfirstlane(tid >> 6), fr = lane & 15, fq = lane >> 4, m0 = 16 * (wv >> 1), n0 = 32 * (wv & 1);
    bf16_t* Y = (bf16_t*)(p.ws + WS_Y);
    struct C5Set { bf16x8 af[2], bq[2][2]; u32x2 y[2]; bf16_t* yp; };
#define C5_LOAD(S, ul_) do { int z, head, cg; unit_ids(half, (ul_), z, head, cg); \
        const bf16_t* ET = (const bf16_t*)(p.ws + WS_CK1) + (size_t)(ul_) * 8192; const bf16_t* SC = (const bf16_t*)(p.ws + WS_CK2) + (size_t)(ul_) * 4096; \
        _Pragma("unroll") for (int ks = 0; ks < 2; ++ks) { S.af[ks] = *(const bf16x8*)(ET + (m0 + fr) * 64 + ks * 32 + fq * 8); \
            _Pragma("unroll") for (int t = 0; t < 2; ++t) S.bq[ks][t] = *(const bf16x8*)(SC + (n0 + 16 * t + fr) * 64 + ks * 32 + fq * 8); } \
        S.yp = Y + ((size_t)z * R + scan_row(z, cg * 64 + m0 + fr)) * 1024 + head * 64 + n0 + 4 * fq; \
        _Pragma("unroll") for (int t = 0; t < 2; ++t) S.y[t] = *(const u32x2*)(S.yp + 16 * t); } while (0)
#define C5_DO(S) do { f32x4 acc[2]; _Pragma("unroll") for (int t = 0; t < 2; ++t) acc[t] = (f32x4){bf2f(S.y[t][0] & 0xffffu), bf2f(S.y[t][0] >> 16), bf2f(S.y[t][1] & 0xffffu), bf2f(S.y[t][1] >> 16)}; \
        _Pragma("unroll") for (int ks = 0; ks < 2; ++ks) _Pragma("unroll") for (int t = 0; t < 2; ++t) acc[t] = __builtin_amdgcn_mfma_f32_16x16x32_bf16(S.bq[ks][t], S.af[ks], acc[t], 0, 0, 0); \
        _Pragma("unroll") for (int t = 0; t < 2; ++t) { u32x2 w_ = {pk2(acc[t][0], acc[t][1]), pk2(acc[t][2], acc[t][3])}; *(u32x2*)(S.yp + 16 * t) = w_; } } while (0)
    C5Set A, B;
    const int G = (int)gridDim.x;
    if ((int)blockIdx.x < NUH) C5_LOAD(A, (int)blockIdx.x);
    for (int ul = blockIdx.x; ul < NUH; ul += 2 * G) {
        const bool hb = ul + G < NUH;
        if (hb) C5_LOAD(B, ul + G);
        C5_DO(A);
        if (hb) { if (ul + 2 * G < NUH) C5_LOAD(A, ul + 2 * G); C5_DO(B); }
    }
#undef C5_LOAD
#undef C5_DO
}
}

__device__ __forceinline__ void phase_bsum(const Params& p, int b0) {
    const int lane = ptid() & 63, wv = ptid() >> 6;
    const int gi = (int)blockIdx.x - b0, gn = (int)gridDim.x - b0;
    if (gi < 0) return;
    const bf16_t* RRb = (const bf16_t*)(p.ws + WS_RR); const bf16_t* KKb = (const bf16_t*)(p.ws + WS_KK); const bf16_t* AP = (const bf16_t*)(p.ws + WS_AP);
    float* BS = (float*)(p.ws + WS_BS);
    const float* k_a = p.in[29]; const float* r_k = p.in[30];
    for (int row = gi * 8 + wv; row < R; row += gn * 8) {
        const int c0 = lane * 16;
        float r[16], k[16], a0[16], a1[16];
#define LD16(dst, ptr) do { _Pragma("unroll") for (int q = 0; q < 2; ++q) { const u32x4 raw = *(const u32x4*)((ptr) + q * 8); _Pragma("unroll") for (int e = 0; e < 4; ++e) { dst[q * 8 + 2 * e] = bf2f(raw[e] & 0xffffu); dst[q * 8 + 2 * e + 1] = bf2f(raw[e] >> 16); } } } while (0)
        LD16(r, RRb + (size_t)row * 1024 + c0); LD16(k, KKb + (size_t)row * 1024 + c0);
        LD16(a0, AP + (size_t)row * 1024 + c0); LD16(a1, AP + ((size_t)R + row) * 1024 + c0);
#undef LD16
        float bsum = 0.f;
#pragma unroll
        for (int e = 0; e < 16; ++e) {
            const float ka = k_a[c0 + e], kd0 = k[e] * (1.f + (a0[e] - 1.f) * ka), kd1 = k[e] * (1.f + (a1[e] - 1.f) * ka);
            bsum += r[e] * (kd0 + kd1) * r_k[c0 + e];
        }
        bsum += __shfl_xor(bsum, 1); bsum += __shfl_xor(bsum, 2);
        if ((lane & 3) == 0) BS[(size_t)row * 16 + (lane >> 2)] = bsum;
    }
}

__device__ __forceinline__ void phase_rout(const Params& p) {
    const int lane = ptid() & 63, wv = ptid() >> 6;
    const bf16_t* Y = (const bf16_t*)(p.ws + WS_Y);
    const bf16_t* VVb = (const bf16_t*)(p.ws + WS_VV); const bf16_t* G = (const bf16_t*)(p.ws + WS_G);
    bf16_t* A2 = (bf16_t*)(p.ws + WS_A2R);
    const float* lw = p.in[31]; const float* lb = p.in[32];
    for (int row = blockIdx.x * 8 + wv; row < R; row += gridDim.x * 8) {
        const int c0 = lane * 16;
        float y[16], v[16], g[16];
#pragma unroll
        for (int q = 0; q < 2; ++q) { const u32x4 ya = *(const u32x4*)(Y + (size_t)row * 1024 + c0 + q * 8), yb = *(const u32x4*)(Y + ((size_t)R + row) * 1024 + c0 + q * 8);
#pragma unroll
            for (int e = 0; e < 4; ++e) { y[q * 8 + 2 * e] = bf2f(ya[e] & 0xffffu) + bf2f(yb[e] & 0xffffu); y[q * 8 + 2 * e + 1] = bf2f(ya[e] >> 16) + bf2f(yb[e] >> 16); } }
#define LD16(dst, ptr) do { _Pragma("unroll") for (int q = 0; q < 2; ++q) { const u32x4 raw = *(const u32x4*)((ptr) + q * 8); _Pragma("unroll") for (int e = 0; e < 4; ++e) { dst[q * 8 + 2 * e] = bf2f(raw[e] & 0xffffu); dst[q * 8 + 2 * e + 1] = bf2f(raw[e] >> 16); } } } while (0)
        LD16(v, VVb + (size_t)row * 1024 + c0); LD16(g, G + (size_t)row * 1024 + c0);
#undef LD16
        const float bsum = ((const float*)(p.ws + WS_BS))[(size_t)row * 16 + (lane >> 2)];
        float s = 0.f;
#pragma unroll
        for (int e = 0; e < 16; ++e) s += y[e];
        s += __shfl_xor(s, 1); s += __shfl_xor(s, 2);
        const float mean = s * (1.f / 64.f);
        float q2 = 0.f;
#pragma unroll
        for (int e = 0; e < 16; ++e) { y[e] -= mean; q2 += y[e] * y[e]; }
        q2 += __shfl_xor(q2, 1); q2 += __shfl_xor(q2, 2);
        const float rs = rsqrtf(q2 * (1.f / 64.f) + 64e-5f);
        unsigned w[8];
#pragma unroll
        for (int e = 0; e < 8; ++e) {
            const float o0 = (y[2 * e] * rs * lw[c0 + 2 * e] + lb[c0 + 2 * e] + bsum * v[2 * e]) * g[2 * e];
            const float o1 = (y[2 * e + 1] * rs * lw[c0 + 2 * e + 1] + lb[c0 + 2 * e + 1] + bsum * v[2 * e + 1]) * g[2 * e + 1];
            w[e] = pk2(o0, o1);
        }
        *(u32x4*)(A2 + (size_t)row * 1024 + c0) = (u32x4){w[0], w[1], w[2], w[3]};
        *(u32x4*)(A2 + (size_t)row * 1024 + c0 + 8) = (u32x4){w[4], w[5], w[6], w[7]};
    }
}


__device__ __forceinline__ void conv_layer(const Params& p, int layer, float* lds, int rot0 = 0, int gi = -1, int gn = 0) {
    int rot = rot0;
    if (layer == 3) {
    } else if (layer == 0) {
        const int j = 0;
        conv_w(BQKV{p.in[8] + (size_t)j * 1024 * 3072}, WSB(WS_WIN), 3072, 1024, lds, rot, gi, gn);
        conv_w(BPlain{p.in[11] + (size_t)j * 1024 * 1024, 1024}, WSB(WS_WOUT), 1024, 1024, lds, rot, gi, gn);
    } else if (layer == 1) {
        conv_w(BPlain{p.in[12], 2048}, WSB(WS_WIN), 2048, 1024, lds, rot, gi, gn);
        for (int i = blockIdx.x * NTHR + ptid(); i < 8 * 128 * 128 / 2; i += gridDim.x * NTHR) ((unsigned*)(p.ws + WS_WSPAT))[i] = pk2(p.in[15][2 * i], p.in[15][2 * i + 1]);
        conv_w(BPlain{p.in[17], 1024}, WSB(WS_WOUT), 1024, 1024, lds, rot, gi, gn);
    } else {
#pragma unroll
        for (int q = 0; q < 3; ++q) conv_w(BPlain{p.in[19] + (size_t)q * 1024 * 1024, 1024}, WSB(WS_WIN) + (size_t)q * 1024 * 1024, 1024, 1024, lds, rot, gi, gn);
        conv_w(BPlain{p.in[33], 1024}, WSB(WS_WOUT2), 1024, 1024, lds, rot, gi, gn);
        conv_w(BLora1{p.in[21]}, WSB(WS_WIN) + (size_t)3 * 1024 * 1024, 256, 1024, lds, rot, gi, gn);
        conv_w(BLora1{p.in[24]}, WSB(WS_WIN) + (size_t)3 * 1024 * 1024 + 256 * 1024, 256, 1024, lds, rot, gi, gn);
        conv_w(BG1{p.in[26]}, WSB(WS_WIN) + (size_t)3 * 1024 * 1024 + 2 * 256 * 1024, 256, 1024, lds, rot, gi, gn);
        conv_w(BLora2{p.in[22]}, WSB(WS_WL), 2048, 128, lds, rot, gi, gn);
        conv_w(BLora2{p.in[25]}, WSB(WS_WL) + 256 * 1024, 2048, 128, lds, rot, gi, gn);
        conv_w(BG2{p.in[27]}, WSB(WS_WL) + 2 * 256 * 1024, 1024, 256, lds, rot, gi, gn);
    }
    if (layer == 0 || layer == 2) {
        const int j = layer >> 1;
        conv_w(BGateUp{p.in[34] + (size_t)j * 1024 * FF, p.in[35] + (size_t)j * 1024 * FF, FF}, WSB(WS_WF1), 2 * FF, 1024, lds, rot, gi, gn);
        conv_w(BPlain{p.in[36] + (size_t)j * FF * 1024, 1024}, WSB(WS_WF2D), 1024, FF, lds, rot, gi, gn);
    } else {
        const int j = layer >> 1;
#pragma unroll 1
        for (int e = 0; e < 8; ++e) {
            const size_t wo = ((size_t)j * 8 + e) * 1024 * FF;
            conv_w(BGateUp{p.in[38] + wo, p.in[39] + wo, FF}, WSB(WS_WF1) + (size_t)e * 2 * FF * 1024, 2 * FF, 1024, lds, rot, gi, gn);
            if (e >= 2) conv_w(BPlain{p.in[40] + wo, 1024}, WSB(WS_WF2M) + (size_t)e * 1024 * FF, 1024, FF, lds, rot, gi, gn);
        }
    }
}

__device__ __forceinline__ void conv_tail(const Params& p, float* lds, int j) {
    const int b0 = 1430 % (int)gridDim.x, gi = (int)blockIdx.x - b0, gn = (int)gridDim.x - b0;
    if (gi < 0) return;
    int rot = 0;
#pragma unroll 1
    for (int e = 0; e < 2; ++e) { const size_t wo = ((size_t)j * 8 + e) * 1024 * FF; conv_w(BPlain{p.in[40] + wo, 1024}, WSB(WS_WF2M) + (size_t)e * 1024 * FF, 1024, FF, lds, rot, gi, gn); }
}
__device__ __forceinline__ void conv_attn3(const Params& p, float* lds, int b0) {
    const int gi = (int)blockIdx.x - b0, gn = (int)gridDim.x - b0;
    if (gi < 0) return;
    int rot = 0;
    conv_w(BQKV{p.in[8] + (size_t)1024 * 3072}, WSB(WS_WIN), 3072, 1024, lds, rot, gi, gn);
    conv_w(BPlain{p.in[11] + (size_t)1024 * 1024, 1024}, WSB(WS_WOUT), 1024, 1024, lds, rot, gi, gn);
}
__device__ __forceinline__ void conv_l2_tail(const Params& p, float* lds, const char* smem) {
    const int units = (__builtin_amdgcn_readfirstlane(((const int*)(smem + 132 * 1024))[8]) >> 8) * 4;
    const int G = (int)gridDim.x; int b0 = units % G; if (G - b0 < G / 2) b0 = 0;
    const int gi = (int)blockIdx.x - b0;
    if (gi < 0) return;
    conv_layer(p, 2, lds, 0, gi, G - b0);
}

#define XB_TMO      128
#define XB_XCNT(j)  (256  + 64 * (j))
#define XB_XSUB(j)  (1280 + 64 * (j))
#define XB_XGEN(j)  (2304 + 64 * (j))
#define XB_TOP      3328
#define XB_TOPGEN   3392
#define XCD_BAR_WORDS 3456
#define XB_SPIN_CAP (1u << 22)
#define LAS __attribute__((address_space(3)))

__device__ __forceinline__ unsigned xb_ld(unsigned* p)              { return __hip_atomic_load(p, __ATOMIC_RELAXED, __HIP_MEMORY_SCOPE_AGENT); }
__device__ __forceinline__ unsigned xb_add(unsigned* p, unsigned v) { return __hip_atomic_fetch_add(p, v, __ATOMIC_RELAXED, __HIP_MEMORY_SCOPE_AGENT); }
__device__ __forceinline__ unsigned xb_xcc_id() { return (unsigned)__builtin_amdgcn_s_getreg((3 << 11) | 20) & 0xFu; }
#define XB_SPIN(cond, bar) do { unsigned _sp = 0; while (cond) { __builtin_amdgcn_s_sleep(1); \
    if ((++_sp & 255u) == 0u) { if (xb_ld(&(bar)[XB_TMO])) break; if (_sp > XB_SPIN_CAP) { atomicAdd(&(bar)[XB_TMO], 1u); break; } } } } while (0)

struct XcdBarrier {
    unsigned* bar; unsigned x;
    volatile LAS unsigned* st;
};

__device__ __forceinline__ XcdBarrier xcd_barrier_post(unsigned* bar, volatile LAS unsigned* st) {
    XcdBarrier b; b.bar = bar; b.x = xb_xcc_id(); b.st = st;
    if (ptid() == 0) (void)xb_add(&bar[XB_XCNT(b.x)], 1u);
    return b;
}
__device__ __forceinline__ void xcd_barrier_complete(unsigned* bar, unsigned x, unsigned& nloc, unsigned& nx) {
    const unsigned G = gridDim.x * gridDim.y * gridDim.z;
    unsigned sum, cnt, mine, sp = 0u;
    for (;;) {
        sum = 0u; cnt = 0u; mine = 0u;
#pragma unroll
        for (unsigned j = 0; j < 16; ++j) { const unsigned c = xb_ld(&bar[XB_XCNT(j)]); sum += c; cnt += (c > 0u) ? 1u : 0u; mine = (j == x) ? c : mine; }
        if (sum == G) break;
        __builtin_amdgcn_s_sleep(1);
        if ((++sp & 255u) == 0u) { if (xb_ld(&bar[XB_TMO])) break; if (sp > XB_SPIN_CAP) { atomicAdd(&bar[XB_TMO], 1u); break; } }
    }
    nloc = mine > 0u ? mine : 1u; nx = cnt > 0u ? cnt : 1u;
}

__device__ __forceinline__ void xcd_barrier(const XcdBarrier& b) {
    asm volatile("s_waitcnt vmcnt(0)" ::: "memory");
    __syncthreads();
    if (ptid() == 0) {
        unsigned* bar = b.bar;
        __builtin_amdgcn_s_waitcnt(0);
        unsigned nloc = b.st[0], nx = b.st[1];
        if (nloc == 0u) { xcd_barrier_complete(bar, b.x, nloc, nx); b.st[0] = nloc; b.st[1] = nx; }
        const unsigned old = xb_add(&bar[XB_XSUB(b.x)], 1u);
        const unsigned gen = old / nloc;
        if (old + 1u == (gen + 1u) * nloc) {
            __builtin_amdgcn_fence(__ATOMIC_RELEASE, "agent");
            asm volatile("s_waitcnt vmcnt(0)" ::: "memory");
            const unsigned og = xb_add(&bar[XB_TOP], 1u);
            const unsigned tg = og / nx;
            if (og + 1u == (tg + 1u) * nx) xb_add(&bar[XB_TOPGEN], 1u);
            else XB_SPIN(xb_ld(&bar[XB_TOPGEN]) == tg, bar);
            __builtin_amdgcn_fence(__ATOMIC_ACQUIRE, "agent");
            xb_add(&bar[XB_XGEN(b.x)], 1u);
            asm volatile("s_waitcnt vmcnt(0)" ::: "memory");
        } else {
            XB_SPIN(xb_ld(&bar[XB_XGEN(b.x)]) == gen, bar);
            __builtin_amdgcn_fence(__ATOMIC_ACQUIRE, "agent");
            asm volatile("s_waitcnt vmcnt(0)" ::: "memory");
        }
    }
    __syncthreads();
}


#define AS4 __attribute__((address_space(4)))
__device__ __forceinline__ Params fresh_params() {
    Params q;
#if defined(__HIP_DEVICE_COMPILE__)
    const AS4 unsigned long long* ka = (const AS4 unsigned long long*)__builtin_amdgcn_kernarg_segment_ptr();
    asm volatile("" : "+s"(ka));
#pragma unroll
    for (int i = 0; i < 41; ++i) q.in[i] = (const float*)(const __attribute__((address_space(1))) float*)ka[i];
    q.out = (float*)(__attribute__((address_space(1))) float*)ka[41]; q.ws = (unsigned char*)(__attribute__((address_space(1))) unsigned char*)ka[42];
#endif
    return q;
}
__global__ void __launch_bounds__(NTHR, 2) mega(Params p_unused) {
    extern __shared__ __attribute__((aligned(16))) char smem[];
    float* lds = (float*)smem;
#define PH(...) do { const Params p = fresh_params(); bf16_t* XL = (bf16_t*)(p.ws + WS_XL); const bf16_t* H = (const bf16_t*)(p.ws + WS_H); const float* MOD = (const float*)(p.ws + WS_MOD); (void)XL; (void)H; (void)MOD; __VA_ARGS__; } while (0)
    volatile LAS unsigned* st = (volatile LAS unsigned*)(smem + 143 * 1024);
    if (ptid() == 0) { st[0] = 0u; st[1] = 0u; st[2] = 0u; st[3] = 0u; }
    __syncthreads();
    PH((void)xcd_barrier_post((unsigned*)(p.ws + WS_CTL), st));
#define GB() do { XcdBarrier b_; b_.bar = (unsigned*)(fresh_params().ws + WS_CTL); b_.x = xb_xcc_id(); b_.st = st; xcd_barrier(b_); } while (0)
    const float QS = 0.125f * 1.4426950408889634f;
    PH(phase_mod(p, lds)); PH(conv_layer(p, 0, lds, 128)); GB();
    PH(phase_norm(p, 0, 0, 1, -1, 0, 0, -1, smem)); GB();
    PH(gemm_ctx(smem, H, 1024, WSB(WS_WIN), 3072, EpiQKV4{WSB(WS_QKV), QS})); PH(gemm_fast(smem, H, RC, R - RC, 1024, WSB(WS_WIN), 3072, EpiQKV{WSB(WS_QKV), (const float*)(p.ws + WS_TAB), QS})); GB();
    PH(phase_attn_fused(p, 0, 0.2f, 1, smem)); GB();
    PH(gemm_ctx(smem, WSB(WS_A2), 1024, WSB(WS_WOUT), 1024, EpiResid4{XL, MOD + 0 * 2 * 6144, 2, p.in[2]})); PH(gemm_fast(smem, WSB(WS_A2), RC, R - RC, 1024, WSB(WS_WOUT), 1024, EpiResid{XL, MOD + 0 * 2 * 6144, 2, nullptr, 0, p.in[0], p.in[2]})); GB();
    PH(phase_norm(p, 0, 1, 0, -1, 0, 0, -1, smem)); GB();
    PH(gemm_fast(smem, H, 0, R, 1024, WSB(WS_WF1), 2 * FF, EpiGateUp{WSB(WS_ACT), FF})); PH(conv_tail(p, lds, 0)); GB();
    PH(gemm_ctx(smem, WSB(WS_ACT), FF, WSB(WS_WF2D), 1024, EpiResid4{XL, MOD + 0 * 2 * 6144, 5})); PH(gemm_fast(smem, WSB(WS_ACT), RC, R - RC, FF, WSB(WS_WF2D), 1024, EpiResid{XL, MOD + 0 * 2 * 6144, 5, nullptr, 0})); GB();
    PH(conv_layer(p, 1, lds)); PH(phase_norm(p, 1, 0, 0, -1, 0, 0, -1, smem)); GB();
    PH(gemm_ctx(smem, H, 1024, WSB(WS_WIN), 2048, EpiGelu4{WSB(WS_U), WSB(WS_VP)})); PH(gemm_fast(smem, H, RC, R - RC, 1024, WSB(WS_WIN), 2048, EpiGelu{WSB(WS_U), WSB(WS_VP)})); GB();
    PH(phase_lnv(p)); GB();
    PH(phase_spat(p, smem)); GB();
    PH(gemm_ctx(smem, WSB(WS_A2), 1024, WSB(WS_WOUT), 1024, EpiResid4{XL, MOD + 1 * 2 * 6144, 2})); PH(gemm_fast(smem, WSB(WS_A2), RC, R - RC, 1024, WSB(WS_WOUT), 1024, EpiResid{XL, MOD + 1 * 2 * 6144, 2, nullptr, 0})); GB();
    PH(phase_norm(p, 1, 1, 0, 0, 0, 0, -1, smem)); GB();
    PH(phase_perm(p, 0, 0, smem)); GB();
    PH(gemm_moe(smem, p, 0, WSB(WS_HP), 1024, WSB(WS_WF1), 22, EpiGateUpM{WSB(WS_ACTM)})); GB();
    PH(gemm_moe(smem, p, 0, WSB(WS_ACTM), FF, WSB(WS_WF2M), 4, EpiStoreM{WSB(WS_YM)})); PH(conv_l2_tail(p, lds, smem)); GB();
    PH(phase_norm(p, 2, 0, 0, -1, 0, 0, 1, smem)); GB();
    PH(phase_mix(p)); GB();
    PH(gemm_rwkv1(smem, p)); GB();
    PH(gemm_fast(smem, WSB(WS_L1W), 0, R, 128, WSB(WS_WL), 2048, EpiDecay{(_Float16*)(p.ws + WS_DEC), p.in[20]}));
    PH(gemm_fast(smem, WSB(WS_L1A), 0, R, 128, WSB(WS_WL) + 256 * 1024, 2048, EpiAP{WSB(WS_AP), p.in[23]}, 248));
    PH(gemm_fast(smem, WSB(WS_L1G), 0, R, 256, WSB(WS_WL) + 2 * 256 * 1024, 1024, EpiStore{WSB(WS_G), 1024, 0}, 240));
    PH(phase_kkn(p)); GB();
#pragma unroll 1
    for (int half = 0; half < 1; ++half) {
        PH(ck::phase_c1(p, half, smem)); __syncthreads();
        PH(ck::phase_c2(p, smem)); __syncthreads();
        PH(ck::phase_c3(p, half, smem)); GB();
        PH(ck::phase_c4(p, half, smem)); PH(phase_bsum(p, gridDim.x > 64 ? 64 : 0)); PH(conv_attn3(p, lds, gridDim.x > 64 ? 64 : 0)); GB();
        PH(ck::phase_c5(p, half)); GB();
    }
    PH(phase_rout(p)); GB();
    PH(gemm_ctx(smem, WSB(WS_A2R), 1024, WSB(WS_WOUT2), 1024, EpiResid4{XL, MOD + 2 * 2 * 6144, 2})); PH(gemm_fast(smem, WSB(WS_A2R), RC, R - RC, 1024, WSB(WS_WOUT2), 1024, EpiResid{XL, MOD + 2 * 2 * 6144, 2, nullptr, 0})); GB();
    PH(phase_norm(p, 2, 1, 0, -1, 0, 0, -1, smem)); GB();
    PH(gemm_fast(smem, H, 0, R, 1024, WSB(WS_WF1), 2 * FF, EpiGateUp{WSB(WS_ACT), FF})); PH(conv_tail(p, lds, 1)); GB();
    PH(gemm_ctx(smem, WSB(WS_ACT), FF, WSB(WS_WF2D), 1024, EpiResid4{XL, MOD + 2 * 2 * 6144, 5})); PH(gemm_fast(smem, WSB(WS_ACT), RC, R - RC, FF, WSB(WS_WF2D), 1024, EpiResid{XL, MOD + 2 * 2 * 6144, 5, nullptr, 0})); GB();
    PH(conv_layer(p, 3, lds)); PH(phase_norm(p, 3, 0, 0, -1, 0, 0, -1, smem)); GB();
    PH(gemm_ctx(smem, H, 1024, WSB(WS_WIN), 3072, EpiQKV4{WSB(WS_QKV), QS})); PH(gemm_fast(smem, H, RC, R - RC, 1024, WSB(WS_WIN), 3072, EpiQKV{WSB(WS_QKV), (const float*)(p.ws + WS_TAB), QS})); GB();
    PH(phase_attn_fused(p, 1, 0.8f - 0.6f * 0.40656965974059911f, 0, smem)); GB();
    PH(gemm_fast(smem, WSB(WS_A2), RC, R - RC, 1024, WSB(WS_WOUT), 1024, EpiResid{XL, MOD + 3 * 2 * 6144, 2, nullptr, 0})); GB();
    PH(phase_norm(p, 3, 1, 0, 1, RC, 0, -1, smem)); GB();
    PH(phase_perm(p, 1, RC, smem)); GB();
    PH(gemm_moe(smem, p, 1, WSB(WS_HP), 1024, WSB(WS_WF1), 22, EpiGateUpM{WSB(WS_ACTM)})); GB();
    PH(gemm_moe(smem, p, 1, WSB(WS_ACTM), FF, WSB(WS_WF2M), 4, EpiStoreM{WSB(WS_YM)})); GB();
    PH(phase_norm(p, 0, 0, 0, -1, RC, 1, 3, smem));
#undef GB
#undef PH
}

constexpr int LDS_BYTES = 144 * 1024;
}

extern "C" void kernel_launch(void* const* d_in, const int* in_sizes, int n_in, void* d_out, int out_size, void* d_ws, size_t ws_size, hipStream_t stream) {
    Params p; memset(&p, 0, sizeof(p));
    for (int i = 0; i < 41; ++i) p.in[i] = (const float*)d_in[i];
    p.out = (float*)d_out; p.ws = (unsigned char*)d_ws;
    hipStream_t s = stream;
    (void)hipMemsetAsync(d_ws, 0, 1 * MiB, s);
    static int grid = 0;
    if (!grid) {
        int dev = 0, cus = 0;
        (void)hipGetDevice(&dev); (void)hipDeviceGetAttribute(&cus, hipDeviceAttributeMultiprocessorCount, dev);
        (void)hipFuncSetAttribute((const void*)mega, hipFuncAttributeMaxDynamicSharedMemorySize, LDS_BYTES);
        grid = cus > 0 ? cus : 256;
    }
    hipLaunchKernelGGL(mega, dim3(grid), dim3(NTHR), LDS_BYTES, s, p);
}
```
